# Optimizing an MI355X kernel written in HIP

```python
import math
import jax, jax.numpy as jnp
from jax import lax
import numpy as np

D_MODEL = 2048
BATCH = 1
SEQ = 8192
DEPTH = 1

CHUNK = 64
Q_BLOCK = 128
ROPE_THETA = 500000.0
EPS = 1e-6

MLA_HEADS = 8
MLA_Q_RANK = 768
MLA_KV_RANK = 512
MLA_NOPE = 128
MLA_ROPE = 64
MLA_V = 128

DIFF_HEADS = 8
DIFF_HEAD_DIM = 64
DIFF_ROT = DIFF_HEAD_DIM // 4
DIFF_QK = DIFF_HEADS * 2 * DIFF_HEAD_DIM
DIFF_VW = DIFF_HEADS * 2 * DIFF_HEAD_DIM

D_MIX = MLA_HEADS * MLA_V + DIFF_VW
IN_SPLITS = (MLA_Q_RANK, MLA_KV_RANK, MLA_ROPE, DIFF_QK, DIFF_QK, DIFF_VW)
D_IN = MLA_Q_RANK + MLA_KV_RANK + MLA_ROPE + 2 * DIFF_QK + DIFF_VW

N_EXPERTS = 64
TOP_K = 8
N_GROUPS = 8
TOPK_GROUPS = 4
D_EXPERT = 512
D_SHARED = 512
ROUTED_SCALE = 2.5
MOE_BLOCK = 128

kernel_name = "hybrid_mla_diffattn_moe_block"


def rmsnorm(x, g):
    xf = x.astype(jnp.float32)
    y = xf * lax.rsqrt(jnp.mean(xf * xf, axis=-1, keepdims=True) + EPS)
    return y.astype(x.dtype) * g


def rope_tables(seq, dim, dtype):
    pos = jnp.arange(seq, dtype=jnp.float32)
    inv = ROPE_THETA ** (-jnp.arange(0, dim, 2, dtype=jnp.float32) / dim)
    ang = pos[:, None] * inv[None, :]
    return jnp.cos(ang).astype(dtype), jnp.sin(ang).astype(dtype)


def rotate(x, cos, sin):
    half = x.shape[-1] // 2
    x1, x2 = x[..., :half], x[..., half:]
    return jnp.concatenate([x1 * cos - x2 * sin, x2 * cos + x1 * sin], axis=-1)


def to_blocks(a):
    b, s = a.shape[:2]
    nb = s // Q_BLOCK
    return jnp.moveaxis(a.reshape((b, nb, Q_BLOCK) + a.shape[2:]), 1, 0)


def from_blocks(a):
    a = jnp.moveaxis(a, 0, 1)
    return a.reshape((a.shape[0], a.shape[1] * a.shape[2]) + a.shape[3:])


def chunk_mask(start, seq):
    qpos = start + jnp.arange(Q_BLOCK, dtype=jnp.int32)
    kpos = jnp.arange(seq, dtype=jnp.int32)
    return (kpos[None, :] // CHUNK) <= (qpos[:, None] // CHUNK)


def sweep_query_blocks(fn, q_arrays):
    seq = q_arrays[0].shape[1]
    nb = seq // Q_BLOCK
    blocks = tuple(to_blocks(a) for a in q_arrays)
    starts = jnp.arange(nb, dtype=jnp.int32) * Q_BLOCK
    return from_blocks(lax.map(fn, blocks + (starts,)))


def mla_mixer(q_lat, kv_lat, k_pe, g_q, w_uq, g_kv, w_ukv):
    b, s, _ = q_lat.shape
    cos, sin = rope_tables(s, MLA_ROPE, q_lat.dtype)
    q = (rmsnorm(q_lat, g_q) @ w_uq).reshape(b, s, MLA_HEADS, MLA_NOPE + MLA_ROPE)
    q_nope = q[..., :MLA_NOPE]
    q_pe = rotate(q[..., MLA_NOPE:], cos[None, :, None, :], sin[None, :, None, :])
    kv = (rmsnorm(kv_lat, g_kv) @ w_ukv).reshape(b, s, MLA_HEADS, MLA_NOPE + MLA_V)
    k_nope, v = kv[..., :MLA_NOPE], kv[..., MLA_NOPE:]
    k_pe = rotate(k_pe, cos[None], sin[None])
    scale = (MLA_NOPE + MLA_ROPE) ** -0.5

    def block(args):
        qn, qp, start = args
        sc = (jnp.einsum('bqhd,bkhd->bhqk', qn, k_nope)
              + jnp.einsum('bqhd,bkd->bhqk', qp, k_pe)).astype(jnp.float32) * scale
        sc = jnp.where(chunk_mask(start, s)[None, None], sc, -jnp.inf)
        p = jax.nn.softmax(sc, axis=-1).astype(v.dtype)
        return jnp.einsum('bhqk,bkhd->bqhd', p, v)

    out = sweep_query_blocks(block, (q_nope, q_pe))
    return out.reshape(b, s, MLA_HEADS * MLA_V)


def diff_mixer(q, k, v, lq1, lk1, lq2, lk2, g_sub, lambda_init):
    b, s, _ = q.shape
    cos, sin = rope_tables(s, DIFF_ROT, q.dtype)
    cb, sb = cos[None, :, None, None, :], sin[None, :, None, None, :]
    q = q.reshape(b, s, DIFF_HEADS, 2, DIFF_HEAD_DIM)
    k = k.reshape(b, s, DIFF_HEADS, 2, DIFF_HEAD_DIM)
    v = v.reshape(b, s, DIFF_HEADS, 2 * DIFF_HEAD_DIM)
    q = jnp.concatenate([rotate(q[..., :DIFF_ROT], cb, sb), q[..., DIFF_ROT:]], axis=-1)
    k = jnp.concatenate([rotate(k[..., :DIFF_ROT], cb, sb), k[..., DIFF_ROT:]], axis=-1)
    lam = (jnp.exp(jnp.sum(lq1.astype(jnp.float32) * lk1.astype(jnp.float32)))
           - jnp.exp(jnp.sum(lq2.astype(jnp.float32) * lk2.astype(jnp.float32)))
           + lambda_init)
    scale = DIFF_HEAD_DIM ** -0.5

    def block(args):
        qb, start = args
        sc = jnp.einsum('bqhcd,bkhcd->cbhqk', qb, k).astype(jnp.float32) * scale
        sc = jnp.where(chunk_mask(start, s)[None, None, None], sc, -jnp.inf)
        p = jax.nn.softmax(sc, axis=-1)
        a = (p[0] - lam * p[1]).astype(v.dtype)
        return jnp.einsum('bhqk,bkhe->bqhe', a, v)

    out = sweep_query_blocks(block, (q,))
    out = rmsnorm(out, g_sub) * (1.0 - lambda_init)
    return out.reshape(b, s, DIFF_VW)


def swiglu(h, w_gate, w_up, w_down):
    return (jax.nn.silu(h @ w_gate) * (h @ w_up)) @ w_down


def moe(h, w_router, b_router, w_gate, w_up, w_down, ws_gate, ws_up, ws_down):
    b, s, d = h.shape
    t = b * s
    hf = h.reshape(t, d)
    scores = jax.nn.sigmoid(hf.astype(jnp.float32) @ w_router.astype(jnp.float32))
    biased = scores + b_router.astype(jnp.float32)
    grouped = biased.reshape(t, N_GROUPS, N_EXPERTS // N_GROUPS)
    gscore = jnp.sum(lax.top_k(grouped, 2)[0], axis=-1)
    _, gidx = lax.top_k(gscore, TOPK_GROUPS)
    gmask = jnp.zeros((t, N_GROUPS), dtype=bool).at[jnp.arange(t)[:, None], gidx].set(True)
    emask = jnp.repeat(gmask, N_EXPERTS // N_GROUPS, axis=1)
    _, eidx = lax.top_k(jnp.where(emask, biased, -jnp.inf), TOP_K)
    wts = jnp.take_along_axis(scores, eidx, axis=1)
    wts = wts / jnp.sum(wts, axis=-1, keepdims=True) * ROUTED_SCALE

    tk = t * TOP_K
    e_flat = eidx.reshape(tk).astype(jnp.int32)
    tok_flat = jnp.repeat(jnp.arange(t, dtype=jnp.int32), TOP_K)
    w_flat = wts.reshape(tk)
    order = jnp.argsort(e_flat, stable=True)
    se = e_flat[order]
    counts = jnp.bincount(e_flat, length=N_EXPERTS).astype(jnp.int32)
    padded = (counts + MOE_BLOCK - 1) // MOE_BLOCK * MOE_BLOCK
    pend = jnp.cumsum(padded)
    pstart = pend - padded
    gstart = jnp.cumsum(counts) - counts
    dest = pstart[se] + jnp.arange(tk, dtype=jnp.int32) - gstart[se]
    m_pad = tk + N_EXPERTS * MOE_BLOCK
    n_blk = m_pad // MOE_BLOCK
    row_tok = jnp.full((m_pad,), t, dtype=jnp.int32).at[dest].set(tok_flat[order])
    row_w = jnp.zeros((m_pad,), dtype=jnp.float32).at[dest].set(w_flat[order])
    blk_start = jnp.arange(n_blk, dtype=jnp.int32) * MOE_BLOCK
    blk_e = jnp.minimum(jnp.searchsorted(pend, blk_start, side='right'), N_EXPERTS - 1)
    h_pad = jnp.concatenate([hf, jnp.zeros((1, d), dtype=hf.dtype)], axis=0)

    def expert_block(args):
        rows, rw, e = args
        y = swiglu(h_pad[rows], w_gate[e], w_up[e], w_down[e])
        return y * rw[:, None].astype(y.dtype)

    ys = lax.map(expert_block, (row_tok.reshape(n_blk, MOE_BLOCK),
                                row_w.reshape(n_blk, MOE_BLOCK), blk_e))
    routed = jax.ops.segment_sum(ys.reshape(m_pad, d), row_tok, num_segments=t + 1)[:t]
    shared = swiglu(hf, ws_gate, ws_up, ws_down)
    return (shared + routed).reshape(b, s, d)


def setup_inputs(seed: int = 0) -> dict:
    key = jax.random.key(seed)
    ks = jax.random.split(key, 32)
    f32 = jnp.float32
    L, D = DEPTH, D_MODEL

    def nrm(k, shape, scale):
        return jax.random.normal(k, shape, dtype=f32) * scale

    def gain(k, shape):
        return 1.0 + 0.02 * jax.random.normal(k, shape, dtype=f32)

    return {
        "x": nrm(ks[0], (BATCH, SEQ, D), 1.0),
        "c": nrm(ks[1], (BATCH, D), 1.0),
        "w_ada": nrm(ks[2], (L, D, 6 * D), 0.5 * D ** -0.5),
        "b_ada": nrm(ks[3], (L, 6 * D), 0.02),
        "g_pre_mix": gain(ks[4], (L, D)),
        "w_in": nrm(ks[5], (L, D, D_IN), D ** -0.5),
        "g_q_lat": gain(ks[6], (L, MLA_Q_RANK)),
        "w_uq": nrm(ks[7], (L, MLA_Q_RANK, MLA_HEADS * (MLA_NOPE + MLA_ROPE)), MLA_Q_RANK ** -0.5),
        "g_kv_lat": gain(ks[8], (L, MLA_KV_RANK)),
        "w_ukv": nrm(ks[9], (L, MLA_KV_RANK, MLA_HEADS * (MLA_NOPE + MLA_V)), MLA_KV_RANK ** -0.5),
        "lambda_q1": nrm(ks[10], (L, DIFF_HEAD_DIM), 0.1),
        "lambda_k1": nrm(ks[11], (L, DIFF_HEAD_DIM), 0.1),
        "lambda_q2": nrm(ks[12], (L, DIFF_HEAD_DIM), 0.1),
        "lambda_k2": nrm(ks[13], (L, DIFF_HEAD_DIM), 0.1),
        "g_diff_sub": gain(ks[14], (L, 2 * DIFF_HEAD_DIM)),
        "w_out": nrm(ks[15], (L, D_MIX, D), D_MIX ** -0.5),
        "g_post_mix": gain(ks[16], (L, D)),
        "g_pre_ffn": gain(ks[17], (L, D)),
        "w_router": nrm(ks[18], (L, D, N_EXPERTS), D ** -0.5),
        "b_router": nrm(ks[19], (L, N_EXPERTS), 0.01),
        "w_gate": nrm(ks[20], (L, N_EXPERTS, D, D_EXPERT), D ** -0.5),
        "w_up": nrm(ks[21], (L, N_EXPERTS, D, D_EXPERT), D ** -0.5),
        "w_down": nrm(ks[22], (L, N_EXPERTS, D_EXPERT, D), D_EXPERT ** -0.5),
        "ws_gate": nrm(ks[23], (L, D, D_SHARED), D ** -0.5),
        "ws_up": nrm(ks[24], (L, D, D_SHARED), D ** -0.5),
        "ws_down": nrm(ks[25], (L, D_SHARED, D), D_SHARED ** -0.5),
        "g_post_ffn": gain(ks[26], (L, D)),
    }


def reference(x, c, w_ada, b_ada, g_pre_mix, w_in, g_q_lat, w_uq, g_kv_lat, w_ukv,
              lambda_q1, lambda_k1, lambda_q2, lambda_k2, g_diff_sub, w_out, g_post_mix,
              g_pre_ffn, w_router, b_router, w_gate, w_up, w_down,
              ws_gate, ws_up, ws_down, g_post_ffn):
    offs = []
    acc = 0
    for wdt in IN_SPLITS[:-1]:
        acc += wdt
        offs.append(acc)
    for l in range(DEPTH):
        lambda_init = 0.8 - 0.6 * math.exp(-0.3 * l)
        mod = (jax.nn.silu(c) @ w_ada[l] + b_ada[l])[:, None, :]
        sh_a, sc_a, gt_a, sh_f, sc_f, gt_f = jnp.split(mod, 6, axis=-1)

        h = rmsnorm(x, g_pre_mix[l]) * (1.0 + sc_a) + sh_a
        proj = h @ w_in[l]
        q_lat, kv_lat, k_pe, dq, dk, dv = jnp.split(proj, offs, axis=-1)
        o_mla = mla_mixer(q_lat, kv_lat, k_pe, g_q_lat[l], w_uq[l], g_kv_lat[l], w_ukv[l])
        o_diff = diff_mixer(dq, dk, dv, lambda_q1[l], lambda_k1[l], lambda_q2[l], lambda_k2[l],
                            g_diff_sub[l], lambda_init)
        y = jnp.concatenate([o_mla, o_diff], axis=-1) @ w_out[l]
        x = x + gt_a * rmsnorm(y, g_post_mix[l])

        h = rmsnorm(x, g_pre_ffn[l]) * (1.0 + sc_f) + sh_f
        y = moe(h, w_router[l], b_router[l], w_gate[l], w_up[l], w_down[l],
                ws_gate[l], ws_up[l], ws_down[l])
        x = x + gt_f * rmsnorm(y, g_post_ffn[l])
    return x
```

```cpp
#include <hip/hip_runtime.h>
#include <hip/hip_cooperative_groups.h>
#include <cstdio>
#include <cstdint>
namespace cg = cooperative_groups;
#ifndef DUP_PHASE
#define DUP_PHASE 0
#endif

typedef unsigned short bf16_t;
typedef short bf16x8 __attribute__((ext_vector_type(8)));
typedef float f32x4 __attribute__((ext_vector_type(4)));
typedef float f32x2 __attribute__((ext_vector_type(2)));
typedef unsigned u32x4 __attribute__((ext_vector_type(4)));
typedef unsigned u32x2 __attribute__((ext_vector_type(2)));
typedef __bf16 bf16x2_t __attribute__((ext_vector_type(2)));

constexpr int T = 8192, D = 2048;
constexpr int NIN = 4608;
constexpr int QR = 768, KVR = 512;
constexpr int NQ = 1536, NKV = 2048;
constexpr int NE = 64, DE = 512;
constexpr float EPS = 1e-6f;
constexpr int NTHREADS = 512, NWAVES = 8;
constexpr int LDS_BYTES = 147456;

constexpr size_t MiB = 1u << 20;
constexpr size_t WS_CTL = 0, CTL_BYTES = 1 * MiB;
constexpr size_t WS_MODP = 1 * MiB;
constexpr size_t WS_MOD = 3 * MiB;
constexpr size_t WS_WRT = 7 * MiB;
constexpr size_t WS_ROPEM = 4 * MiB;
constexpr size_t WS_ROPED = 6 * MiB;
constexpr size_t WS_WIN = 8 * MiB;
constexpr size_t WS_WUQ = 26 * MiB;
constexpr size_t WS_WUKV = 29 * MiB;
constexpr size_t WS_WOUT = 31 * MiB;
constexpr size_t WS_WGU = 40 * MiB;
constexpr size_t WS_WD = 300 * MiB;
constexpr size_t WS_H2 = 430 * MiB;
constexpr size_t WS_ACT = 462 * MiB;
constexpr size_t WS_ROWL = 550 * MiB;
constexpr size_t WS_TOPW = 552 * MiB;
constexpr size_t WS_TPOS = 554 * MiB;
constexpr size_t WS_SSQ = 553 * MiB;
constexpr size_t WS_R1 = 556 * MiB;
constexpr size_t R_QLAT = WS_R1 + 0 * MiB;
constexpr size_t R_KVLAT = WS_R1 + 12 * MiB;
constexpr size_t R_KPE = WS_R1 + 20 * MiB;
constexpr size_t R_DQ = WS_R1 + 21 * MiB;
constexpr size_t R_DK = WS_R1 + 37 * MiB;
constexpr size_t R_DV = WS_R1 + 53 * MiB;
constexpr size_t R_QM = WS_R1 + 69 * MiB;
constexpr size_t R_KVM = WS_R1 + 93 * MiB;
constexpr size_t R_OATT = WS_R1 + 125 * MiB;
constexpr size_t R_Y = WS_R1 + 157 * MiB;
constexpr size_t R_OC = WS_R1 + 221 * MiB;
constexpr size_t R_YSLOT = WS_R1;
constexpr size_t WS_END = WS_R1 + 288 * MiB;

constexpr int CW_GCNT = 64;

struct Params {
  const float* in[27];
  float* out;
  unsigned char* ws;
};

__device__ __forceinline__ unsigned f2bf(float f) { unsigned u = __builtin_bit_cast(unsigned, f); return (u + 0x7fffu + ((u >> 16) & 1u)) >> 16; }
__device__ __forceinline__ unsigned pk2(float lo, float hi) { return f2bf(lo) | (f2bf(hi) << 16); }
__device__ __forceinline__ unsigned cvtpk2(float lo, float hi) { f32x2 v = {lo, hi}; bf16x2_t b = __builtin_convertvector(v, bf16x2_t); return __builtin_bit_cast(unsigned, b); }
__device__ __forceinline__ u32x4 pack8(const f32x4& a, const f32x4& b) { return (u32x4){cvtpk2(a.x, a.y), cvtpk2(a.z, a.w), cvtpk2(b.x, b.y), cvtpk2(b.z, b.w)}; }
__device__ __forceinline__ u32x2 pack8_fp8(const f32x4& a, const f32x4& b) {
  int lo = __builtin_amdgcn_cvt_pk_fp8_f32(a.x, a.y, 0, false); lo = __builtin_amdgcn_cvt_pk_fp8_f32(a.z, a.w, lo, true);
  int hi = __builtin_amdgcn_cvt_pk_fp8_f32(b.x, b.y, 0, false); hi = __builtin_amdgcn_cvt_pk_fp8_f32(b.z, b.w, hi, true);
  return (u32x2){(unsigned)lo, (unsigned)hi};
}
__device__ __forceinline__ f32x4 unpack4_fp8(unsigned v) { const f32x2 a = __builtin_amdgcn_cvt_pk_f32_fp8((int)v, false), b = __builtin_amdgcn_cvt_pk_f32_fp8((int)v, true); return (f32x4){a.x, a.y, b.x, b.y}; }
__device__ __forceinline__ float bf_lo(unsigned u) { return __uint_as_float(u << 16); }
__device__ __forceinline__ float bf_hi(unsigned u) { return __uint_as_float(u & 0xffff0000u); }
__device__ __forceinline__ float bf1(bf16_t h) { return __uint_as_float(((unsigned)h) << 16); }
__device__ __forceinline__ float wave_sum(float v) {
#pragma unroll
  for (int o = 1; o < 64; o <<= 1) v += __shfl_xor(v, o);
  return v;
}
__device__ __forceinline__ float dot2bf(unsigned a, unsigned b, float c) {
  return __builtin_amdgcn_fdot2_f32_bf16(__builtin_bit_cast(bf16x2_t, a), __builtin_bit_cast(bf16x2_t, b), c, false);
}
__device__ __forceinline__ void sincos_rev(float ang, float& c, float& s) {
  float rev = ang * 0.15915494309189535f;
  rev = rev - floorf(rev);
  s = __builtin_amdgcn_sinf(rev);
  c = __builtin_amdgcn_cosf(rev);
}
__device__ __forceinline__ int opaque_tid() { int t = threadIdx.x; asm volatile("" : "+v"(t)); return t; }
__device__ __forceinline__ int perm32(int rho) { const int n = rho >> 4, i = rho & 15; return 8 * (i >> 2) + 4 * n + (i & 3); }

struct TrDesc { const float* src; bf16_t* dst; const float* gs; int ldw, ldt; int f8; };
template <bool NT> __device__ __forceinline__ void tr_load(const TrDesc& d, f32x4 (&v)[8], int lane) {
  const float* s = d.src + (size_t)(lane >> 3) * d.ldw + 4 * (lane & 7);
#pragma unroll
  for (int i = 0; i < 8; ++i) { const f32x4* q = (const f32x4*)(s + (size_t)(8 * i) * d.ldw); v[i] = NT ? __builtin_nontemporal_load(q) : *q; }
}
template <bool NT> __device__ __forceinline__ void tr_finish(const TrDesc& d, f32x4 (&v)[8], float* scr, int lane) {
  const int r8 = lane >> 3, c4 = lane & 7;
  if (d.gs) {
#pragma unroll
    for (int i = 0; i < 8; ++i) v[i] *= d.gs[8 * i + r8];
  }
#pragma unroll
  for (int i = 0; i < 8; ++i) { float* t = scr + (8 * i + r8) * 33 + 4 * c4; t[0] = v[i].x; t[1] = v[i].y; t[2] = v[i].z; t[3] = v[i].w; }
  asm volatile("s_waitcnt lgkmcnt(0)" ::: "memory");
  const int c = lane & 7;
  if (d.f8) {
#pragma unroll
    for (int j = 0; j < 4; ++j) {
      const int n = (lane >> 3) + 8 * j; const float* s = scr + (8 * c) * 33 + n;
      const f32x4 a = (f32x4){s[0 * 33], s[1 * 33], s[2 * 33], s[3 * 33]} * 32.0f, b = (f32x4){s[4 * 33], s[5 * 33], s[6 * 33], s[7 * 33]} * 32.0f;
      const u32x2 o = pack8_fp8(a, b);
      u32x2* q = (u32x2*)((unsigned char*)d.dst + (size_t)n * d.ldt + 8 * c);
      if (NT) __builtin_nontemporal_store(o, q); else *q = o;
    }
  } else {
#pragma unroll
    for (int j = 0; j < 4; ++j) {
      const int n = (lane >> 3) + 8 * j; const float* s = scr + (8 * c) * 33 + n;
      u32x4 o; o.x = cvtpk2(s[0 * 33], s[1 * 33]); o.y = cvtpk2(s[2 * 33], s[3 * 33]); o.z = cvtpk2(s[4 * 33], s[5 * 33]); o.w = cvtpk2(s[6 * 33], s[7 * 33]);
      u32x4* q = (u32x4*)(d.dst + (size_t)n * d.ldt + 8 * c);
      if (NT) __builtin_nontemporal_store(o, q); else *q = o;
    }
  }
  asm volatile("s_waitcnt lgkmcnt(0)" ::: "memory");
}
constexpr int I_WIN = 32 * 138, I_WUQ = 12 * 48, I_WUKV = 8 * 64, I_WOUT = 32 * 64, I_GU = 65 * 1024, I_DN = 65 * 512;
constexpr int TR_SMALL = I_WIN + I_WUQ + I_WUKV + I_WOUT, TOTAL_TR = TR_SMALL + I_GU + I_DN;
constexpr int TR_FG = TR_SMALL - I_WOUT;
constexpr int CONV_CHUNK = 64, N_CONV_CHUNKS = (I_WOUT + I_GU + I_DN) / CONV_CHUNK;
static_assert((I_WOUT + I_GU + I_DN) % CONV_CHUNK == 0, "chunking");
__device__ __forceinline__ TrDesc tr_decode(const Params& p, int r) {
  unsigned char* ws = p.ws; TrDesc d; d.gs = nullptr; d.f8 = 0;
  if (r < I_WIN) {
    const int kb = r / 138, nb = r % 138, n0 = 32 * nb, k0 = 64 * kb;
    const int d0 = n0 < 1344 ? n0 : n0 + 192;
    d.src = p.in[5] + (size_t)k0 * 4416 + n0; d.ldw = 4416; d.dst = (bf16_t*)(ws + WS_WIN) + (size_t)d0 * 2048 + k0; d.ldt = 2048; return d;
  }
  r -= I_WIN;
  if (r < I_WUQ) { const int kb = r / 48, nb = r % 48, k0 = 64 * kb, n0 = 32 * nb;
    d.src = p.in[7] + (size_t)k0 * 1536 + n0; d.ldw = 1536; d.dst = (bf16_t*)(ws + WS_WUQ) + (size_t)n0 * 768 + k0; d.ldt = 768; d.gs = p.in[6] + k0; return d; }
  r -= I_WUQ;
  if (r < I_WUKV) { const int kb = r / 64, nb = r % 64, k0 = 64 * kb, n0 = 32 * nb;
    d.src = p.in[9] + (size_t)k0 * 2048 + n0; d.ldw = 2048; d.dst = (bf16_t*)(ws + WS_WUKV) + (size_t)n0 * 512 + k0; d.ldt = 512; d.gs = p.in[8] + k0; return d; }
  r -= I_WUKV;
  if (r < I_WOUT) { const int kb = r / 64, nb = r % 64, k0 = 64 * kb, n0 = 32 * nb;
    d.src = p.in[15] + (size_t)k0 * 2048 + n0; d.ldw = 2048; d.dst = (bf16_t*)(ws + WS_WOUT) + (size_t)n0 * 2048 + k0; d.ldt = 2048; return d; }
  r -= I_WOUT;
  if (r < I_GU) {
    const int e = r >> 10, q = r & 1023, up = q >> 9, idx = q & 511, kb = idx >> 4, nb = idx & 15, n0 = 32 * nb, k0 = 64 * kb;
    const float* s = (e < 64) ? (p.in[up ? 21 : 20] + (size_t)e * 2048 * 512) : p.in[up ? 24 : 23];
    const int d0 = 256 * (n0 >> 7) + (n0 & 127) + 128 * up;
    d.src = s + (size_t)k0 * 512 + n0; d.ldw = 512; d.dst = (bf16_t*)(ws + WS_WGU + (size_t)e * 1024 * 2048 + (size_t)d0 * 2048 + k0); d.ldt = 2048; d.f8 = 1; return d;
  }
  r -= I_GU;
  { const int e = r >> 9, idx = r & 511, kb = idx >> 6, nb = idx & 63, k0 = 64 * kb, n0 = 32 * nb;
    const float* s = (e < 64) ? (p.in[22] + (size_t)e * 512 * 2048) : p.in[25];
    d.src = s + (size_t)k0 * 2048 + n0; d.ldw = 2048; d.dst = (bf16_t*)(ws + WS_WD + (size_t)e * 2048 * 512 + (size_t)n0 * 512 + k0); d.ldt = 512; d.f8 = 1; return d; }
}
__device__ __forceinline__ void phase0a(const Params& p, char* lds) {
  const int tid = opaque_tid(), lane = tid & 63, wave = tid >> 6;
  const int gw = blockIdx.x * NWAVES + wave, NGW = gridDim.x * NWAVES;
  float* scr = (float*)(lds + wave * 16384);
  unsigned char* ws = p.ws;
  for (int r = gw; r < 48 * 32; r += NGW) {
    const int nt = r % 48, ks = r / 48;
    const float* c = p.in[1]; const float* w = p.in[2] + (size_t)(64 * ks) * 12288 + 256 * nt + 4 * lane;
    f32x4 acc = {0.f, 0.f, 0.f, 0.f};
#pragma unroll 16
    for (int k = 0; k < 64; ++k) {
      const float cv = c[64 * ks + k]; const float sv = cv / (1.f + expf(-cv));
      const f32x4 wv = *(const f32x4*)(w + (size_t)k * 12288);
      acc += wv * sv;
    }
    *(f32x4*)((float*)(ws + WS_MODP) + (size_t)ks * 12288 + 256 * nt + 4 * lane) = acc;
  }
  {
    f32x4 vA[8], vB[8]; TrDesc dA, dB;
    int it = gw;
    if (it < TR_FG) {
      dA = tr_decode(p, it); tr_load<false>(dA, vA, lane);
      for (;;) {
        const int itB = it + NGW; const bool hasB = itB < TR_FG;
        if (hasB) { dB = tr_decode(p, itB); tr_load<false>(dB, vB, lane); }
        tr_finish<false>(dA, vA, scr, lane);
        if (!hasB) break;
        const int itA = itB + NGW; const bool hasA = itA < TR_FG;
        if (hasA) { dA = tr_decode(p, itA); tr_load<false>(dA, vA, lane); }
        tr_finish<false>(dB, vB, scr, lane);
        if (!hasA) break;
        it = itA;
      }
    }
  }
  const int gt = blockIdx.x * NTHREADS + tid, NGT = gridDim.x * NTHREADS;
  for (int i = gt; i < T * 40; i += NGT) {
    if (i < T * 32) {
      const int pos = i >> 5, f = i & 31;
      const float inv = powf(500000.0f, -(float)(2 * f) / 64.0f);
      float c, s; sincos_rev((float)pos * inv, c, s);
      ((f32x2*)(ws + WS_ROPEM))[i] = (f32x2){c, s};
    } else {
      const int j = i - T * 32, pos = j >> 3, f = j & 7;
      const float inv = powf(500000.0f, -(float)(2 * f) / 16.0f);
      float c, s; sincos_rev((float)pos * inv, c, s);
      ((f32x2*)(ws + WS_ROPED))[j] = (f32x2){c, s};
    }
  }
  for (int i = gt; i < 64 * 4 * 64; i += NGT) {
    const int l = i & 63, jt = (i >> 6) & 3, s = i >> 8;
    const float* w = p.in[18] + (size_t)(32 * s + 8 * (l >> 4)) * 64 + 16 * jt + (l & 15);
    float v[8], lo[8];
#pragma unroll
    for (int j = 0; j < 8; ++j) { v[j] = w[(size_t)j * 64]; lo[j] = v[j] - bf1((bf16_t)f2bf(v[j])); }
    ((u32x4*)(ws + WS_WRT))[i] = (u32x4){pk2(v[0], v[1]), pk2(v[2], v[3]), pk2(v[4], v[5]), pk2(v[6], v[7])};
    ((u32x4*)(ws + WS_WRT + 256 * 1024))[i] = (u32x4){pk2(lo[0], lo[1]), pk2(lo[2], lo[3]), pk2(lo[4], lo[5]), pk2(lo[6], lo[7])};
  }
  if (blockIdx.x == 0 && tid == 0) {
    float a = 0.f, b = 0.f;
    for (int i = 0; i < 64; ++i) { a += p.in[10][i] * p.in[11][i]; b += p.in[12][i] * p.in[13][i]; }
    ((float*)(ws + WS_MOD))[16384] = expf(a) - expf(b) + 0.2f;
  }
}


__device__ __forceinline__ void conv_chunk(const Params& p, char* lds, int chunk) {
  const int tid = opaque_tid(), lane = tid & 63, wave = tid >> 6;
  float* scr = (float*)(lds + wave * 16384);
  const int base = TR_FG + chunk * CONV_CHUNK + wave * 8;
  f32x4 vA[8], vB[8], vC[8], vD[8]; TrDesc dA, dB, dC, dD;
  dA = tr_decode(p, base + 0); tr_load<true>(dA, vA, lane);
  dB = tr_decode(p, base + 1); tr_load<true>(dB, vB, lane);
  dC = tr_decode(p, base + 2); tr_load<true>(dC, vC, lane);
  dD = tr_decode(p, base + 3); tr_load<true>(dD, vD, lane);
  tr_finish<true>(dA, vA, scr, lane); dA = tr_decode(p, base + 4); tr_load<true>(dA, vA, lane);
  tr_finish<true>(dB, vB, scr, lane); dB = tr_decode(p, base + 5); tr_load<true>(dB, vB, lane);
  tr_finish<true>(dC, vC, scr, lane); dC = tr_decode(p, base + 6); tr_load<true>(dC, vC, lane);
  tr_finish<true>(dD, vD, scr, lane); dD = tr_decode(p, base + 7); tr_load<true>(dD, vD, lane);
  tr_finish<true>(dA, vA, scr, lane);
  tr_finish<true>(dB, vB, scr, lane);
  tr_finish<true>(dC, vC, scr, lane);
  tr_finish<true>(dD, vD, scr, lane);
}

__device__ __forceinline__ void phase0b(const Params& p, char* lds) {
  const int tid = opaque_tid(), lane = tid & 63, wave = tid >> 6;
  const int gw = blockIdx.x * NWAVES + wave, NGW = gridDim.x * NWAVES;
  unsigned char* ws = p.ws;
  const float* modp = (const float*)(ws + WS_MODP);
  float* shsc = (float*)lds;
  for (int n = tid; n < 4096; n += NTHREADS) { float s = p.in[3][n]; for (int k = 0; k < 32; ++k) s += modp[(size_t)k * 12288 + n]; shsc[n] = s; }
  for (int n = blockIdx.x * NTHREADS + tid; n < 12288; n += gridDim.x * NTHREADS) { float s = p.in[3][n]; for (int k = 0; k < 32; ++k) s += modp[(size_t)k * 12288 + n]; ((float*)(ws + WS_MOD))[n] = s; }
  __syncthreads();
  const float* x = p.in[0]; const float* g = p.in[4];
  bf16_t* xn = (bf16_t*)(ws + WS_H2);
  for (int row = gw; row < T; row += NGW) {
    f32x4 v[8]; float ss = 0.f;
#pragma unroll
    for (int j = 0; j < 8; ++j) { v[j] = *(const f32x4*)(x + (size_t)row * D + 256 * j + 4 * lane); ss += v[j].x * v[j].x + v[j].y * v[j].y + v[j].z * v[j].z + v[j].w * v[j].w; }
    const float rstd = 1.0f / sqrtf(wave_sum(ss) * (1.0f / D) + EPS);
#pragma unroll
    for (int j = 0; j < 8; ++j) {
      const int c0 = 256 * j + 4 * lane;
      const f32x4 gv = *(const f32x4*)(g + c0);
      const f32x4 sh = *(const f32x4*)(shsc + c0), sc = *(const f32x4*)(shsc + 2048 + c0);
      const f32x4 h = (v[j] * rstd) * gv * (sc + 1.0f) + sh;
      u32x2 o; o.x = pk2(h.x, h.y); o.y = pk2(h.z, h.w);
      *(u32x2*)(xn + (size_t)row * D + c0) = o;
    }
  }
}

template <bool PERM> __device__ __forceinline__ int acc_col(int bj, int wc, int n, int fq) { return 128 * bj + 32 * wc + (PERM ? 8 * fq + 4 * n : 16 * n + 4 * fq); }
__device__ __forceinline__ int acc_row(int ai, int wr, int m, int fr) { return 128 * ai + 64 * wr + 16 * m + fr; }

template <bool PERM, class RowMap, class Epi, class U>
__device__ __forceinline__ void gemm_tile_naive(const bf16_t* A, int lda, const bf16_t* Bt, int K, const RowMap& rm, const Epi& epi, const U& unit) {
  const int tid = opaque_tid(), lane = tid & 63, wid = tid >> 6, wr = wid >> 2, wc = wid & 3, fr = lane & 15, fq = lane >> 4;
  f32x4 acc[2][2][4][2];
#pragma unroll
  for (int a = 0; a < 2; ++a)
#pragma unroll
    for (int b = 0; b < 2; ++b)
#pragma unroll
      for (int m = 0; m < 4; ++m)
#pragma unroll
        for (int n = 0; n < 2; ++n) acc[a][b][m][n] = (f32x4){0.f, 0.f, 0.f, 0.f};
  unsigned aoff[2][4], boff[2][2];
#pragma unroll
  for (int a = 0; a < 2; ++a)
#pragma unroll
    for (int m = 0; m < 4; ++m) aoff[a][m] = (unsigned)rm(acc_row(a, wr, m, fr)) * (unsigned)lda + 8u * fq;
#pragma unroll
  for (int b = 0; b < 2; ++b)
#pragma unroll
    for (int n = 0; n < 2; ++n) { const int rho = 16 * n + fr; boff[b][n] = (unsigned)(128 * b + 32 * wc + (PERM ? perm32(rho) : rho)) * (unsigned)K + 8u * fq; }
  for (int k0 = 0; k0 < K; k0 += 32) {
    bf16x8 af[2][4], bfr[2][2];
#pragma unroll
    for (int a = 0; a < 2; ++a)
#pragma unroll
      for (int m = 0; m < 4; ++m) af[a][m] = *(const bf16x8*)(A + aoff[a][m] + k0);
#pragma unroll
    for (int b = 0; b < 2; ++b)
#pragma unroll
      for (int n = 0; n < 2; ++n) bfr[b][n] = *(const bf16x8*)(Bt + boff[b][n] + k0);
#pragma unroll
    for (int a = 0; a < 2; ++a)
#pragma unroll
      for (int b = 0; b < 2; ++b)
#pragma unroll
        for (int m = 0; m < 4; ++m)
#pragma unroll
          for (int n = 0; n < 2; ++n) acc[a][b][m][n] = __builtin_amdgcn_mfma_f32_16x16x32_bf16(bfr[b][n], af[a][m], acc[a][b][m][n], 0, 0, 0);
  }
  epi(acc, unit, wr, wc, fr, fq);
}


#define LAS __attribute__((address_space(3)))
namespace pg8 {
typedef int i32x4_t __attribute__((ext_vector_type(4)));
constexpr int BM = 256, BK = 64, HALF = 128, HTB = HALF * BK * 2, STAGE_BYTES = 8 * HTB, NXCD = 8, WGM = 8;
__host__ __device__ __forceinline__ int lds_byte(int r, int c) { const int st = (r >> 4) * 2 + (c >> 5), rr = r & 15, cc = c & 31, ob = rr * 64 + cc * 2; return st * 1024 + (ob ^ (((ob >> 9) & 1) << 5)); }
__host__ __device__ __forceinline__ void stage_rc(int b, int& R, int& C) { const int st = b / 1024, sb = b % 1024, swz = sb ^ (((sb >> 9) & 1) << 5); R = (st >> 1) * 16 + swz / 64; C = (st & 1) * 32 + (swz % 64) / 2; }
struct Unit { const char* A; const char* B; int pm, pn, e, aux; };

__device__ __forceinline__ int xcd_remap(int L, int nwg) { const int q = nwg / NXCD, r = nwg % NXCD, xcd = L % NXCD, off = L / NXCD; return (xcd < r ? xcd * (q + 1) : r * (q + 1) + (xcd - r) * q) + off; }

template <class Epi, class Sched, bool ALIGN_EPI, bool GATHER, bool F8 = false>
__device__ __forceinline__ void gemm_phase(LAS unsigned char* lds, const int K, const Sched& S, const Epi& E) {
    const int tid = opaque_tid(), wid = __builtin_amdgcn_readfirstlane(tid >> 6), lane = tid & 63, wr = wid >> 2, wc = wid & 3, fr = lane & 15, fq = lane >> 4;
    const int nt = K / BK;
    unsigned voffB[2];
#pragma unroll
    for (int i = 0; i < 2; ++i) { int R, C; stage_rc(tid * 16 + i * 8192, R, C); const int Rb = Epi::PERM ? ((R & ~31) + perm32(R & 31)) : R; voffB[i] = (unsigned)(Rb * K + C) * 2u; }
    const size_t kstep = (size_t)(BK * 2);
    const size_t hstep = (size_t)HALF * K * 2;
    const unsigned ldsw = (unsigned)wid * 1024u;
    const int aoff = lds_byte(wr * 64 + fr, fq * 8), boff = lds_byte(wc * 32 + fr, fq * 8);
#define PG8_SA(b, h) (((b) * 2 + (h)) * HTB)
#define PG8_SB(b, h) ((4 + (b) * 2 + (h)) * HTB)
#define PG8_STAGE(bufoff, gbase, voff) do { _Pragma("unroll") for (int _i = 0; _i < 2; ++_i) \
        __builtin_amdgcn_global_load_lds((const unsigned*)((const char*)(gbase) + (voff)[_i]), (LAS unsigned*)(lds + (bufoff) + ldsw + _i * 8192), 16, 0, 0); } while (0)
#define PG8_LDA(dst, b, h) do { _Pragma("unroll") for (int m = 0; m < 4; ++m) _Pragma("unroll") for (int k = 0; k < 2; ++k) dst[m][k] = *(const LAS bf16x8*)(lds + PG8_SA(b, h) + aoff + m * 2048 + k * 1024); } while (0)
#define PG8_LDB(dst, b, h) do { _Pragma("unroll") for (int n = 0; n < 2; ++n) _Pragma("unroll") for (int k = 0; k < 2; ++k) dst[n][k] = *(const LAS bf16x8*)(lds + PG8_SB(b, h) + boff + n * 2048 + k * 1024); } while (0)
#define PG8_CAT(x, y) __builtin_shufflevector(__builtin_bit_cast(i32x4_t, x), __builtin_bit_cast(i32x4_t, y), 0, 1, 2, 3, 4, 5, 6, 7)
#define PG8_MMA(ai, bj, At, Bt) do { __builtin_amdgcn_s_setprio(1); _Pragma("unroll") for (int m = 0; m < 4; ++m) _Pragma("unroll") for (int n = 0; n < 2; ++n) { \
        if constexpr (F8) { const auto _a8 = PG8_CAT(Bt[n][0], Bt[n][1]); const auto _b8 = PG8_CAT(At[m][0], At[m][1]); \
          asm("v_mfma_scale_f32_16x16x128_f8f6f4 %0, %1, %2, %0, %3, %3 op_sel_hi:[0,0,0]" : "+v"(acc[ai][bj][m][n]) : "v"(_a8), "v"(_b8), "v"(mxs)); } \
        else { _Pragma("unroll") for (int k = 0; k < 2; ++k) acc[ai][bj][m][n] = __builtin_amdgcn_mfma_f32_16x16x32_bf16(Bt[n][k], At[m][k], acc[ai][bj][m][n], 0, 0, 0); } } \
        __builtin_amdgcn_s_setprio(0); } while (0)
#define PG8_WAIT_V(n) asm volatile("s_waitcnt vmcnt(" #n ")" ::: "memory")
#define PG8_WAIT_L(n) asm volatile("s_waitcnt lgkmcnt(" #n ")" ::: "memory")
#define PG8_BAR __builtin_amdgcn_s_barrier()
#define PG8_SCHED __builtin_amdgcn_sched_barrier(0)
    const int mxs = 0x7f7f7f7f;
    (void)mxs;
    Unit cur, nxt; int ui = 0;
    if (!S.next(0, cur)) return;
    unsigned vA[2][2], vN[2][2];
#define PG8_MKOFF(u, v) do { _Pragma("unroll") for (int _h = 0; _h < 2; ++_h) _Pragma("unroll") for (int _i = 0; _i < 2; ++_i) { int _R, _C; stage_rc(opaque_tid() * 16 + _i * 8192, _R, _C); \
        v[_h][_i] = (unsigned)((GATHER ? S.row(u, _h * HALF + _R) : (_h * HALF + _R)) * K + _C) * 2u; } } while (0)
    PG8_MKOFF(cur, vA);
    f32x4 acc[2][2][4][2];
#pragma unroll
    for (int a = 0; a < 2; ++a)
#pragma unroll
        for (int b = 0; b < 2; ++b)
#pragma unroll
            for (int m = 0; m < 4; ++m)
#pragma unroll
                for (int n = 0; n < 2; ++n) acc[a][b][m][n] = (f32x4){0.f, 0.f, 0.f, 0.f};
    bf16x8 At[4][2], B0[2][2], B1[2][2];
    const char* cA = cur.A; const char* cB = cur.B;
    PG8_STAGE(PG8_SB(0, 0), cB, voffB); PG8_STAGE(PG8_SB(0, 1), cB + hstep, voffB); PG8_STAGE(PG8_SA(0, 0), cA, vA[0]); PG8_STAGE(PG8_SA(0, 1), cA, vA[1]);
    if (wr == 1) PG8_BAR;
    PG8_WAIT_V(2); PG8_BAR;
    PG8_STAGE(PG8_SB(1, 0), cB + kstep, voffB); PG8_STAGE(PG8_SA(1, 0), cA + kstep, vA[0]); PG8_STAGE(PG8_SB(1, 1), cB + hstep + kstep, voffB);
    PG8_WAIT_V(6); PG8_BAR;
    for (;;) {
        const bool has_next = S.next(ui + 1, nxt);
        if (has_next) { PG8_MKOFF(nxt, vN); } else {
#pragma unroll
            for (int h = 0; h < 2; ++h)
#pragma unroll
                for (int i = 0; i < 2; ++i) vN[h][i] = vA[h][i]; }
        const char* nA = has_next ? nxt.A : cA; const char* nB = has_next ? nxt.B : cB;
        for (int t = 0; t < nt; t += 2) {
            const bool last = (t == nt - 2);
            const char* a1 = cA + (size_t)(t + 1) * kstep;
            const char* a2 = last ? nA : cA + (size_t)(t + 2) * kstep; const char* b2 = last ? nB : cB + (size_t)(t + 2) * kstep;
            const char* a3 = a2 + kstep; const char* b3 = b2 + kstep;
            unsigned w0[2], w1[2];
#pragma unroll
            for (int i = 0; i < 2; ++i) { w0[i] = last ? vN[0][i] : vA[0][i]; w1[i] = last ? vN[1][i] : vA[1][i]; }
            PG8_LDB(B0, 0, 0); PG8_LDB(B1, 0, 1); PG8_SCHED; PG8_LDA(At, 0, 0); PG8_STAGE(PG8_SA(1, 1), a1, vA[1]);
            PG8_WAIT_V(8); PG8_WAIT_L(0); PG8_BAR; PG8_MMA(0, 0, At, B0); PG8_MMA(0, 1, At, B1); PG8_BAR; PG8_SCHED;
            PG8_LDA(At, 0, 1); PG8_STAGE(PG8_SB(0, 0), b2, voffB); PG8_STAGE(PG8_SB(0, 1), b2 + hstep, voffB); PG8_STAGE(PG8_SA(0, 0), a2, w0);
            PG8_WAIT_V(8); PG8_WAIT_L(0); PG8_BAR; PG8_MMA(1, 0, At, B0); PG8_MMA(1, 1, At, B1); PG8_BAR; PG8_SCHED;
            PG8_LDB(B0, 1, 0); PG8_LDB(B1, 1, 1); PG8_SCHED; PG8_LDA(At, 1, 0); PG8_STAGE(PG8_SA(0, 1), a2, w1);
            PG8_WAIT_V(8); PG8_WAIT_L(0); PG8_BAR; PG8_MMA(0, 0, At, B0); PG8_MMA(0, 1, At, B1); PG8_BAR; PG8_SCHED;
            PG8_LDA(At, 1, 1); PG8_STAGE(PG8_SB(1, 0), b3, voffB); PG8_STAGE(PG8_SB(1, 1), b3 + hstep, voffB); PG8_STAGE(PG8_SA(1, 0), a3, w0);
            PG8_WAIT_V(8); PG8_WAIT_L(0); PG8_BAR; PG8_MMA(1, 0, At, B0); PG8_MMA(1, 1, At, B1); PG8_BAR; PG8_SCHED;
        }
        if constexpr (ALIGN_EPI) { if (wr == 0) PG8_BAR; }
        if constexpr (F8) asm volatile("s_nop 15\n\ts_nop 7" ::: "memory");
        E(acc, cur, wr, wc, fr, fq);
        if (!has_next) break;
#pragma unroll
        for (int a = 0; a < 2; ++a)
#pragma unroll
            for (int b = 0; b < 2; ++b)
#pragma unroll
                for (int m = 0; m < 4; ++m)
#pragma unroll
                    for (int n = 0; n < 2; ++n) acc[a][b][m][n] = (f32x4){0.f, 0.f, 0.f, 0.f};
        cur = nxt; cA = nA; cB = nB; ++ui;
#pragma unroll
        for (int h = 0; h < 2; ++h)
#pragma unroll
            for (int i = 0; i < 2; ++i) vA[h][i] = vN[h][i];
        if constexpr (ALIGN_EPI) { if (wr == 1) PG8_BAR; }
    }
    PG8_WAIT_V(0);
    if constexpr (!ALIGN_EPI) { if (wr == 0) PG8_BAR; }
    PG8_BAR;
#undef PG8_SA
#undef PG8_SB
#undef PG8_STAGE
#undef PG8_LDA
#undef PG8_LDB
#undef PG8_MMA
#undef PG8_CAT
#undef PG8_WAIT_V
#undef PG8_WAIT_L
#undef PG8_BAR
#undef PG8_SCHED
#undef PG8_MKOFF
}

struct SchedPlain {
    const char* A; const char* B; int nM, nN, nwg, G, c; size_t tstep;
    __device__ __forceinline__ SchedPlain(const void* A_, const void* B_, int M, int N, int K, int G_, int c_) : A((const char*)A_), B((const char*)B_), nM(M / BM), nN(N / BM), nwg((M / BM) * (N / BM)), G(G_), c(c_), tstep((size_t)BM * K * 2) {}
    __device__ __forceinline__ bool next(int i, Unit& u) const {
        const int L = i * G + c; if (L >= nwg) return false;
        const int wgid = xcd_remap(L, nwg);
        const int nig = WGM * nN, gid = wgid / nig, fm = gid * WGM, gsz = (nM - fm) < WGM ? (nM - fm) : WGM;
        u.pm = fm + ((wgid % nig) % gsz); u.pn = (wgid % nig) / gsz; u.e = 0; u.aux = 0;
        u.A = A + (size_t)u.pm * tstep; u.B = B + (size_t)u.pn * tstep; return true;
    }
    __device__ __forceinline__ int row(const Unit&, int r) const { return r; }
};
}

struct RowIdent { int base; __device__ __forceinline__ int operator()(int r) const { return base + r; } };

template <bool PERM_> struct EpiProj {
  static constexpr bool PERM = PERM_;
  unsigned char* ws; int pn_base;
  __device__ __forceinline__ void operator()(const f32x4 (&acc)[2][2][4][2], const pg8::Unit& u, int wr, int wc, int fr, int fq) const {
    const int pm = u.pm, pn = u.pn + pn_base;
    bf16_t* dst; int ld, cb; float* ssq = nullptr; int nss = 0, sidx = 0; int climit = 256; float osc = 1.0f;
    if (pn < 3) { dst = (bf16_t*)(ws + R_QLAT); ld = 768; cb = 256 * pn; ssq = (float*)(ws + WS_SSQ); nss = 12; sidx = 4 * pn + wc; }
    else if (pn < 5) { dst = (bf16_t*)(ws + R_KVLAT); ld = 512; cb = 256 * (pn - 3); ssq = (float*)(ws + WS_SSQ + 512 * 1024); nss = 8; sidx = 4 * (pn - 3) + wc; }
    else if (pn == 5) { dst = (bf16_t*)(ws + R_KPE); ld = 64; cb = 0; climit = 64; }
    else if (pn < 10) { dst = (bf16_t*)(ws + R_DQ); ld = 1024; cb = 256 * (pn - 6); osc = 0.125f * 1.4426950408889634f; }
    else if (pn < 14) { dst = (bf16_t*)(ws + R_DK); ld = 1024; cb = 256 * (pn - 10); }
    else { dst = (bf16_t*)(ws + R_DV); ld = 1024; cb = 256 * (pn - 14); }
#pragma unroll
    for (int ai = 0; ai < 2; ++ai)
#pragma unroll
      for (int m = 0; m < 4; ++m) {
        const int row = 256 * pm + acc_row(ai, wr, m, fr); float ss = 0.f;
#pragma unroll
        for (int bj = 0; bj < 2; ++bj) {
#pragma unroll
          for (int n = 0; n < 2; ++n) {
            const f32x4 v = acc[ai][bj][m][n];
            ss += v.x * v.x + v.y * v.y + v.z * v.z + v.w * v.w;
            if (!PERM) { const int c0 = acc_col<PERM>(bj, wc, n, fq); if (c0 < climit) { u32x2 o; o.x = cvtpk2(v.x * osc, v.y * osc); o.y = cvtpk2(v.z * osc, v.w * osc); *(u32x2*)(dst + (size_t)row * ld + cb + c0) = o; } }
          }
          if (PERM) { const int c0 = acc_col<PERM>(bj, wc, 0, fq); if (c0 < climit) *(u32x4*)(dst + (size_t)row * ld + cb + c0) = pack8(acc[ai][bj][m][0] * osc, acc[ai][bj][m][1] * osc); }
        }
        if (ssq) { ss += __shfl_xor(ss, 16); ss += __shfl_xor(ss, 32); if (fq == 0) ssq[(size_t)row * nss + sidx] = ss; }
      }
  }
};

template <bool PERM_> struct EpiRowScale {
  static constexpr bool PERM = PERM_;
  bf16_t* dst; int ld; const float* ssq; int nss; float invk; float post;
  __device__ __forceinline__ void operator()(const f32x4 (&acc)[2][2][4][2], const pg8::Unit& u, int wr, int wc, int fr, int fq) const {
    const int pm = u.pm, pn = u.pn;
#pragma unroll
    for (int ai = 0; ai < 2; ++ai)
#pragma unroll
      for (int m = 0; m < 4; ++m) {
        const int row = 256 * pm + acc_row(ai, wr, m, fr); float ss = 0.f;
        for (int i = 0; i < nss; ++i) ss += ssq[(size_t)row * nss + i];
        const float rstd = post / sqrtf(ss * invk + EPS);
#pragma unroll
        for (int bj = 0; bj < 2; ++bj) {
          if (PERM) *(u32x4*)(dst + (size_t)row * ld + 256 * pn + acc_col<PERM>(bj, wc, 0, fq)) = pack8(acc[ai][bj][m][0] * rstd, acc[ai][bj][m][1] * rstd);
          else {
#pragma unroll
            for (int n = 0; n < 2; ++n) {
              const f32x4 v = acc[ai][bj][m][n] * rstd; const int c0 = acc_col<PERM>(bj, wc, n, fq);
              u32x2 o; o.x = cvtpk2(v.x, v.y); o.y = cvtpk2(v.z, v.w); *(u32x2*)(dst + (size_t)row * ld + 256 * pn + c0) = o;
            }
          }
        }
      }
  }
};

template <bool PERM_> struct EpiF32 {
  static constexpr bool PERM = PERM_;
  float* dst; int ld;
  __device__ __forceinline__ void operator()(const f32x4 (&acc)[2][2][4][2], const pg8::Unit& u, int wr, int wc, int fr, int fq) const {
    const int pm = u.pm, pn = u.pn;
#pragma unroll
    for (int ai = 0; ai < 2; ++ai)
#pragma unroll
      for (int m = 0; m < 4; ++m) {
        const int row = 256 * pm + acc_row(ai, wr, m, fr);
#pragma unroll
        for (int bj = 0; bj < 2; ++bj)
#pragma unroll
          for (int n = 0; n < 2; ++n) *(f32x4*)(dst + (size_t)row * ld + 256 * pn + acc_col<PERM>(bj, wc, n, fq)) = acc[ai][bj][m][n];
      }
  }
};

template <bool PERM_> struct EpiBf16 {
  static constexpr bool PERM = PERM_;
  bf16_t* dst; int ld;
  __device__ __forceinline__ void operator()(const f32x4 (&acc)[2][2][4][2], const pg8::Unit& u, int wr, int wc, int fr, int fq) const {
    const int pm = u.pm, pn = u.pn;
#pragma unroll
    for (int ai = 0; ai < 2; ++ai)
#pragma unroll
      for (int m = 0; m < 4; ++m) {
        const int row = 256 * pm + acc_row(ai, wr, m, fr);
#pragma unroll
        for (int bj = 0; bj < 2; ++bj) {
          if (PERM) *(u32x4*)(dst + (size_t)row * ld + 256 * pn + acc_col<PERM>(bj, wc, 0, fq)) = pack8(acc[ai][bj][m][0], acc[ai][bj][m][1]);
          else {
#pragma unroll
            for (int n = 0; n < 2; ++n) { const f32x4 v = acc[ai][bj][m][n]; u32x2 o; o.x = cvtpk2(v.x, v.y); o.y = cvtpk2(v.z, v.w); *(u32x2*)(dst + (size_t)row * ld + 256 * pn + acc_col<PERM>(bj, wc, n, fq)) = o; }
          }
        }
      }
  }
};

template <bool PERM_> struct EpiSwiglu {
  static constexpr bool PERM = PERM_;
  bf16_t* act; float insc;
  __device__ __forceinline__ void operator()(const f32x4 (&acc)[2][2][4][2], const pg8::Unit& u, int wr, int wc, int fr, int fq) const {
    const int arow0 = 256 * u.pm, pn = u.pn;
#pragma unroll
    for (int ai = 0; ai < 2; ++ai)
#pragma unroll
      for (int m = 0; m < 4; ++m) {
        const int row = arow0 + acc_row(ai, wr, m, fr);
        f32x4 av[2];
#pragma unroll
        for (int n = 0; n < 2; ++n) {
          const f32x4 g = acc[ai][0][m][n] * insc, u = acc[ai][1][m][n] * insc; f32x4 a;
          a.x = g.x / (1.f + __expf(-g.x)) * u.x; a.y = g.y / (1.f + __expf(-g.y)) * u.y; a.z = g.z / (1.f + __expf(-g.z)) * u.z; a.w = g.w / (1.f + __expf(-g.w)) * u.w;
          av[n] = a;
          if (!PERM) *(unsigned*)((unsigned char*)act + (size_t)row * 512 + 128 * pn + acc_col<PERM>(0, wc, n, fq)) = pack8_fp8(a, a).x;
        }
        if (PERM) *(u32x2*)((unsigned char*)act + (size_t)row * 512 + 128 * pn + acc_col<PERM>(0, wc, 0, fq)) = pack8_fp8(av[0], av[1]);
      }
  }
};

template <bool PERM_> struct EpiRowsFp8 {
  static constexpr bool PERM = PERM_;
  unsigned char* yp; float insc;
  __device__ __forceinline__ void operator()(const f32x4 (&acc)[2][2][4][2], const pg8::Unit& u, int wr, int wc, int fr, int fq) const {
    const int pn = u.pn;
#pragma unroll
    for (int ai = 0; ai < 2; ++ai)
#pragma unroll
      for (int m = 0; m < 4; ++m) {
        const size_t row = (size_t)256 * u.pm + acc_row(ai, wr, m, fr);
#pragma unroll
        for (int bj = 0; bj < 2; ++bj) {
          if (PERM) *(u32x2*)(yp + row * 2048 + 256 * pn + acc_col<PERM>(bj, wc, 0, fq)) = pack8_fp8(acc[ai][bj][m][0] * insc, acc[ai][bj][m][1] * insc);
          else {
#pragma unroll
            for (int n = 0; n < 2; ++n) { const f32x4 v = acc[ai][bj][m][n] * insc; const u32x2 o = pack8_fp8(v, v); *(unsigned*)(yp + row * 2048 + 256 * pn + acc_col<PERM>(bj, wc, n, fq)) = o.x; }
          }
        }
      }
  }
};

__device__ __forceinline__ void rotary_rows(const Params& p) {
  const int tid = opaque_tid(), lane = tid & 63, wave = tid >> 6;
  const int gw = blockIdx.x * NWAVES + wave, NGW = gridDim.x * NWAVES;
  unsigned char* ws = p.ws;
  bf16_t* dq = (bf16_t*)(ws + R_DQ); bf16_t* dk = (bf16_t*)(ws + R_DK); bf16_t* kpe = (bf16_t*)(ws + R_KPE);
  const f32x2* rd = (const f32x2*)(ws + WS_ROPED); const f32x2* rm = (const f32x2*)(ws + WS_ROPEM);
  for (int row = gw; row < T; row += NGW) {
#pragma unroll
    for (int h = 0; h < 2; ++h) {
      const int pr = lane + 64 * h, comp = pr >> 3, i = pr & 7;
      const f32x2 cs = rd[row * 8 + i];
      const size_t i1 = (size_t)row * 1024 + comp * 64 + i, i2 = i1 + 8;
      { const float x1 = bf1(dq[i1]), x2 = bf1(dq[i2]); dq[i1] = (bf16_t)f2bf(x1 * cs.x - x2 * cs.y); dq[i2] = (bf16_t)f2bf(x2 * cs.x + x1 * cs.y); }
      { const float x1 = bf1(dk[i1]), x2 = bf1(dk[i2]); dk[i1] = (bf16_t)f2bf(x1 * cs.x - x2 * cs.y); dk[i2] = (bf16_t)f2bf(x2 * cs.x + x1 * cs.y); }
    }
    if (lane < 32) {
      const f32x2 cs = rm[row * 32 + lane];
      const size_t i1 = (size_t)row * 64 + lane, i2 = i1 + 32;
      const float x1 = bf1(kpe[i1]), x2 = bf1(kpe[i2]); kpe[i1] = (bf16_t)f2bf(x1 * cs.x - x2 * cs.y); kpe[i2] = (bf16_t)f2bf(x2 * cs.x + x1 * cs.y);
    }
  }
}

__device__ __forceinline__ void attn_mla_naive(const Params& p, int h, int ci, int vq, int lane) {
  unsigned char* ws = p.ws;
  const bf16_t* qm = (const bf16_t*)(ws + R_QM); const bf16_t* kvm = (const bf16_t*)(ws + R_KVM); const bf16_t* kpe = (const bf16_t*)(ws + R_KPE);
  const f32x2* rm = (const f32x2*)(ws + WS_ROPEM);
  const int t = 64 * ci + lane;
  unsigned qn[64], qp[32];
  { const u32x4* q4 = (const u32x4*)(qm + (size_t)t * NQ + 192 * h);
#pragma unroll
    for (int i = 0; i < 16; ++i) { const u32x4 v = q4[i]; qn[4 * i] = v.x; qn[4 * i + 1] = v.y; qn[4 * i + 2] = v.z; qn[4 * i + 3] = v.w; }
#pragma unroll
    for (int i = 0; i < 8; ++i) { const u32x4 v = q4[16 + i]; qp[4 * i] = v.x; qp[4 * i + 1] = v.y; qp[4 * i + 2] = v.z; qp[4 * i + 3] = v.w; }
#pragma unroll
    for (int w = 0; w < 16; ++w) {
      const f32x2 c0 = rm[t * 32 + 2 * w], c1 = rm[t * 32 + 2 * w + 1];
      const float a0 = bf_lo(qp[w]), a1 = bf_hi(qp[w]), b0 = bf_lo(qp[w + 16]), b1 = bf_hi(qp[w + 16]);
      qp[w] = pk2(a0 * c0.x - b0 * c0.y, a1 * c1.x - b1 * c1.y);
      qp[w + 16] = pk2(b0 * c0.x + a0 * c0.y, b1 * c1.x + a1 * c1.y);
    }
  }
  const float scale = 0.07216878364870322f;
  float mx = -INFINITY, l = 0.f, o[32];
#pragma unroll
  for (int j = 0; j < 32; ++j) o[j] = 0.f;
  const int nk = 64 * (ci + 1);
  for (int key = 0; key < nk; ++key) {
    const u32x4* k4 = (const u32x4*)(kvm + (size_t)key * NKV + 256 * h);
    const u32x4* p4 = (const u32x4*)(kpe + (size_t)key * 64);
    float s = 0.f;
#pragma unroll
    for (int i = 0; i < 16; ++i) { const u32x4 v = k4[i]; s = dot2bf(qn[4 * i], v.x, s); s = dot2bf(qn[4 * i + 1], v.y, s); s = dot2bf(qn[4 * i + 2], v.z, s); s = dot2bf(qn[4 * i + 3], v.w, s); }
#pragma unroll
    for (int i = 0; i < 8; ++i) { const u32x4 v = p4[i]; s = dot2bf(qp[4 * i], v.x, s); s = dot2bf(qp[4 * i + 1], v.y, s); s = dot2bf(qp[4 * i + 2], v.z, s); s = dot2bf(qp[4 * i + 3], v.w, s); }
    s *= scale;
    if (s > mx) { const float f = __expf(mx - s); l *= f;
#pragma unroll
      for (int j = 0; j < 32; ++j) o[j] *= f;
      mx = s; }
    const float pe = __expf(s - mx); l += pe;
    const u32x4* v4 = (const u32x4*)(kvm + (size_t)key * NKV + 256 * h + 128 + 32 * vq);
#pragma unroll
    for (int i = 0; i < 4; ++i) { const u32x4 v = v4[i];
      o[8 * i] += pe * bf_lo(v.x); o[8 * i + 1] += pe * bf_hi(v.x); o[8 * i + 2] += pe * bf_lo(v.y); o[8 * i + 3] += pe * bf_hi(v.y);
      o[8 * i + 4] += pe * bf_lo(v.z); o[8 * i + 5] += pe * bf_hi(v.z); o[8 * i + 6] += pe * bf_lo(v.w); o[8 * i + 7] += pe * bf_hi(v.w); }
  }
  const float il = 1.0f / l;
  bf16_t* oa = (bf16_t*)(ws + R_OATT) + (size_t)t * 2048 + 128 * h + 32 * vq;
#pragma unroll
  for (int i = 0; i < 4; ++i) { u32x4 w; w.x = pk2(o[8 * i] * il, o[8 * i + 1] * il); w.y = pk2(o[8 * i + 2] * il, o[8 * i + 3] * il); w.z = pk2(o[8 * i + 4] * il, o[8 * i + 5] * il); w.w = pk2(o[8 * i + 6] * il, o[8 * i + 7] * il);
    ((u32x4*)oa)[i] = w; }
}
__device__ __forceinline__ void attn_diff_naive(const Params& p, int h, int c, int ci, int vh, int lane) {
  unsigned char* ws = p.ws;
  const bf16_t* dq = (const bf16_t*)(ws + R_DQ); const bf16_t* dk = (const bf16_t*)(ws + R_DK); const bf16_t* dv = (const bf16_t*)(ws + R_DV);
  const int t = 64 * ci + lane;
  unsigned q[32];
  { const u32x4* q4 = (const u32x4*)(dq + (size_t)t * 1024 + 128 * h + 64 * c);
#pragma unroll
    for (int i = 0; i < 8; ++i) { const u32x4 v = q4[i]; q[4 * i] = v.x; q[4 * i + 1] = v.y; q[4 * i + 2] = v.z; q[4 * i + 3] = v.w; } }
  const float scale = 0.125f;
  float mx = -INFINITY, l = 0.f, o[64];
#pragma unroll
  for (int j = 0; j < 64; ++j) o[j] = 0.f;
  const int nk = 64 * (ci + 1);
  for (int key = 0; key < nk; ++key) {
    const u32x4* k4 = (const u32x4*)(dk + (size_t)key * 1024 + 128 * h + 64 * c);
    float s = 0.f;
#pragma unroll
    for (int i = 0; i < 8; ++i) { const u32x4 v = k4[i]; s = dot2bf(q[4 * i], v.x, s); s = dot2bf(q[4 * i + 1], v.y, s); s = dot2bf(q[4 * i + 2], v.z, s); s = dot2bf(q[4 * i + 3], v.w, s); }
    s *= scale;
    if (s > mx) { const float f = __expf(mx - s); l *= f;
#pragma unroll
      for (int j = 0; j < 64; ++j) o[j] *= f;
      mx = s; }
    const float pe = __expf(s - mx); l += pe;
    const u32x4* v4 = (const u32x4*)(dv + (size_t)key * 1024 + 128 * h + 64 * vh);
#pragma unroll
    for (int i = 0; i < 8; ++i) { const u32x4 v = v4[i];
      o[8 * i] += pe * bf_lo(v.x); o[8 * i + 1] += pe * bf_hi(v.x); o[8 * i + 2] += pe * bf_lo(v.y); o[8 * i + 3] += pe * bf_hi(v.y);
      o[8 * i + 4] += pe * bf_lo(v.z); o[8 * i + 5] += pe * bf_hi(v.z); o[8 * i + 6] += pe * bf_lo(v.w); o[8 * i + 7] += pe * bf_hi(v.w); }
  }
  const float il = 1.0f / l;
  float* oc = (float*)(ws + R_OC) + (size_t)c * T * 1024 + (size_t)t * 1024 + 128 * h + 64 * vh;
#pragma unroll
  for (int i = 0; i < 16; ++i) ((f32x4*)oc)[i] = (f32x4){o[4 * i] * il, o[4 * i + 1] * il, o[4 * i + 2] * il, o[4 * i + 3] * il};
}
__device__ __forceinline__ void phase3_naive(const Params& p) {
  const int tid = opaque_tid(), lane = tid & 63, wave = tid >> 6;
  const int gw = blockIdx.x * NWAVES + wave, NGW = gridDim.x * NWAVES;
  for (int u = gw; u < 4096; u += NGW) {
    const int uu = (u < 2048) ? u : (6143 - u);
    const int ci = uu & 127, hv = uu >> 7;
    attn_mla_naive(p, hv >> 2, ci, hv & 3, lane);
  }
  for (int u = gw; u < 4096; u += NGW) {
    const int uu = (u < 2048) ? u : (6143 - u);
    const int ci = uu & 127, r = uu >> 7;
    attn_diff_naive(p, r >> 2, (r >> 1) & 1, ci, r & 1, lane);
  }
}
__device__ __forceinline__ void phase3b_naive(const Params& p) {
  const int tid = opaque_tid(), lane = tid & 63, wave = tid >> 6;
  const int gw = blockIdx.x * NWAVES + wave, NGW = gridDim.x * NWAVES;
  unsigned char* ws = p.ws;
  const float lam = ((const float*)(ws + WS_MOD))[16384];
  const float* oc0 = (const float*)(ws + R_OC); const float* oc1 = oc0 + (size_t)T * 1024;
  const float* gsub = p.in[14];
  bf16_t* oa = (bf16_t*)(ws + R_OATT);
  for (int it = gw; it < T * 8; it += NGW) {
    const int t = it >> 3, h = it & 7;
    const size_t off = (size_t)t * 1024 + 128 * h + 2 * lane;
    const f32x2 a = *(const f32x2*)(oc0 + off), b = *(const f32x2*)(oc1 + off);
    const float v0 = a.x - lam * b.x, v1 = a.y - lam * b.y;
    const float rstd = 1.0f / sqrtf(wave_sum(v0 * v0 + v1 * v1) * (1.0f / 128.0f) + EPS);
    const f32x2 g = *(const f32x2*)(gsub + 2 * lane);
    *(unsigned*)(oa + (size_t)t * 2048 + 1024 + 128 * h + 2 * lane) = pk2(v0 * rstd * g.x * 0.8f, v1 * rstd * g.y * 0.8f);
  }
}


namespace fa {
typedef float f32x16 __attribute__((ext_vector_type(16)));
typedef short v4i16_t __attribute__((ext_vector_type(4)));
constexpr int VBYTES = 16384, WSF_OFF = 122880;
constexpr float THR = 8.0f;
__device__ __forceinline__ int crow(int r, int hi) { return (r & 3) + 8 * (r >> 2) + 4 * hi; }
__device__ __forceinline__ unsigned cvtpk(float lo, float hi) { f32x2 v = {lo, hi}; bf16x2_t b = __builtin_convertvector(v, bf16x2_t); return __builtin_bit_cast(unsigned, b); }
__device__ __forceinline__ void glds16(const void* gsrc, unsigned lds_dst) { unsigned keep;
  asm volatile("s_mov_b32 %0, m0\n\ts_mov_b32 m0, %2\n\ts_nop 0\n\tglobal_load_lds_dwordx4 %1, off\n\ts_mov_b32 m0, %0" : "=&s"(keep) : "v"(gsrc), "s"(lds_dst) : "memory"); }
__device__ __forceinline__ float max3f(float a, float b, float c) { float r; asm("v_max3_f32 %0, %1, %2, %3" : "=v"(r) : "v"(a), "v"(b), "v"(c)); return r; }
__device__ __forceinline__ float max2f(float a, float b) { float r; asm("v_max_f32_e32 %0, %1, %2" : "=v"(r) : "v"(a), "v"(b)); return r; }
struct Src { const char* kb0; unsigned kp0; const char* kb1; unsigned kp1; const char* vb; unsigned vp; };

template <int NKC  >
__device__ __forceinline__ void attn_pass(LAS unsigned char* lds, const Src& S, const bf16x8* qf, const float qscale, const int NT, const int NTW, f32x16 (&o)[4], float& l_out) {
  constexpr int NKS = NKC * 4, KBYTES = NKC * 8192, STAGE = KBYTES + VBYTES;
  const int tid = opaque_tid(), lane = tid & 63, wid = __builtin_amdgcn_readfirstlane(tid >> 6), r32 = lane & 31, hi = lane >> 5;
  unsigned koff[NKC], voff[2]; unsigned kdst[NKC], vdst[2];
#pragma unroll
  for (int i = 0; i < NKC; ++i) {
    if (NKC == 3 && i == 2) { koff[i] = (unsigned)lane * S.kp1 + (unsigned)wid * 16u; kdst[i] = (unsigned)(16 + wid) * 1024u; }
    else { koff[i] = (unsigned)lane * S.kp0 + (unsigned)(wid + 8 * i) * 16u; kdst[i] = (unsigned)(wid + 8 * i) * 1024u; }
  }
#pragma unroll
  for (int i = 0; i < 2; ++i) { const int ii = 2 * wid + i, b = ii >> 2, kg = ii & 3; voff[i] = (unsigned)(16 * kg + (lane >> 2)) * S.vp + (unsigned)(32 * b + 8 * (lane & 3)) * 2u; vdst[i] = (unsigned)KBYTES + (unsigned)b * 4096u + (unsigned)kg * 1024u; }
#define FA_ISSUE(j, st) do { const size_t _j = (size_t)(j) * 64; const unsigned _so = (unsigned)(st) * STAGE; \
    _Pragma("unroll") for (int _i = 0; _i < NKC; ++_i) { const char* _b = (NKC == 3 && _i == 2) ? S.kb1 + _j * S.kp1 : S.kb0 + _j * S.kp0; \
      __builtin_amdgcn_global_load_lds((const unsigned*)(_b + koff[_i]), (LAS unsigned*)(lds + _so + kdst[_i]), 16, 0, 0); } \
    _Pragma("unroll") for (int _i = 0; _i < 2; ++_i) __builtin_amdgcn_global_load_lds((const unsigned*)(S.vb + _j * S.vp + voff[_i]), (LAS unsigned*)(lds + _so + vdst[_i]), 16, 0, 0); } while (0)
  LAS float* wsf = (LAS float*)(lds + WSF_OFF) + wid * 64;
  float m_ref = -INFINITY, l_part = 0.f;
#pragma unroll
  for (int b = 0; b < 4; ++b)
#pragma unroll
    for (int r = 0; r < 16; ++r) o[b][r] = 0.f;
  const unsigned kread = (unsigned)hi * 1024u + (unsigned)r32 * 16u;
  const unsigned vread = (unsigned)KBYTES + (unsigned)(((lane >> 4) & 1) * 32 + (lane & 3) * 8 + (4 * hi + ((lane & 15) >> 2)) * 64);
  FA_ISSUE(0, 0);
  if (NT > 1) FA_ISSUE(1, 1);
  int st = 0;
  for (int j = 0; j < NT; ++j) {
    if (j + 1 < NT) { if (NKC == 3) asm volatile("s_waitcnt vmcnt(5)" ::: "memory"); else asm volatile("s_waitcnt vmcnt(3)" ::: "memory"); }
    else asm volatile("s_waitcnt vmcnt(0)" ::: "memory");
    asm volatile("s_waitcnt lgkmcnt(0)\n\ts_barrier" ::: "memory");
    if (j + 2 < NT) { const int st2 = (st + 2 >= 3) ? st - 1 : st + 2; FA_ISSUE(j + 2, st2); }
    if (j < NTW) {
      const LAS unsigned char* kb = lds + (unsigned)st * STAGE + kread;
      f32x16 p0, p1;
#pragma unroll
      for (int r = 0; r < 16; ++r) { p0[r] = 0.f; p1[r] = 0.f; }
#pragma unroll
      for (int d0 = 0; d0 < NKS; ++d0) {
        const bf16x8 k0 = *(const LAS bf16x8*)(kb + d0 * 2048);
        const bf16x8 k1 = *(const LAS bf16x8*)(kb + d0 * 2048 + 512);
        p0 = __builtin_amdgcn_mfma_f32_32x32x16_bf16(k0, qf[d0], p0, 0, 0, 0);
        p1 = __builtin_amdgcn_mfma_f32_32x32x16_bf16(k1, qf[d0], p1, 0, 0, 0);
      }
      float rm = __builtin_fmaxf(p0[0], p1[0]);
#pragma unroll
      for (int r = 1; r < 16; ++r) rm = __builtin_fmaxf(rm, __builtin_fmaxf(p0[r], p1[r]));
      { auto rr = __builtin_amdgcn_permlane32_swap(__float_as_uint(rm), __float_as_uint(rm), false, false); rm = __builtin_fmaxf(__uint_as_float(rr[0]), __uint_as_float(rr[1])); }
      rm *= qscale;
      if (__any(rm > m_ref + THR)) {
        const float m_new = __builtin_fmaxf(m_ref, rm);
        const float alpha = __builtin_amdgcn_exp2f(m_ref - m_new);
        l_part *= alpha; m_ref = m_new;
        if (hi == 0) wsf[r32] = alpha;
        asm volatile("s_waitcnt lgkmcnt(0)" ::: "memory");
#pragma unroll
        for (int r = 0; r < 16; ++r) { const float a = wsf[crow(r, hi)];
#pragma unroll
          for (int b = 0; b < 4; ++b) o[b][r] *= a; }
      }
      float ls = 0.f;
#pragma unroll
      for (int r = 0; r < 16; ++r) { p0[r] = __builtin_amdgcn_exp2f(p0[r] * qscale - m_ref); p1[r] = __builtin_amdgcn_exp2f(p1[r] * qscale - m_ref); ls += p0[r] + p1[r]; }
      l_part += ls;
      u32x4 pw[4];
      pw[0] = (u32x4){cvtpk(p0[0], p0[1]), cvtpk(p0[2], p0[3]), cvtpk(p0[4], p0[5]), cvtpk(p0[6], p0[7])};
      pw[1] = (u32x4){cvtpk(p0[8], p0[9]), cvtpk(p0[10], p0[11]), cvtpk(p0[12], p0[13]), cvtpk(p0[14], p0[15])};
      pw[2] = (u32x4){cvtpk(p1[0], p1[1]), cvtpk(p1[2], p1[3]), cvtpk(p1[4], p1[5]), cvtpk(p1[6], p1[7])};
      pw[3] = (u32x4){cvtpk(p1[8], p1[9]), cvtpk(p1[10], p1[11]), cvtpk(p1[12], p1[13]), cvtpk(p1[14], p1[15])};
      const LAS unsigned char* vbp = lds + (unsigned)st * STAGE + vread;
#pragma unroll
      for (int ks = 0; ks < 4; ++ks)
#pragma unroll
        for (int b = 0; b < 4; ++b) {
          const v4i16_t lo = __builtin_amdgcn_ds_read_tr16_b64_v4i16((LAS v4i16_t*)(vbp + b * 4096 + ks * 1024));
          const v4i16_t hh = __builtin_amdgcn_ds_read_tr16_b64_v4i16((LAS v4i16_t*)(vbp + b * 4096 + ks * 1024 + 512));
          const bf16x8 vf = (bf16x8){lo[0], lo[1], lo[2], lo[3], hh[0], hh[1], hh[2], hh[3]};
          o[b] = __builtin_amdgcn_mfma_f32_32x32x16_bf16(__builtin_bit_cast(bf16x8, pw[ks]), vf, o[b], 0, 0, 0);
        }
    }
    st = (st == 2) ? 0 : st + 1;
  }
  asm volatile("s_waitcnt lgkmcnt(0)\n\ts_barrier" ::: "memory");
  { auto rr = __builtin_amdgcn_permlane32_swap(__float_as_uint(l_part), __float_as_uint(l_part), false, false); l_out = __uint_as_float(rr[0]) + __uint_as_float(rr[1]); }
#undef FA_ISSUE
}


template <int NKC>
__device__ __forceinline__ void attn_pass3(LAS unsigned char* lds, const Src& S, const bf16x8* qf, const float qscale, const int NT, const int NTW, f32x16 (&o)[4], float& l_out) {
  constexpr int NKS = NKC * 4, KBYTES = NKC * 8192, STAGE = KBYTES + VBYTES;
  const int tid = opaque_tid(), lane = tid & 63, wid = __builtin_amdgcn_readfirstlane(tid >> 6), r32 = lane & 31, hi = lane >> 5;
  unsigned koff[NKC], voff[2]; unsigned kdst[NKC], vdst[2];
#pragma unroll
  for (int i = 0; i < NKC; ++i) {
    if (NKC == 3 && i < 2) { const int pi = wid + 8 * i, row = 4 * pi + (lane >> 4); koff[i] = (unsigned)row * S.kp0 + (unsigned)(((lane & 15) ^ (row & 15)) * 16); kdst[i] = (unsigned)pi * 1024u; }
    else { const int row = 8 * wid + (lane >> 3); const unsigned kp = (NKC == 3) ? S.kp1 : S.kp0; koff[i] = (unsigned)row * kp + (unsigned)(((lane & 7) ^ ((row >> 1) & 7)) * 16); kdst[i] = (NKC == 3 ? 16384u : 0u) + (unsigned)wid * 1024u; }
  }
#pragma unroll
  for (int i = 0; i < 2; ++i) { const int ii = 2 * wid + i, b = ii >> 2, kg = ii & 3; voff[i] = (unsigned)(16 * kg + (lane >> 2)) * S.vp + (unsigned)(32 * b + 8 * (lane & 3)) * 2u; vdst[i] = (unsigned)KBYTES + (unsigned)b * 4096u + (unsigned)kg * 1024u; }
#define FA_ISSUE(j, st) do { const size_t _j = (size_t)(j) * 64; const unsigned _so = lds0 + (unsigned)(st) * STAGE; \
    _Pragma("unroll") for (int _i = 0; _i < NKC; ++_i) { const char* _b = (NKC == 3 && _i == 2) ? S.kb1 + _j * S.kp1 : S.kb0 + _j * S.kp0; \
      glds16(_b + koff[_i], (unsigned)__builtin_amdgcn_readfirstlane(_so + kdst[_i])); } \
    _Pragma("unroll") for (int _i = 0; _i < 2; ++_i) glds16(S.vb + _j * S.vp + voff[_i], (unsigned)__builtin_amdgcn_readfirstlane(_so + vdst[_i])); } while (0)
#define FA_EXP8(P, base, PW) do { float _e[8]; _Pragma("unroll") for (int _i = 0; _i < 8; ++_i) { _e[_i] = __builtin_amdgcn_exp2f(P[(base) + _i]); } \
      l_part += ((_e[0] + _e[1]) + (_e[2] + _e[3])) + ((_e[4] + _e[5]) + (_e[6] + _e[7])); \
      PW = (u32x4){cvtpk(_e[0], _e[1]), cvtpk(_e[2], _e[3]), cvtpk(_e[4], _e[5]), cvtpk(_e[6], _e[7])}; } while (0)
#define FA_VRD1(L, H, va, off) asm volatile("ds_read_b64_tr_b16 %0, %2 offset:%c3\n\tds_read_b64_tr_b16 %1, %2 offset:%c4" : "=&v"(L), "=&v"(H) : "v"(va), "i"(off), "i"((off) + 512) : "memory")
#define FA_VRD8(VL, VH, va, ks0) do { _Pragma("unroll") for (int _b = 0; _b < 4; ++_b) { FA_VRD1(VL[_b], VH[_b], va, _b * 4096 + (ks0) * 1024); } \
      _Pragma("unroll") for (int _b = 0; _b < 4; ++_b) { FA_VRD1(VL[4 + _b], VH[4 + _b], va, _b * 4096 + ((ks0) + 1) * 1024); } } while (0)
#define FA_FRAG(VL, VH, i) (bf16x8){VL[i][0], VL[i][1], VL[i][2], VL[i][3], VH[i][0], VH[i][1], VH[i][2], VH[i][3]}
#define FA_PV8(PWA, PWB, VL, VH) do { _Pragma("unroll") for (int _b = 0; _b < 4; ++_b) o[_b] = __builtin_amdgcn_mfma_f32_32x32x16_bf16(__builtin_bit_cast(bf16x8, PWA), FA_FRAG(VL, VH, _b), o[_b], 0, 0, 0); \
      _Pragma("unroll") for (int _b = 0; _b < 4; ++_b) o[_b] = __builtin_amdgcn_mfma_f32_32x32x16_bf16(__builtin_bit_cast(bf16x8, PWB), FA_FRAG(VL, VH, 4 + _b), o[_b], 0, 0, 0); } while (0)
#define FA_PV(PW, vbp, ks) do { _Pragma("unroll") for (int _b = 0; _b < 4; ++_b) { \
      const v4i16_t lo = __builtin_amdgcn_ds_read_tr16_b64_v4i16((LAS v4i16_t*)((vbp) + _b * 4096 + (ks) * 1024)); \
      const v4i16_t hh = __builtin_amdgcn_ds_read_tr16_b64_v4i16((LAS v4i16_t*)((vbp) + _b * 4096 + (ks) * 1024 + 512)); \
      const bf16x8 vf = (bf16x8){lo[0], lo[1], lo[2], lo[3], hh[0], hh[1], hh[2], hh[3]}; \
      o[_b] = __builtin_amdgcn_mfma_f32_32x32x16_bf16(__builtin_bit_cast(bf16x8, PW), vf, o[_b], 0, 0, 0); } } while (0)
  const unsigned lds0 = (unsigned)(uintptr_t)lds;
  LAS float* wsf = (LAS float*)(lds + WSF_OFF) + wid * 64;
  float m_ref = 0.f, l_part = 0.f;
  f32x16 negm;
#pragma unroll
  for (int r = 0; r < 16; ++r) negm[r] = 0.f;
#pragma unroll
  for (int b = 0; b < 4; ++b)
#pragma unroll
    for (int r = 0; r < 16; ++r) o[b][r] = 0.f;
  const unsigned kread_n = (unsigned)r32 * 256u + (unsigned)(((r32 & 15) ^ hi) * 16);
  const unsigned kread_p = (NKC == 3 ? 16384u : 0u) + (unsigned)r32 * 128u + (unsigned)((((r32 >> 1) & 7) ^ hi) * 16);
  const unsigned vread = (unsigned)KBYTES + (unsigned)(((lane >> 4) & 1) * 32 + (lane & 3) * 8 + (4 * hi + ((lane & 15) >> 2)) * 64);
  constexpr int NST = (NKC == 1) ? 4 : 3;
  FA_ISSUE(0, 0);
  if (NT > 1) FA_ISSUE(1, 1);
  if (NST == 4 && NT > 2) FA_ISSUE(2, 2);
  int st = 0;
  for (int j = 0; j < NT; ++j) {
    if (NST == 4) { if (j + 2 < NT) asm volatile("s_waitcnt vmcnt(6)" ::: "memory"); else if (j + 1 < NT) asm volatile("s_waitcnt vmcnt(3)" ::: "memory"); else asm volatile("s_waitcnt vmcnt(0)" ::: "memory"); }
    else { if (j + 1 < NT) asm volatile("s_waitcnt vmcnt(5)" ::: "memory"); else asm volatile("s_waitcnt vmcnt(0)" ::: "memory"); }
    asm volatile("s_waitcnt lgkmcnt(0)\n\ts_barrier" ::: "memory");
    if (j + NST - 1 < NT) { const int st2 = (st == 0) ? NST - 1 : st - 1; FA_ISSUE(j + NST - 1, st2); }
    if (j < NTW) {
      const unsigned ksb = (unsigned)st * STAGE;
      f32x16 p0, p1;
#pragma unroll
      for (int d0 = 0; d0 < NKS; ++d0) {
        const bool nope = (NKC == 3) && d0 < 8;
        const unsigned ka = ksb + (nope ? (kread_n ^ (unsigned)(d0 * 32)) : (kread_p ^ (unsigned)((NKC == 3 ? d0 - 8 : d0) * 32)));
        const bf16x8 k0 = *(const LAS bf16x8*)(lds + ka);
        const bf16x8 k1 = *(const LAS bf16x8*)(lds + ka + (nope ? 8192u : 4096u));
        if (d0 == 0) { p0 = __builtin_amdgcn_mfma_f32_32x32x16_bf16(k0, qf[d0], negm, 0, 0, 0); p1 = __builtin_amdgcn_mfma_f32_32x32x16_bf16(k1, qf[d0], negm, 0, 0, 0); }
        else { p0 = __builtin_amdgcn_mfma_f32_32x32x16_bf16(k0, qf[d0], p0, 0, 0, 0); p1 = __builtin_amdgcn_mfma_f32_32x32x16_bf16(k1, qf[d0], p1, 0, 0, 0); }
      }
      __builtin_amdgcn_sched_group_barrier(0x100, 4, 0);
#pragma unroll
      for (int d0 = 0; d0 < NKS - 2; ++d0) { __builtin_amdgcn_sched_group_barrier(0x008, 2, 0); __builtin_amdgcn_sched_group_barrier(0x100, 2, 0); }
      __builtin_amdgcn_sched_group_barrier(0x008, 4, 0);
      __builtin_amdgcn_sched_barrier(0);
      asm volatile("s_nop 15\n\ts_nop 7" : "+v"(p0), "+v"(p1));
      float rm;
      { float a = max3f(p0[0], p0[1], p1[0]), b = max3f(p0[2], p0[3], p1[1]); a = max3f(a, p1[2], p1[3]);
#pragma unroll
        for (int r = 4; r < 16; r += 4) { a = max3f(a, p0[r], p0[r + 1]); b = max3f(b, p0[r + 2], p0[r + 3]); a = max3f(a, p1[r], p1[r + 1]); b = max3f(b, p1[r + 2], p1[r + 3]); }
        rm = max2f(a, b);
        auto rr = __builtin_amdgcn_permlane32_swap(__float_as_uint(rm), __float_as_uint(rm), false, false); rm = max2f(__uint_as_float(rr[0]), __uint_as_float(rr[1])); }
      if (__builtin_expect(j == 0 || __any(rm > THR), 0)) {
        const float dl = (j == 0) ? rm : __builtin_fmaxf(rm, 0.f);
        m_ref += dl;
#pragma unroll
        for (int r = 0; r < 16; ++r) { p0[r] -= dl; p1[r] -= dl; negm[r] = -m_ref; }
        const float alpha = __builtin_amdgcn_exp2f(-dl);
        l_part *= alpha;
        if (hi == 0) wsf[r32] = alpha;
        asm volatile("s_waitcnt lgkmcnt(0)" ::: "memory");
#pragma unroll
        for (int r = 0; r < 16; ++r) { const float a = wsf[crow(r, hi)];
#pragma unroll
          for (int b = 0; b < 4; ++b) o[b][r] *= a; }
      }
      const unsigned vaddr = lds0 + (unsigned)st * STAGE + vread;
      u32x4 pw0, pw1, pw2, pw3;
      if constexpr (NKC == 1) {
        v4i16_t vl[8], vh[8], wl[8], wh[8];
        FA_VRD8(vl, vh, vaddr, 0);
        FA_EXP8(p0, 0, pw0); FA_EXP8(p0, 8, pw1);
        asm volatile("s_waitcnt lgkmcnt(0)" ::: "memory"); __builtin_amdgcn_sched_barrier(0);
        FA_VRD8(wl, wh, vaddr, 2);
        __builtin_amdgcn_sched_barrier(0);
        FA_PV8(pw0, pw1, vl, vh);
        FA_EXP8(p1, 0, pw2); FA_EXP8(p1, 8, pw3);
#pragma unroll
        for (int q = 0; q < 8; ++q) { __builtin_amdgcn_sched_group_barrier(0x008, 1, 4); __builtin_amdgcn_sched_group_barrier(0x402, 6, 4); }
        asm volatile("s_waitcnt lgkmcnt(0)" ::: "memory"); __builtin_amdgcn_sched_barrier(0);
        FA_PV8(pw2, pw3, wl, wh);
        __builtin_amdgcn_sched_barrier(0);
      } else
      { v4i16_t vl[8], vh[8];
        FA_VRD8(vl, vh, vaddr, 0);
        FA_EXP8(p0, 0, pw0); FA_EXP8(p0, 8, pw1);
        asm volatile("s_waitcnt lgkmcnt(0)" ::: "memory"); __builtin_amdgcn_sched_barrier(0);
        FA_PV8(pw0, pw1, vl, vh);
        FA_EXP8(p1, 0, pw2); FA_EXP8(p1, 8, pw3);
#pragma unroll
        for (int q = 0; q < 8; ++q) { __builtin_amdgcn_sched_group_barrier(0x008, 1, 5); __builtin_amdgcn_sched_group_barrier(0x402, 6, 5); }
        __builtin_amdgcn_sched_barrier(0);
        FA_VRD8(vl, vh, vaddr, 2);
        asm volatile("s_waitcnt lgkmcnt(0)" ::: "memory"); __builtin_amdgcn_sched_barrier(0);
        FA_PV8(pw2, pw3, vl, vh);
        __builtin_amdgcn_sched_barrier(0);
      }
    }
    st = (st == NST - 1) ? 0 : st + 1;
  }
  asm volatile("s_waitcnt lgkmcnt(0)\n\ts_barrier" ::: "memory");
  { auto rr = __builtin_amdgcn_permlane32_swap(__float_as_uint(l_part), __float_as_uint(l_part), false, false); l_out = __uint_as_float(rr[0]) + __uint_as_float(rr[1]); }
#undef FA_ISSUE
#undef FA_EXP8
#undef FA_PV
#undef FA_VRD1
#undef FA_VRD8
#undef FA_FRAG
#undef FA_PV8
}

__device__ __forceinline__ void row_bcast(LAS float* wsf, float v, int r32, int hi, float (&out)[16]) {
  asm volatile("s_waitcnt lgkmcnt(0)" ::: "memory");
  if (hi == 0) wsf[r32] = v;
  asm volatile("s_waitcnt lgkmcnt(0)" ::: "memory");
#pragma unroll
  for (int r = 0; r < 16; ++r) out[r] = wsf[crow(r, hi)];
  asm volatile("s_waitcnt lgkmcnt(0)" ::: "memory");
}

__device__ __forceinline__ void mla_unit(const Params& p, LAS unsigned char* lds, int h, int qb) {
  unsigned char* ws = p.ws;
  const int tid = opaque_tid(), lane = tid & 63, wid = __builtin_amdgcn_readfirstlane(tid >> 6), r32 = lane & 31, hi = lane >> 5;
  const int t = 256 * qb + 32 * wid + r32;
  bf16x8 qf[12];
  { const bf16_t* q = (const bf16_t*)(ws + R_QM) + (size_t)t * NQ + 192 * h + 8 * hi;
#pragma unroll
    for (int d0 = 0; d0 < 12; ++d0) qf[d0] = *(const bf16x8*)(q + 16 * d0);
    const f32x2* rm = (const f32x2*)(ws + WS_ROPEM) + (size_t)t * 32;
#pragma unroll
    for (int s = 8; s < 10; ++s) {
      bf16x8 a = qf[s], b = qf[s + 2];
#pragma unroll
      for (int j = 0; j < 8; ++j) { const f32x2 cs = rm[16 * (s - 8) + 8 * hi + j];
        const float x1 = bf1((bf16_t)a[j]), x2 = bf1((bf16_t)b[j]);
        a[j] = (short)f2bf(x1 * cs.x - x2 * cs.y); b[j] = (short)f2bf(x2 * cs.x + x1 * cs.y); }
      qf[s] = a; qf[s + 2] = b;
    }
  }
  asm volatile("s_waitcnt vmcnt(0)" ::: "memory");
#pragma unroll
  for (int d0 = 0; d0 < 12; ++d0) asm volatile("" : "+v"(qf[d0]));
  Src S; S.kb0 = (const char*)(ws + R_KVM) + 256 * h * 2; S.kp0 = NKV * 2; S.kb1 = (const char*)(ws + R_KPE); S.kp1 = 128; S.vb = (const char*)(ws + R_KVM) + (256 * h + 128) * 2; S.vp = NKV * 2;
  f32x16 o[4]; float l;
  attn_pass3<3>(lds, S, qf, 1.0f, 4 * qb + 4, 4 * qb + 1 + (wid >> 1), o, l);
  LAS float* wsf = (LAS float*)(lds + WSF_OFF) + wid * 64;
  float il[16]; row_bcast(wsf, 1.0f / l, r32, hi, il);
  char* ob = (char*)((bf16_t*)(ws + R_OATT) + (size_t)(256 * qb + 32 * wid) * 2048 + 128 * h);
  const unsigned lo = (unsigned)(4 * hi * 2048 + r32) * 2u;
#pragma unroll
  for (int r = 0; r < 16; ++r)
#pragma unroll
    for (int b = 0; b < 4; ++b) *(bf16_t*)(ob + lo + (unsigned)((((r & 3) + 8 * (r >> 2)) * 2048 + 32 * b) * 2)) = (bf16_t)f2bf(o[b][r] * il[r]);
}

template <int C>
__device__ __forceinline__ void diff_comp(const Params& p, LAS unsigned char* lds, int h, int qb, f32x16 (&oacc)[4]) {
  unsigned char* ws = p.ws;
  const int tid = opaque_tid(), lane = tid & 63, wid = __builtin_amdgcn_readfirstlane(tid >> 6), r32 = lane & 31, hi = lane >> 5;
  const int t = 256 * qb + 32 * wid + r32;
  LAS float* wsf = (LAS float*)(lds + WSF_OFF) + wid * 64;
  bf16x8 qf[4];
  { const bf16_t* q = (const bf16_t*)(ws + R_DQ) + (size_t)t * 1024 + 128 * h + 64 * C + 8 * hi;
#pragma unroll
    for (int d0 = 0; d0 < 4; ++d0) qf[d0] = *(const bf16x8*)(q + 16 * d0); }
  asm volatile("s_waitcnt vmcnt(0)" ::: "memory");
#pragma unroll
  for (int d0 = 0; d0 < 4; ++d0) asm volatile("" : "+v"(qf[d0]));
  Src S; S.kb0 = (const char*)(ws + R_DK) + (128 * h + 64 * C) * 2; S.kp0 = 2048; S.kb1 = S.kb0; S.kp1 = 2048; S.vb = (const char*)(ws + R_DV) + 128 * h * 2; S.vp = 2048;
  f32x16 o[4]; float l;
  attn_pass3<1>(lds, S, qf, 1.0f, 4 * qb + 4, 4 * qb + 1 + (wid >> 1), o, l);
  const float lam = ((const float*)(ws + WS_MOD))[16384];
  float il[16]; row_bcast(wsf, (C == 0 ? 1.0f : -lam) / l, r32, hi, il);
  const char* park = (const char*)((float*)(ws + R_OC) + (size_t)(((h * 32 + qb) * 8 + wid)) * 4096);
  const unsigned pl = (unsigned)(opaque_tid() & 63) * 4u;
  if (C == 0) {
#pragma unroll
    for (int b = 0; b < 4; ++b) { const char* pb = park + b * 4096;
#pragma unroll
      for (int r = 0; r < 16; ++r) *(float*)(const_cast<char*>(pb) + pl + (unsigned)(r * 256)) = o[b][r] * il[r]; }
  } else {
#pragma unroll
    for (int b = 0; b < 4; ++b) { const char* pb = park + b * 4096;
#pragma unroll
      for (int r = 0; r < 16; ++r) oacc[b][r] = *(const float*)(pb + pl + (unsigned)(r * 256)) + o[b][r] * il[r]; }
  }
}

__device__ __forceinline__ void diff_unit(const Params& p, LAS unsigned char* lds, int h, int qb) {
  unsigned char* ws = p.ws;
  f32x16 oacc[4];
  diff_comp<0>(p, lds, h, qb, oacc);
  diff_comp<1>(p, lds, h, qb, oacc);
  const int tid = opaque_tid(), lane = tid & 63, wid = __builtin_amdgcn_readfirstlane(tid >> 6), r32 = lane & 31, hi = lane >> 5;
  const float* gsub = p.in[14];
  float g4[4];
#pragma unroll
  for (int b = 0; b < 4; ++b) g4[b] = gsub[32 * b + r32] * 0.8f;
  char* ob = (char*)((bf16_t*)(ws + R_OATT) + (size_t)(256 * qb + 32 * wid) * 2048 + 1024 + 128 * h);
  const unsigned lo = (unsigned)(4 * hi * 2048 + r32) * 2u;
#pragma unroll
  for (int r = 0; r < 16; ++r) {
    float ss = 0.f;
#pragma unroll
    for (int b = 0; b < 4; ++b) ss += oacc[b][r] * oacc[b][r];
    ss += __shfl_xor(ss, 1); ss += __shfl_xor(ss, 2); ss += __shfl_xor(ss, 4); ss += __shfl_xor(ss, 8); ss += __shfl_xor(ss, 16);
    const float rstd = 1.0f / sqrtf(ss * (1.0f / 128.0f) + EPS);
#pragma unroll
    for (int b = 0; b < 4; ++b) *(bf16_t*)(ob + lo + (unsigned)((((r & 3) + 8 * (r >> 2)) * 2048 + 32 * b) * 2)) = (bf16_t)f2bf(oacc[b][r] * rstd * g4[b]);
  }
}

struct AUnit { unsigned char kind, qb; };
struct AList { AUnit u[64]; };
constexpr AList make_alist() {
  AList L{}; int cost[64] = {}; int n = 0;
  for (int qb = 0; qb < 32; ++qb) { L.u[n].kind = 0; L.u[n].qb = (unsigned char)qb; cost[n] = 100 * (qb + 1); ++n; }
  for (int qb = 0; qb < 32; ++qb) { L.u[n].kind = 1; L.u[n].qb = (unsigned char)qb; cost[n] = 165 * (qb + 1); ++n; }
  for (int i = 1; i < 64; ++i) { const AUnit x = L.u[i]; const int c = cost[i]; int j = i - 1; while (j >= 0 && cost[j] < c) { L.u[j + 1] = L.u[j]; cost[j + 1] = cost[j]; --j; } L.u[j + 1] = x; cost[j + 1] = c; }
  return L;
}
__constant__ AList g_alist = make_alist();
constexpr int CW_AQ = 1024, CW_ROLE = 1280, CW_CQ = 1536;
constexpr int LDS_AQW = 147408;
constexpr unsigned N_CONVERTERS_PER_XCD = 7;

__device__ __forceinline__ int wg_pull(unsigned* head, unsigned limit, volatile LAS int* bw) {
  if (threadIdx.x == 0) {
    int idx = (int)limit;
    if (__hip_atomic_load(head, __ATOMIC_RELAXED, __HIP_MEMORY_SCOPE_AGENT) < limit) idx = (int)__hip_atomic_fetch_add(head, 1u, __ATOMIC_RELAXED, __HIP_MEMORY_SCOPE_AGENT);
    bw[0] = idx;
  }
  __syncthreads();
  const int idx = __builtin_amdgcn_readfirstlane(bw[0]);
  __syncthreads();
  return idx;
}
__device__ __forceinline__ void attn_queue_loop(const Params& p, LAS unsigned char* lds, unsigned* ctl, volatile LAS int* bw, unsigned x0) {
  for (unsigned k = 0; k < 8u; ++k) {
    const unsigned g = (x0 + k) & 7u;
    for (;;) {
      const int idx = wg_pull(ctl + CW_AQ + 16u * g, 64u, bw);
      if (idx >= 64) break;
      const AUnit u = g_alist.u[idx];
      const int kind = __builtin_amdgcn_readfirstlane((int)u.kind), qb = __builtin_amdgcn_readfirstlane((int)u.qb);
      if (kind == 0) mla_unit(p, lds, (int)g, qb); else diff_unit(p, lds, (int)g, qb);
    }
  }
}
__device__ __forceinline__ void conv_queue_loop(const Params& p, char* lds_generic, unsigned* ctl, volatile LAS int* bw) {
  for (;;) {
    const int c = wg_pull(ctl + CW_CQ, (unsigned)N_CONV_CHUNKS, bw);
    if (c >= N_CONV_CHUNKS) break;
    conv_chunk(p, lds_generic, c);
    __syncthreads();
  }
}
__device__ __forceinline__ void phase3_fast(const Params& p, LAS unsigned char* lds, char* lds_generic) {
  unsigned* ctl = (unsigned*)(p.ws + WS_CTL);
  volatile LAS int* bw = (volatile LAS int*)(lds + LDS_AQW);
  const unsigned x0 = (unsigned)__builtin_amdgcn_s_getreg((3 << 11) | 20) & 7u;
  const int ticket = wg_pull(ctl + CW_ROLE + 16u * x0, 0xffffffffu, bw);
  if ((unsigned)ticket < N_CONVERTERS_PER_XCD) { conv_queue_loop(p, lds_generic, ctl, bw); attn_queue_loop(p, lds, ctl, bw, x0); }
  else { attn_queue_loop(p, lds, ctl, bw, x0); conv_queue_loop(p, lds_generic, ctl, bw); }
}
}

constexpr int P5_STRIDE = 2052;
__device__ __forceinline__ void phase5(const Params& p, char* lds) {
  const int tid = opaque_tid(), lane = tid & 63, wave = tid >> 6;
  unsigned char* ws = p.ws;
  float* tile = (float*)lds;
  float* part = (float*)lds;
  int* lcnt = (int*)(lds + 135168);
  int* lbase = lcnt + 64;
  int* nent = lcnt + 128;
  int* ent = lcnt + 192;
  const float* mod = (const float*)(ws + WS_MOD);
  const float* x = p.in[0]; const bf16_t* y = (const bf16_t*)(ws + R_Y);
  const float* g_post = p.in[16]; const float* g_pre = p.in[17];
  const float* wr_ = p.in[18]; const float* br_ = p.in[19];
  unsigned char* h2 = (unsigned char*)(ws + WS_H2);
  float* topw = (float*)(ws + WS_TOPW);
  if (tid < 64) lcnt[tid] = 0;
  if (tid == 64) nent[0] = 0;
  __syncthreads();
  for (int ti = blockIdx.x; ti < T / 16; ti += gridDim.x) {
    const int row0 = 16 * ti;
#pragma unroll 1
    for (int rr = 0; rr < 2; ++rr) {
      const int lr = 2 * wave + rr, row = row0 + lr;
      f32x4 v[8]; float ss = 0.f;
#pragma unroll
      for (int j = 0; j < 8; ++j) { const u32x2 yy = *(const u32x2*)(y + (size_t)row * D + 256 * j + 4 * lane); v[j] = (f32x4){bf_lo(yy.x), bf_hi(yy.x), bf_lo(yy.y), bf_hi(yy.y)}; ss += v[j].x * v[j].x + v[j].y * v[j].y + v[j].z * v[j].z + v[j].w * v[j].w; }
      const float rstdy = 1.0f / sqrtf(wave_sum(ss) * (1.0f / D) + EPS);
      float s1 = 0.f;
#pragma unroll
      for (int j = 0; j < 8; ++j) {
        const int c0 = 256 * j + 4 * lane;
        const f32x4 xv = *(const f32x4*)(x + (size_t)row * D + c0), gp = *(const f32x4*)(g_post + c0), ga = *(const f32x4*)(mod + 4096 + c0);
        const f32x4 x1 = xv + ga * ((v[j] * rstdy) * gp);
        *(f32x4*)(p.out + (size_t)row * D + c0) = x1;
        v[j] = x1; s1 += x1.x * x1.x + x1.y * x1.y + x1.z * x1.z + x1.w * x1.w;
      }
      const float rstd1 = 1.0f / sqrtf(wave_sum(s1) * (1.0f / D) + EPS);
#pragma unroll
      for (int j = 0; j < 8; ++j) {
        const int c0 = 256 * j + 4 * lane;
        const f32x4 gf = *(const f32x4*)(g_pre + c0), sh = *(const f32x4*)(mod + 6144 + c0), sc = *(const f32x4*)(mod + 8192 + c0);
        const f32x4 hv = (v[j] * rstd1) * gf * (sc + 1.0f) + sh;
        *(unsigned*)(h2 + (size_t)row * D + c0) = pack8_fp8(hv, hv).x;
        float* tp = tile + lr * P5_STRIDE + c0; tp[0] = hv.x; tp[1] = hv.y; tp[2] = hv.z; tp[3] = hv.w;
      }
    }
    __syncthreads();
    f32x4 racc[4];
#pragma unroll
    for (int jt = 0; jt < 4; ++jt) racc[jt] = (f32x4){0.f, 0.f, 0.f, 0.f};
    const u32x4* wrh = (const u32x4*)(ws + WS_WRT); const u32x4* wrl = (const u32x4*)(ws + WS_WRT + 256 * 1024);
#pragma unroll 2
    for (int ks = 0; ks < 8; ++ks) {
      const int s = 8 * wave + ks;
      const float* ap = tile + (lane & 15) * P5_STRIDE + 32 * s + 8 * (lane >> 4);
      const f32x4 a0 = *(const f32x4*)ap, a1 = *(const f32x4*)(ap + 4);
      const float av[8] = {a0.x, a0.y, a0.z, a0.w, a1.x, a1.y, a1.z, a1.w};
      unsigned hw[4], lw[4];
#pragma unroll
      for (int j = 0; j < 4; ++j) {
        const unsigned h = cvtpk2(av[2 * j], av[2 * j + 1]);
        hw[j] = h; lw[j] = cvtpk2(av[2 * j] - bf_lo(h), av[2 * j + 1] - bf_hi(h));
      }
      const bf16x8 ah = __builtin_bit_cast(bf16x8, (u32x4){hw[0], hw[1], hw[2], hw[3]}), al = __builtin_bit_cast(bf16x8, (u32x4){lw[0], lw[1], lw[2], lw[3]});
#pragma unroll
      for (int jt = 0; jt < 4; ++jt) {
        const bf16x8 bh = __builtin_bit_cast(bf16x8, wrh[(s * 4 + jt) * 64 + lane]), bl = __builtin_bit_cast(bf16x8, wrl[(s * 4 + jt) * 64 + lane]);
        racc[jt] = __builtin_amdgcn_mfma_f32_16x16x32_bf16(ah, bh, racc[jt], 0, 0, 0);
        racc[jt] = __builtin_amdgcn_mfma_f32_16x16x32_bf16(ah, bl, racc[jt], 0, 0, 0);
        racc[jt] = __builtin_amdgcn_mfma_f32_16x16x32_bf16(al, bh, racc[jt], 0, 0, 0);
      }
    }
    __syncthreads();
#pragma unroll
    for (int jt = 0; jt < 4; ++jt)
#pragma unroll
      for (int r = 0; r < 4; ++r) part[(wave * 16 + (lane >> 4) * 4 + r) * 64 + 16 * jt + (lane & 15)] = racc[jt][r];
    __syncthreads();
#pragma unroll 1
    for (int rr = 0; rr < 2; ++rr) {
      const int lr = 2 * wave + rr, tok = row0 + lr;
      float logit = 0.f;
#pragma unroll
      for (int w = 0; w < 8; ++w) logit += part[(w * 16 + lr) * 64 + lane];
      const float score = 1.0f / (1.0f + expf(-logit));
      const float v = score + br_[lane];
      int rk = 0;
#pragma unroll
      for (int d = 1; d < 8; ++d) { const int ol = (lane & ~7) | ((lane + d) & 7); const float ov = __shfl(v, ol); rk += (ov > v || (ov == v && ol < lane)) ? 1 : 0; }
      float gs = rk < 2 ? v : 0.f;
      gs += __shfl_xor(gs, 1); gs += __shfl_xor(gs, 2); gs += __shfl_xor(gs, 4);
      int grk = 0; const int g = lane >> 3;
#pragma unroll
      for (int gg = 0; gg < 8; ++gg) { const float og = __shfl(gs, 8 * gg); grk += (og > gs || (og == gs && gg < g)) ? 1 : 0; }
      const float mv = grk < 4 ? v : -INFINITY;
      int erk = 0;
#pragma unroll 8
      for (int e2 = 0; e2 < 64; ++e2) { const float ov = __shfl(mv, e2); erk += (ov > mv || (ov == mv && e2 < lane)) ? 1 : 0; }
      const bool sel = (erk < 8) && (grk < 4);
      const float tot = wave_sum(sel ? score : 0.f);
      if (sel) {
        topw[tok * 8 + erk] = score / tot * 2.5f;
        const int lp = atomicAdd(&lcnt[lane], 1);
        const int ix = atomicAdd(&nent[0], 1);
        ent[ix] = (tok * 8 + erk) | (lane << 16) | (lp << 22);
      }
    }
    __syncthreads();
  }
  unsigned* gcnt = (unsigned*)(ws + WS_CTL) + CW_GCNT;
  if (tid < 64) lbase[tid] = (int)atomicAdd(&gcnt[tid], (unsigned)lcnt[tid]);
  __syncthreads();
  int* rowl = (int*)(ws + WS_ROWL);
  const int ne = nent[0];
  int* tpos = (int*)(ws + WS_TPOS);
  for (int i = tid; i < ne; i += NTHREADS) { const int w = ent[i]; const int code = w & 0xffff, e = (w >> 16) & 63, lp = (w >> 22) & 1023; const int pos = lbase[e] + lp; rowl[e * 8192 + pos] = code; tpos[code] = (e << 16) | pos; }
}

struct MoeMap { LAS int* cnt; LAS int* tstart; LAS unsigned char* t2e; };
__device__ __forceinline__ void moe_map_build(const Params& p, char* lds, MoeMap& mm) {
  mm.cnt = (LAS int*)((LAS char*)lds + 140000); mm.tstart = mm.cnt + 80; mm.t2e = (LAS unsigned char*)((LAS char*)lds + 141024);
  if (threadIdx.x == 0) {
    const unsigned* gcnt = (const unsigned*)(p.ws + WS_CTL) + CW_GCNT; int acc = 0;
    for (int e = 0; e < 65; ++e) { const int c = (e < 64) ? (int)__hip_atomic_load(&gcnt[e], __ATOMIC_RELAXED, __HIP_MEMORY_SCOPE_AGENT) : T; mm.cnt[e] = c; mm.tstart[e] = acc; acc += (c + 255) >> 8; }
    mm.tstart[65] = acc;
  }
  __syncthreads();
  for (int e = threadIdx.x; e < 65; e += NTHREADS) for (int t = mm.tstart[e]; t < mm.tstart[e + 1]; ++t) mm.t2e[t] = (unsigned char)e;
  __syncthreads();
}
__device__ __forceinline__ int moe_find(const MoeMap& mm, int mtg) { return (int)mm.t2e[mtg]; }

struct RowGather { const int* rl; int cnt, base; __device__ __forceinline__ int operator()(int r) const { const int i = base + r; return i < cnt ? (rl[i] >> 3) : 0; } };

__device__ __forceinline__ void phase8(const Params& p, const MoeMap& mm) {
  const int tid = opaque_tid(), lane = tid & 63, wave = tid >> 6;
  const int gw = blockIdx.x * NWAVES + wave, NGW = gridDim.x * NWAVES;
  unsigned char* ws = p.ws;
  const unsigned char* yp = (const unsigned char*)(ws + R_YSLOT); const float* topw = (const float*)(ws + WS_TOPW); const int* tpos = (const int*)(ws + WS_TPOS);
  const float* mod = (const float*)(ws + WS_MOD); const float* g = p.in[26];
  for (int row = gw; row < T; row += NGW) {
    float w[8]; const unsigned char* rp[9];
#pragma unroll
    for (int s = 0; s < 8; ++s) { w[s] = topw[row * 8 + s]; const int tp = tpos[row * 8 + s]; rp[s] = yp + ((size_t)256 * mm.tstart[tp >> 16] + (tp & 0xffff)) * 2048; }
    rp[8] = yp + ((size_t)256 * mm.tstart[64] + row) * 2048;
    f32x4 v[8]; float ss = 0.f;
#pragma unroll
    for (int j = 0; j < 8; ++j) {
      const int c0 = 256 * j + 4 * lane;
      f32x4 a = unpack4_fp8(*(const unsigned*)(rp[8] + c0));
#pragma unroll
      for (int s = 0; s < 8; ++s) a += unpack4_fp8(*(const unsigned*)(rp[s] + c0)) * w[s];
      v[j] = a; ss += a.x * a.x + a.y * a.y + a.z * a.z + a.w * a.w;
    }
    const float rstd = 1.0f / sqrtf(wave_sum(ss) * (1.0f / D) + EPS);
#pragma unroll
    for (int j = 0; j < 8; ++j) {
      const int c0 = 256 * j + 4 * lane;
      const f32x4 gt = *(const f32x4*)(mod + 10240 + c0), gv = *(const f32x4*)(g + c0);
      float* op = p.out + (size_t)row * D + c0;
      const f32x4 x1 = *(const f32x4*)op;
      *(f32x4*)op = x1 + gt * ((v[j] * rstd) * gv);
    }
  }
}

template <bool GATHER> struct SchedMoe {
  MoeMap mm; int shift, nwg, G, c; const char* Abase; const char* Bbase; size_t bstride, tstepB, tstepA; const int* rowl;
  __device__ __forceinline__ bool next(int i, pg8::Unit& u) const {
    const int L = i * G + c; if (L >= nwg) return false;
    const int wgid = pg8::xcd_remap(L, nwg);
    const int mtg = wgid >> shift, pn = wgid & ((1 << shift) - 1), e = moe_find(mm, mtg);
    u.pm = mtg; u.pn = pn; u.e = e; u.aux = mtg - mm.tstart[e];
    u.A = GATHER ? Abase : Abase + (size_t)mtg * tstepA; u.B = Bbase + (size_t)e * bstride + (size_t)pn * tstepB; return true;
  }
  __device__ __forceinline__ int row(const pg8::Unit& u, int r) const {
    const int i = 256 * u.aux + r;
    if (u.e == 64) return i;
    return i < mm.cnt[u.e] ? (rowl[u.e * 8192 + i] >> 3) : 0;
  }
};


#define XB_TMO      128
#define XB_XCNT(j)  (256  + 64 * (j))
#define XB_XSUB(j)  (1280 + 64 * (j))
#define XB_XGEN(j)  (2304 + 64 * (j))
#define XB_TOP      3328
#define XB_TOPGEN   3392
#define XCD_BAR_WORDS 3456
#define XB_SPIN_CAP (1u << 18)
__device__ __forceinline__ unsigned xb_ld(unsigned* p)              { return __hip_atomic_load(p, __ATOMIC_RELAXED, __HIP_MEMORY_SCOPE_AGENT); }
__device__ __forceinline__ unsigned xb_add(unsigned* p, unsigned v) { return __hip_atomic_fetch_add(p, v, __ATOMIC_RELAXED, __HIP_MEMORY_SCOPE_AGENT); }
__device__ __forceinline__ unsigned xb_xcc_id() { return (unsigned)__builtin_amdgcn_s_getreg((3 << 11) | 20) & 0xFu; }
#define XB_SPIN(cond, bar) do { unsigned _sp = 0; while (cond) { __builtin_amdgcn_s_sleep(1); \
    if ((++_sp & 255u) == 0u) { if (xb_ld(&(bar)[XB_TMO])) break; if (_sp > XB_SPIN_CAP) { atomicAdd(&(bar)[XB_TMO], 1u); break; } } } } while (0)
struct XcdBarrier { unsigned* bar; unsigned x; volatile LAS unsigned* st; };
__device__ __forceinline__ XcdBarrier xcd_barrier_post(unsigned* bar, volatile LAS unsigned* st) {
    XcdBarrier b; b.bar = bar; b.x = xb_xcc_id(); b.st = st;
    if (threadIdx.x == 0) (void)xb_add(&bar[XB_XCNT(b.x)], 1u);
    return b;
}
__device__ __forceinline__ void xcd_barrier_complete(unsigned* bar, unsigned x, unsigned& nloc, unsigned& nx) {
    const unsigned G = gridDim.x * gridDim.y * gridDim.z;
    unsigned sum, cnt, mine, sp = 0u;
    for (;;) {
        sum = 0u; cnt = 0u; mine = 0u;
#pragma unroll
        for (unsigned j = 0; j < 16; ++j) { const unsigned c = xb_ld(&bar[XB_XCNT(j)]); sum += c; cnt += (c > 0u) ? 1u : 0u; mine = (j == x) ? c : mine; }
        if (sum == G) break;
        __builtin_amdgcn_s_sleep(1);
        if ((++sp & 255u) == 0u) { if (xb_ld(&bar[XB_TMO])) break; if (sp > XB_SPIN_CAP) { atomicAdd(&bar[XB_TMO], 1u); break; } }
    }
    nloc = mine > 0u ? mine : 1u; nx = cnt > 0u ? cnt : 1u;
}
__device__ __forceinline__ void xcd_barrier(const XcdBarrier& b) {
    asm volatile("s_waitcnt vmcnt(0)" ::: "memory");
    __syncthreads();
    if (threadIdx.x == 0) {
        unsigned* bar = b.bar;
        __builtin_amdgcn_s_waitcnt(0);
        unsigned nloc = b.st[0], nx = b.st[1];
        if (nloc == 0u) { xcd_barrier_complete(bar, b.x, nloc, nx); b.st[0] = nloc; b.st[1] = nx; }
        const unsigned old = xb_add(&bar[XB_XSUB(b.x)], 1u);
        const unsigned gen = old / nloc;
        if (old + 1u == (gen + 1u) * nloc) {
            __builtin_amdgcn_fence(__ATOMIC_RELEASE, "agent");
            asm volatile("s_waitcnt vmcnt(0)" ::: "memory");
            const unsigned og = xb_add(&bar[XB_TOP], 1u);
            const unsigned tg = og / nx;
            if (og + 1u == (tg + 1u) * nx) xb_add(&bar[XB_TOPGEN], 1u);
            else XB_SPIN(xb_ld(&bar[XB_TOPGEN]) == tg, bar);
            __builtin_amdgcn_fence(__ATOMIC_ACQUIRE, "agent");
            xb_add(&bar[XB_XGEN(b.x)], 1u);
            asm volatile("s_waitcnt vmcnt(0)" ::: "memory");
        } else {
            XB_SPIN(xb_ld(&bar[XB_XGEN(b.x)]) == gen, bar);
            __builtin_amdgcn_fence(__ATOMIC_ACQUIRE, "agent");
            asm volatile("s_waitcnt vmcnt(0)" ::: "memory");
        }
    }
    __syncthreads();
}
constexpr int CW_BAR = 4096;
constexpr int LDS_BARST = 147392;

#ifndef FAST_GEMM
#define FAST_GEMM 1
#endif
#ifndef FAST_ATTN
#define FAST_ATTN 1
#endif

__global__ void __launch_bounds__(NTHREADS) fwd_megakernel(Params p) {
  extern __shared__ __attribute__((aligned(16))) char lds[];
  cg::grid_group grid = cg::this_grid();
  unsigned char* ws = p.ws;
  const int G = gridDim.x;
  LAS unsigned char* ring = (LAS unsigned char*)lds;
  if (threadIdx.x < 16) ((LAS unsigned*)(ring + LDS_BARST))[threadIdx.x] = 0u;
  __syncthreads();
  const XcdBarrier xbar = xcd_barrier_post((unsigned*)(ws + WS_CTL) + CW_BAR, (volatile LAS unsigned*)(ring + LDS_BARST));
#define GRID_BAR() xcd_barrier(xbar)

  phase0a(p, lds);
#if DUP_PHASE == 1
  GRID_BAR(); phase0a(p, lds);
#endif
  GRID_BAR();
  phase0b(p, lds);
  GRID_BAR();
  {
    EpiProj<true> E{ws, 0};
#if FAST_GEMM
    pg8::SchedPlain S(ws + WS_H2, ws + WS_WIN, T, 4096, D, G, (int)blockIdx.x);
    pg8::gemm_phase<EpiProj<true>, pg8::SchedPlain, true, false>(ring, D, S, E);
#if DUP_PHASE == 2
    GRID_BAR(); pg8::gemm_phase<EpiProj<true>, pg8::SchedPlain, true, false>(ring, D, S, E);
#endif
#else
    for (int u = blockIdx.x; u < 32 * 18; u += G) {
      pg8::Unit un{}; un.pm = u / 18; un.pn = u % 18;
      gemm_tile_naive<true>((const bf16_t*)(ws + WS_H2), D, (const bf16_t*)(ws + WS_WIN) + (size_t)256 * un.pn * D, D, RowIdent{256 * un.pm}, E, un);
    }
#endif
  }
  GRID_BAR();
  {
    EpiRowScale<true> EQ{(bf16_t*)(ws + R_QM), NQ, (const float*)(ws + WS_SSQ), 12, 1.0f / QR, 0.07216878364870322f * 1.4426950408889634f};
    EpiRowScale<true> EK{(bf16_t*)(ws + R_KVM), NKV, (const float*)(ws + WS_SSQ + 512 * 1024), 8, 1.0f / KVR, 1.0f};
#if FAST_GEMM
    const int bx = (int)blockIdx.x, NA = (G >= 128) ? 64 : 0;
    if (NA) { EpiProj<true> EV{ws, 16};
      pg8::SchedPlain S(ws + WS_H2, ws + WS_WIN + (size_t)4096 * D * 2, T, 512, D, NA, bx < NA ? bx : (1 << 20));
      pg8::gemm_phase<EpiProj<true>, pg8::SchedPlain, true, false>(ring, D, S, EV); }
    else { EpiProj<true> EV{ws, 16};
      pg8::SchedPlain S(ws + WS_H2, ws + WS_WIN + (size_t)4096 * D * 2, T, 512, D, G, bx);
      pg8::gemm_phase<EpiProj<true>, pg8::SchedPlain, true, false>(ring, D, S, EV); }
    { pg8::SchedPlain S(ws + R_QLAT, ws + WS_WUQ, T, NQ, QR, G - NA, bx >= NA ? bx - NA : (1 << 20));
      pg8::gemm_phase<EpiRowScale<true>, pg8::SchedPlain, true, false>(ring, QR, S, EQ); }
    { pg8::SchedPlain S(ws + R_KVLAT, ws + WS_WUKV, T, NKV, KVR, G - NA, bx >= NA ? bx - NA : (1 << 20));
      pg8::gemm_phase<EpiRowScale<true>, pg8::SchedPlain, true, false>(ring, KVR, S, EK); }
#else
    for (int u = blockIdx.x; u < 32 * 6 + 32 * 8; u += G) {
      pg8::Unit un{};
      if (u < 192) { un.pm = u / 6; un.pn = u % 6;
        gemm_tile_naive<true>((const bf16_t*)(ws + R_QLAT), QR, (const bf16_t*)(ws + WS_WUQ) + (size_t)256 * un.pn * QR, QR, RowIdent{256 * un.pm}, EQ, un);
      } else { const int v = u - 192; un.pm = v / 8; un.pn = v % 8;
        gemm_tile_naive<true>((const bf16_t*)(ws + R_KVLAT), KVR, (const bf16_t*)(ws + WS_WUKV) + (size_t)256 * un.pn * KVR, KVR, RowIdent{256 * un.pm}, EK, un);
      }
    }
#endif
  }
  rotary_rows(p);
  GRID_BAR();
#if FAST_ATTN
  fa::phase3_fast(p, ring, lds);
  GRID_BAR();
#else
  phase3_naive(p);
  GRID_BAR();
  phase3b_naive(p);
  GRID_BAR();
#endif
  {
    EpiBf16<true> E{(bf16_t*)(ws + R_Y), D};
#if FAST_GEMM
    pg8::SchedPlain S(ws + R_OATT, ws + WS_WOUT, T, D, D, G, (int)blockIdx.x);
    pg8::gemm_phase<EpiBf16<true>, pg8::SchedPlain, true, false>(ring, D, S, E);
#else
    for (int u = blockIdx.x; u < 32 * 8; u += G) {
      pg8::Unit un{}; un.pm = u / 8; un.pn = u % 8;
      gemm_tile_naive<true>((const bf16_t*)(ws + R_OATT), D, (const bf16_t*)(ws + WS_WOUT) + (size_t)256 * un.pn * D, D, RowIdent{256 * un.pm}, E, un);
    }
#endif
  }
  GRID_BAR();
  phase5(p, lds);
  GRID_BAR();
  {
    MoeMap mm; moe_map_build(p, lds, mm);
    const int nmt = mm.tstart[65];
    {
      EpiSwiglu<true> E{(bf16_t*)(ws + WS_ACT), 1.0f / 32.0f};
      SchedMoe<true> S{mm, 2, nmt * 4, G, (int)blockIdx.x, (const char*)(ws + WS_H2), (const char*)(ws + WS_WGU), (size_t)1024 * D, (size_t)256 * D, 0, (const int*)(ws + WS_ROWL)};
#if FAST_GEMM
      pg8::gemm_phase<EpiSwiglu<true>, SchedMoe<true>, true, true, true>(ring, D / 2, S, E);
#if DUP_PHASE == 6
      GRID_BAR(); pg8::gemm_phase<EpiSwiglu<true>, SchedMoe<true>, true, true, true>(ring, D / 2, S, E);
#endif
#else
      pg8::Unit un;
      for (int i = 0; S.next(i, un); ++i) {
        const int e = un.e, mt = un.aux;
        if (e < 64) gemm_tile_naive<true>((const bf16_t*)(ws + WS_H2), D, (const bf16_t*)un.B, D, RowGather{(const int*)(ws + WS_ROWL) + e * 8192, mm.cnt[e], 256 * mt}, E, un);
        else gemm_tile_naive<true>((const bf16_t*)(ws + WS_H2), D, (const bf16_t*)un.B, D, RowIdent{256 * mt}, E, un);
      }
#endif
    }
    GRID_BAR();
    {
      EpiRowsFp8<true> E{(unsigned char*)(ws + R_YSLOT), 1.0f / 32.0f};
      SchedMoe<false> S{mm, 3, nmt * 8, G, (int)blockIdx.x, (const char*)(ws + WS_ACT), (const char*)(ws + WS_WD), (size_t)2048 * DE, (size_t)256 * DE, (size_t)256 * DE, (const int*)(ws + WS_ROWL)};
#if FAST_GEMM
      pg8::gemm_phase<EpiRowsFp8<true>, SchedMoe<false>, true, false, true>(ring, DE / 2, S, E);
#if DUP_PHASE == 7
      GRID_BAR(); pg8::gemm_phase<EpiRowsFp8<true>, SchedMoe<false>, true, false, true>(ring, DE / 2, S, E);
#endif
#else
      pg8::Unit un;
      for (int i = 0; S.next(i, un); ++i)
        gemm_tile_naive<true>((const bf16_t*)(ws + WS_ACT), DE, (const bf16_t*)un.B, DE, RowIdent{256 * un.pm}, E, un);
#endif
    }
  }
  GRID_BAR();
  { MoeMap mm8; mm8.cnt = (LAS int*)((LAS char*)lds + 140000); mm8.tstart = mm8.cnt + 80; mm8.t2e = (LAS unsigned char*)((LAS char*)lds + 141024); phase8(p, mm8); }
}

extern "C" void kernel_launch(void* const* d_in, const int* in_sizes, int n_in, void* d_out, int out_size, void* d_ws, size_t ws_size, hipStream_t stream) {
  static int grid_blocks = 0;
  if (grid_blocks == 0) {
    if (n_in != 27 || out_size != T * D || ws_size < WS_END) { fprintf(stderr, "kernel_launch: unexpected shapes (n_in %d out %d ws %zu)\n", n_in, out_size, ws_size); grid_blocks = -1; return; }
    int dev = 0, cus = 0, per_cu = 0;
    hipGetDevice(&dev);
    hipDeviceGetAttribute(&cus, hipDeviceAttributeMultiprocessorCount, dev);
    hipFuncSetAttribute((const void*)fwd_megakernel, hipFuncAttributeMaxDynamicSharedMemorySize, LDS_BYTES);
    hipOccupancyMaxActiveBlocksPerMultiprocessor(&per_cu, (const void*)fwd_megakernel, NTHREADS, LDS_BYTES);
    if (per_cu < 1) { fprintf(stderr, "kernel_launch: occupancy query says %d\n", per_cu); per_cu = 1; }
    if (per_cu > 1) per_cu = 1;
    grid_blocks = cus * per_cu;
  }
  if (grid_blocks < 0) return;
  hipMemsetAsync((char*)d_ws + WS_CTL, 0, CTL_BYTES, stream);
  Params p{};
  for (int i = 0; i < 27; ++i) p.in[i] = (const float*)d_in[i];
  p.out = (float*)d_out; p.ws = (unsigned char*)d_ws;
  void* args[] = {&p};
  hipError_t e = hipLaunchCooperativeKernel((const void*)fwd_megakernel, dim3(grid_blocks), dim3(NTHREADS), args, LDS_BYTES, stream);
  if (e != hipSuccess) fprintf(stderr, "cooperative launch failed: %s (grid %d)\n", hipGetErrorString(e), grid_blocks);
}
```

```cpp
#include <hip/hip_runtime.h>
#include <hip/hip_cooperative_groups.h>
#include <cstdio>
#include <cstdint>
namespace cg = cooperative_groups;
#ifndef DUP_PHASE
#define DUP_PHASE 0
#endif

typedef unsigned short bf16_t;
typedef short bf16x8 __attribute__((ext_vector_type(8)));
typedef float f32x4 __attribute__((ext_vector_type(4)));
typedef float f32x2 __attribute__((ext_vector_type(2)));
typedef unsigned u32x4 __attribute__((ext_vector_type(4)));
typedef unsigned u32x2 __attribute__((ext_vector_type(2)));
typedef __bf16 bf16x2_t __attribute__((ext_vector_type(2)));

constexpr int T = 8192, D = 2048;
constexpr int NIN = 4608;
constexpr int QR = 768, KVR = 512;
constexpr int NQ = 1536, NKV = 2048;
constexpr int NE = 64, DE = 512;
constexpr float EPS = 1e-6f;
constexpr int NTHREADS = 512, NWAVES = 8;
constexpr int LDS_BYTES = 147456;

constexpr size_t MiB = 1u << 20;
constexpr size_t WS_CTL = 0, CTL_BYTES = 1 * MiB;
constexpr size_t WS_MODP = 1 * MiB;
constexpr size_t WS_MOD = 3 * MiB;
constexpr size_t WS_WRT = 7 * MiB;
constexpr size_t WS_ROPEM = 4 * MiB;
constexpr size_t WS_ROPED = 6 * MiB;
constexpr size_t WS_WIN = 8 * MiB;
constexpr size_t WS_WUQ = 26 * MiB;
constexpr size_t WS_WUKV = 29 * MiB;
constexpr size_t WS_WOUT = 31 * MiB;
constexpr size_t WS_WGU = 40 * MiB;
constexpr size_t WS_WD = 300 * MiB;
constexpr size_t WS_H2 = 430 * MiB;
constexpr size_t WS_ACT = 462 * MiB;
constexpr size_t WS_ROWL = 550 * MiB;
constexpr size_t WS_TOPW = 552 * MiB;
constexpr size_t WS_TPOS = 554 * MiB;
constexpr size_t WS_SSQ = 553 * MiB;
constexpr size_t WS_R1 = 556 * MiB;
constexpr size_t R_QLAT = WS_R1 + 0 * MiB;
constexpr size_t R_KVLAT = WS_R1 + 12 * MiB;
constexpr size_t R_KPE = WS_R1 + 20 * MiB;
constexpr size_t R_DQ = WS_R1 + 21 * MiB;
constexpr size_t R_DK = WS_R1 + 37 * MiB;
constexpr size_t R_DV = WS_R1 + 53 * MiB;
constexpr size_t R_QM = WS_R1 + 69 * MiB;
constexpr size_t R_KVM = WS_R1 + 93 * MiB;
constexpr size_t R_OATT = WS_R1 + 125 * MiB;
constexpr size_t R_Y = WS_R1 + 157 * MiB;
constexpr size_t R_OC = WS_R1 + 221 * MiB;
constexpr size_t R_YSLOT = WS_R1;
constexpr size_t WS_END = WS_R1 + 288 * MiB;

constexpr int CW_GCNT = 64;

struct Params {
  const float* in[27];
  float* out;
  unsigned char* ws;
};

__device__ __forceinline__ unsigned f2bf(float f) { unsigned u = __builtin_bit_cast(unsigned, f); return (u + 0x7fffu + ((u >> 16) & 1u)) >> 16; }
__device__ __forceinline__ unsigned pk2(float lo, float hi) { return f2bf(lo) | (f2bf(hi) << 16); }
__device__ __forceinline__ unsigned cvtpk2(float lo, float hi) { f32x2 v = {lo, hi}; bf16x2_t b = __builtin_convertvector(v, bf16x2_t); return __builtin_bit_cast(unsigned, b); }
__device__ __forceinline__ u32x4 pack8(const f32x4& a, const f32x4& b) { return (u32x4){cvtpk2(a.x, a.y), cvtpk2(a.z, a.w), cvtpk2(b.x, b.y), cvtpk2(b.z, b.w)}; }
__device__ __forceinline__ u32x2 pack8_fp8(const f32x4& a, const f32x4& b) {
  int lo = __builtin_amdgcn_cvt_pk_fp8_f32(a.x, a.y, 0, false); lo = __builtin_amdgcn_cvt_pk_fp8_f32(a.z, a.w, lo, true);
  int hi = __builtin_amdgcn_cvt_pk_fp8_f32(b.x, b.y, 0, false); hi = __builtin_amdgcn_cvt_pk_fp8_f32(b.z, b.w, hi, true);
  return (u32x2){(unsigned)lo, (unsigned)hi};
}
__device__ __forceinline__ f32x4 unpack4_fp8(unsigned v) { const f32x2 a = __builtin_amdgcn_cvt_pk_f32_fp8((int)v, false), b = __builtin_amdgcn_cvt_pk_f32_fp8((int)v, true); return (f32x4){a.x, a.y, b.x, b.y}; }
__device__ __forceinline__ float bf_lo(unsigned u) { return __uint_as_float(u << 16); }
__device__ __forceinline__ float bf_hi(unsigned u) { return __uint_as_float(u & 0xffff0000u); }
__device__ __forceinline__ float bf1(bf16_t h) { return __uint_as_float(((unsigned)h) << 16); }
__device__ __forceinline__ float wave_sum(float v) {
#pragma unroll
  for (int o = 1; o < 64; o <<= 1) v += __shfl_xor(v, o);
  return v;
}
__device__ __forceinline__ float dot2bf(unsigned a, unsigned b, float c) {
  return __builtin_amdgcn_fdot2_f32_bf16(__builtin_bit_cast(bf16x2_t, a), __builtin_bit_cast(bf16x2_t, b), c, false);
}
__device__ __forceinline__ void sincos_rev(float ang, float& c, float& s) {
  float rev = ang * 0.15915494309189535f;
  rev = rev - floorf(rev);
  s = __builtin_amdgcn_sinf(rev);
  c = __builtin_amdgcn_cosf(rev);
}
__device__ __forceinline__ int opaque_tid() { int t = threadIdx.x; asm volatile("" : "+v"(t)); return t; }
__device__ __forceinline__ int perm32(int rho) { const int n = rho >> 4, i = rho & 15; return 8 * (i >> 2) + 4 * n + (i & 3); }

struct TrDesc { const float* src; bf16_t* dst; const float* gs; int ldw, ldt; int f8; };
template <bool NT> __device__ __forceinline__ void tr_load(const TrDesc& d, f32x4 (&v)[8], int lane) {
  const float* s = d.src + (size_t)(lane >> 3) * d.ldw + 4 * (lane & 7);
#pragma unroll
  for (int i = 0; i < 8; ++i) { const f32x4* q = (const f32x4*)(s + (size_t)(8 * i) * d.ldw); v[i] = NT ? __builtin_nontemporal_load(q) : *q; }
}
template <bool NT> __device__ __forceinline__ void tr_finish(const TrDesc& d, f32x4 (&v)[8], float* scr, int lane) {
  const int r8 = lane >> 3, c4 = lane & 7;
  if (d.gs) {
#pragma unroll
    for (int i = 0; i < 8; ++i) v[i] *= d.gs[8 * i + r8];
  }
#pragma unroll
  for (int i = 0; i < 8; ++i) { float* t = scr + (8 * i + r8) * 33 + 4 * c4; t[0] = v[i].x; t[1] = v[i].y; t[2] = v[i].z; t[3] = v[i].w; }
  asm volatile("s_waitcnt lgkmcnt(0)" ::: "memory");
  const int c = lane & 7;
  if (d.f8) {
#pragma unroll
    for (int j = 0; j < 4; ++j) {
      const int n = (lane >> 3) + 8 * j; const float* s = scr + (8 * c) * 33 + n;
      const f32x4 a = (f32x4){s[0 * 33], s[1 * 33], s[2 * 33], s[3 * 33]} * 32.0f, b = (f32x4){s[4 * 33], s[5 * 33], s[6 * 33], s[7 * 33]} * 32.0f;
      const u32x2 o = pack8_fp8(a, b);
      u32x2* q = (u32x2*)((unsigned char*)d.dst + (size_t)n * d.ldt + 8 * c);
      if (NT) __builtin_nontemporal_store(o, q); else *q = o;
    }
  } else {
#pragma unroll
    for (int j = 0; j < 4; ++j) {
      const int n = (lane >> 3) + 8 * j; const float* s = scr + (8 * c) * 33 + n;
      u32x4 o; o.x = cvtpk2(s[0 * 33], s[1 * 33]); o.y = cvtpk2(s[2 * 33], s[3 * 33]); o.z = cvtpk2(s[4 * 33], s[5 * 33]); o.w = cvtpk2(s[6 * 33], s[7 * 33]);
      u32x4* q = (u32x4*)(d.dst + (size_t)n * d.ldt + 8 * c);
      if (NT) __builtin_nontemporal_store(o, q); else *q = o;
    }
  }
  asm volatile("s_waitcnt lgkmcnt(0)" ::: "memory");
}
constexpr int I_WIN = 32 * 138, I_WUQ = 12 * 48, I_WUKV = 8 * 64, I_WOUT = 32 * 64, I_GU = 65 * 1024, I_DN = 65 * 512;
constexpr int TR_SMALL = I_WIN + I_WUQ + I_WUKV + I_WOUT, TOTAL_TR = TR_SMALL + I_GU + I_DN;
constexpr int TR_FG = TR_SMALL - I_WOUT;
constexpr int CONV_CHUNK = 64, N_CONV_CHUNKS = (I_WOUT + I_GU + I_DN) / CONV_CHUNK;
static_assert((I_WOUT + I_GU + I_DN) % CONV_CHUNK == 0, "chunking");
__device__ __forceinline__ TrDesc tr_decode(const Params& p, int r) {
  unsigned char* ws = p.ws; TrDesc d; d.gs = nullptr; d.f8 = 0;
  if (r < I_WIN) {
    const int kb = r / 138, nb = r % 138, n0 = 32 * nb, k0 = 64 * kb;
    const int d0 = n0 < 1344 ? n0 : n0 + 192;
    d.src = p.in[5] + (size_t)k0 * 4416 + n0; d.ldw = 4416; d.dst = (bf16_t*)(ws + WS_WIN) + (size_t)d0 * 2048 + k0; d.ldt = 2048; return d;
  }
  r -= I_WIN;
  if (r < I_WUQ) { const int kb = r / 48, nb = r % 48, k0 = 64 * kb, n0 = 32 * nb;
    d.src = p.in[7] + (size_t)k0 * 1536 + n0; d.ldw = 1536; d.dst = (bf16_t*)(ws + WS_WUQ) + (size_t)n0 * 768 + k0; d.ldt = 768; d.gs = p.in[6] + k0; return d; }
  r -= I_WUQ;
  if (r < I_WUKV) { const int kb = r / 64, nb = r % 64, k0 = 64 * kb, n0 = 32 * nb;
    d.src = p.in[9] + (size_t)k0 * 2048 + n0; d.ldw = 2048; d.dst = (bf16_t*)(ws + WS_WUKV) + (size_t)n0 * 512 + k0; d.ldt = 512; d.gs = p.in[8] + k0; return d; }
  r -= I_WUKV;
  if (r < I_WOUT) { const int kb = r / 64, nb = r % 64, k0 = 64 * kb, n0 = 32 * nb;
    d.src = p.in[15] + (size_t)k0 * 2048 + n0; d.ldw = 2048; d.dst = (bf16_t*)(ws + WS_WOUT) + (size_t)n0 * 2048 + k0; d.ldt = 2048; return d; }
  r -= I_WOUT;
  if (r < I_GU) {
    const int e = r >> 10, q = r & 1023, up = q >> 9, idx = q & 511, kb = idx >> 4, nb = idx & 15, n0 = 32 * nb, k0 = 64 * kb;
    const float* s = (e < 64) ? (p.in[up ? 21 : 20] + (size_t)e * 2048 * 512) : p.in[up ? 24 : 23];
    const int d0 = 256 * (n0 >> 7) + (n0 & 127) + 128 * up;
    d.src = s + (size_t)k0 * 512 + n0; d.ldw = 512; d.dst = (bf16_t*)(ws + WS_WGU + (size_t)e * 1024 * 2048 + (size_t)d0 * 2048 + k0); d.ldt = 2048; d.f8 = 1; return d;
  }
  r -= I_GU;
  { const int e = r >> 9, idx = r & 511, kb = idx >> 6, nb = idx & 63, k0 = 64 * kb, n0 = 32 * nb;
    const float* s = (e < 64) ? (p.in[22] + (size_t)e * 512 * 2048) : p.in[25];
    d.src = s + (size_t)k0 * 2048 + n0; d.ldw = 2048; d.dst = (bf16_t*)(ws + WS_WD + (size_t)e * 2048 * 512 + (size_t)n0 * 512 + k0); d.ldt = 512; d.f8 = 1; return d; }
}
__device__ __forceinline__ void phase0a(const Params& p, char* lds) {
  const int tid = opaque_tid(), lane = tid & 63, wave = tid >> 6;
  const int gw = blockIdx.x * NWAVES + wave, NGW = gridDim.x * NWAVES;
  float* scr = (float*)(lds + wave * 16384);
  unsigned char* ws = p.ws;
  for (int r = gw; r < 48 * 32; r += NGW) {
    const int nt = r % 48, ks = r / 48;
    const float* c = p.in[1]; const float* w = p.in[2] + (size_t)(64 * ks) * 12288 + 256 * nt + 4 * lane;
    f32x4 acc = {0.f, 0.f, 0.f, 0.f};
#pragma unroll 16
    for (int k = 0; k < 64; ++k) {
      const float cv = c[64 * ks + k]; const float sv = cv / (1.f + expf(-cv));
      const f32x4 wv = *(const f32x4*)(w + (size_t)k * 12288);
      acc += wv * sv;
    }
    *(f32x4*)((float*)(ws + WS_MODP) + (size_t)ks * 12288 + 256 * nt + 4 * lane) = acc;
  }
  {
    f32x4 vA[8], vB[8]; TrDesc dA, dB;
    int it = gw;
    if (it < TR_FG) {
      dA = tr_decode(p, it); tr_load<false>(dA, vA, lane);
      for (;;) {
        const int itB = it + NGW; const bool hasB = itB < TR_FG;
        if (hasB) { dB = tr_decode(p, itB); tr_load<false>(dB, vB, lane); }
        tr_finish<false>(dA, vA, scr, lane);
        if (!hasB) break;
        const int itA = itB + NGW; const bool hasA = itA < TR_FG;
        if (hasA) { dA = tr_decode(p, itA); tr_load<false>(dA, vA, lane); }
        tr_finish<false>(dB, vB, scr, lane);
        if (!hasA) break;
        it = itA;
      }
    }
  }
  const int gt = blockIdx.x * NTHREADS + tid, NGT = gridDim.x * NTHREADS;
  for (int i = gt; i < T * 40; i += NGT) {
    if (i < T * 32) {
      const int pos = i >> 5, f = i & 31;
      const float inv = powf(500000.0f, -(float)(2 * f) / 64.0f);
      float c, s; sincos_rev((float)pos * inv, c, s);
      ((f32x2*)(ws + WS_ROPEM))[i] = (f32x2){c, s};
    } else {
      const int j = i - T * 32, pos = j >> 3, f = j & 7;
      const float inv = powf(500000.0f, -(float)(2 * f) / 16.0f);
      float c, s; sincos_rev((float)pos * inv, c, s);
      ((f32x2*)(ws + WS_ROPED))[j] = (f32x2){c, s};
    }
  }
  for (int i = gt; i < 64 * 4 * 64; i += NGT) {
    const int l = i & 63, jt = (i >> 6) & 3, s = i >> 8;
    const float* w = p.in[18] + (size_t)(32 * s + 8 * (l >> 4)) * 64 + 16 * jt + (l & 15);
    float v[8], lo[8];
#pragma unroll
    for (int j = 0; j < 8; ++j) { v[j] = w[(size_t)j * 64]; lo[j] = v[j] - bf1((bf16_t)f2bf(v[j])); }
    ((u32x4*)(ws + WS_WRT))[i] = (u32x4){pk2(v[0], v[1]), pk2(v[2], v[3]), pk2(v[4], v[5]), pk2(v[6], v[7])};
    ((u32x4*)(ws + WS_WRT + 256 * 1024))[i] = (u32x4){pk2(lo[0], lo[1]), pk2(lo[2], lo[3]), pk2(lo[4], lo[5]), pk2(lo[6], lo[7])};
  }
  if (blockIdx.x == 0 && tid == 0) {
    float a = 0.f, b = 0.f;
    for (int i = 0; i < 64; ++i) { a += p.in[10][i] * p.in[11][i]; b += p.in[12][i] * p.in[13][i]; }
    ((float*)(ws + WS_MOD))[16384] = expf(a) - expf(b) + 0.2f;
  }
}


__device__ __forceinline__ void conv_chunk(const Params& p, char* lds, int chunk) {
  const int tid = opaque_tid(), lane = tid & 63, wave = tid >> 6;
  float* scr = (float*)(lds + wave * 16384);
  const int base = TR_FG + chunk * CONV_CHUNK + wave * 8;
  f32x4 vA[8], vB[8], vC[8], vD[8]; TrDesc dA, dB, dC, dD;
  dA = tr_decode(p, base + 0); tr_load<true>(dA, vA, lane);
  dB = tr_decode(p, base + 1); tr_load<true>(dB, vB, lane);
  dC = tr_decode(p, base + 2); tr_load<true>(dC, vC, lane);
  dD = tr_decode(p, base + 3); tr_load<true>(dD, vD, lane);
  tr_finish<true>(dA, vA, scr, lane); dA = tr_decode(p, base + 4); tr_load<true>(dA, vA, lane);
  tr_finish<true>(dB, vB, scr, lane); dB = tr_decode(p, base + 5); tr_load<true>(dB, vB, lane);
  tr_finish<true>(dC, vC, scr, lane); dC = tr_decode(p, base + 6); tr_load<true>(dC, vC, lane);
  tr_finish<true>(dD, vD, scr, lane); dD = tr_decode(p, base + 7); tr_load<true>(dD, vD, lane);
  tr_finish<true>(dA, vA, scr, lane);
  tr_finish<true>(dB, vB, scr, lane);
  tr_finish<true>(dC, vC, scr, lane);
  tr_finish<true>(dD, vD, scr, lane);
}

__device__ __forceinline__ void phase0b(const Params& p, char* lds) {
  const int tid = opaque_tid(), lane = tid & 63, wave = tid >> 6;
  const int gw = blockIdx.x * NWAVES + wave, NGW = gridDim.x * NWAVES;
  unsigned char* ws = p.ws;
  const float* modp = (const float*)(ws + WS_MODP);
  float* shsc = (float*)lds;
  for (int n = tid; n < 4096; n += NTHREADS) { float s = p.in[3][n]; for (int k = 0; k < 32; ++k) s += modp[(size_t)k * 12288 + n]; shsc[n] = s; }
  for (int n = blockIdx.x * NTHREADS + tid; n < 12288; n += gridDim.x * NTHREADS) { float s = p.in[3][n]; for (int k = 0; k < 32; ++k) s += modp[(size_t)k * 12288 + n]; ((float*)(ws + WS_MOD))[n] = s; }
  __syncthreads();
  const float* x = p.in[0]; const float* g = p.in[4];
  bf16_t* xn = (bf16_t*)(ws + WS_H2);
  for (int row = gw; row < T; row += NGW) {
    f32x4 v[8]; float ss = 0.f;
#pragma unroll
    for (int j = 0; j < 8; ++j) { v[j] = *(const f32x4*)(x + (size_t)row * D + 256 * j + 4 * lane); ss += v[j].x * v[j].x + v[j].y * v[j].y + v[j].z * v[j].z + v[j].w * v[j].w; }
    const float rstd = 1.0f / sqrtf(wave_sum(ss) * (1.0f / D) + EPS);
#pragma unroll
    for (int j = 0; j < 8; ++j) {
      const int c0 = 256 * j + 4 * lane;
      const f32x4 gv = *(const f32x4*)(g + c0);
      const f32x4 sh = *(const f32x4*)(shsc + c0), sc = *(const f32x4*)(shsc + 2048 + c0);
      const f32x4 h = (v[j] * rstd) * gv * (sc + 1.0f) + sh;
      u32x2 o; o.x = pk2(h.x, h.y); o.y = pk2(h.z, h.w);
      *(u32x2*)(xn + (size_t)row * D + c0) = o;
    }
  }
}

template <bool PERM> __device__ __forceinline__ int acc_col(int bj, int wc, int n, int fq) { return 128 * bj + 32 * wc + (PERM ? 8 * fq + 4 * n : 16 * n + 4 * fq); }
__device__ __forceinline__ int acc_row(int ai, int wr, int m, int fr) { return 128 * ai + 64 * wr + 16 * m + fr; }

template <bool PERM, class RowMap, class Epi, class U>
__device__ __forceinline__ void gemm_tile_naive(const bf16_t* A, int lda, const bf16_t* Bt, int K, const RowMap& rm, const Epi& epi, const U& unit) {
  const int tid = opaque_tid(), lane = tid & 63, wid = tid >> 6, wr = wid >> 2, wc = wid & 3, fr = lane & 15, fq = lane >> 4;
  f32x4 acc[2][2][4][2];
#pragma unroll
  for (int a = 0; a < 2; ++a)
#pragma unroll
    for (int b = 0; b < 2; ++b)
#pragma unroll
      for (int m = 0; m < 4; ++m)
#pragma unroll
        for (int n = 0; n < 2; ++n) acc[a][b][m][n] = (f32x4){0.f, 0.f, 0.f, 0.f};
  unsigned aoff[2][4], boff[2][2];
#pragma unroll
  for (int a = 0; a < 2; ++a)
#pragma unroll
    for (int m = 0; m < 4; ++m) aoff[a][m] = (unsigned)rm(acc_row(a, wr, m, fr)) * (unsigned)lda + 8u * fq;
#pragma unroll
  for (int b = 0; b < 2; ++b)
#pragma unroll
    for (int n = 0; n < 2; ++n) { const int rho = 16 * n + fr; boff[b][n] = (unsigned)(128 * b + 32 * wc + (PERM ? perm32(rho) : rho)) * (unsigned)K + 8u * fq; }
  for (int k0 = 0; k0 < K; k0 += 32) {
    bf16x8 af[2][4], bfr[2][2];
#pragma unroll
    for (int a = 0; a < 2; ++a)
#pragma unroll
      for (int m = 0; m < 4; ++m) af[a][m] = *(const bf16x8*)(A + aoff[a][m] + k0);
#pragma unroll
    for (int b = 0; b < 2; ++b)
#pragma unroll
      for (int n = 0; n < 2; ++n) bfr[b][n] = *(const bf16x8*)(Bt + boff[b][n] + k0);
#pragma unroll
    for (int a = 0; a < 2; ++a)
#pragma unroll
      for (int b = 0; b < 2; ++b)
#pragma unroll
        for (int m = 0; m < 4; ++m)
#pragma unroll
          for (int n = 0; n < 2; ++n) acc[a][b][m][n] = __builtin_amdgcn_mfma_f32_16x16x32_bf16(bfr[b][n], af[a][m], acc[a][b][m][n], 0, 0, 0);
  }
  epi(acc, unit, wr, wc, fr, fq);
}


#define LAS __attribute__((address_space(3)))
namespace pg8 {
typedef int i32x4_t __attribute__((ext_vector_type(4)));
constexpr int BM = 256, BK = 64, HALF = 128, HTB = HALF * BK * 2, STAGE_BYTES = 8 * HTB, NXCD = 8, WGM = 8;
__host__ __device__ __forceinline__ int lds_byte(int r, int c) { const int st = (r >> 4) * 2 + (c >> 5), rr = r & 15, cc = c & 31, ob = rr * 64 + cc * 2; return st * 1024 + (ob ^ (((ob >> 9) & 1) << 5)); }
__host__ __device__ __forceinline__ void stage_rc(int b, int& R, int& C) { const int st = b / 1024, sb = b % 1024, swz = sb ^ (((sb >> 9) & 1) << 5); R = (st >> 1) * 16 + swz / 64; C = (st & 1) * 32 + (swz % 64) / 2; }
struct Unit { const char* A; const char* B; int pm, pn, e, aux; };

__device__ __forceinline__ int xcd_remap(int L, int nwg) { const int q = nwg / NXCD, r = nwg % NXCD, xcd = L % NXCD, off = L / NXCD; return (xcd < r ? xcd * (q + 1) : r * (q + 1) + (xcd - r) * q) + off; }

template <class Epi, class Sched, bool ALIGN_EPI, bool GATHER, bool F8 = false>
__device__ __forceinline__ void gemm_phase(LAS unsigned char* lds, const int K, const Sched& S, const Epi& E) {
    const int tid = opaque_tid(), wid = __builtin_amdgcn_readfirstlane(tid >> 6), lane = tid & 63, wr = wid >> 2, wc = wid & 3, fr = lane & 15, fq = lane >> 4;
    const int nt = K / BK;
    unsigned voffB[2];
#pragma unroll
    for (int i = 0; i < 2; ++i) { int R, C; stage_rc(tid * 16 + i * 8192, R, C); const int Rb = Epi::PERM ? ((R & ~31) + perm32(R & 31)) : R; voffB[i] = (unsigned)(Rb * K + C) * 2u; }
    const size_t kstep = (size_t)(BK * 2);
    const size_t hstep = (size_t)HALF * K * 2;
    const unsigned ldsw = (unsigned)wid * 1024u;
    const int aoff = lds_byte(wr * 64 + fr, fq * 8), boff = lds_byte(wc * 32 + fr, fq * 8);
#define PG8_SA(b, h) (((b) * 2 + (h)) * HTB)
#define PG8_SB(b, h) ((4 + (b) * 2 + (h)) * HTB)
#define PG8_STAGE(bufoff, gbase, voff) do { _Pragma("unroll") for (int _i = 0; _i < 2; ++_i) \
        __builtin_amdgcn_global_load_lds((const unsigned*)((const char*)(gbase) + (voff)[_i]), (LAS unsigned*)(lds + (bufoff) + ldsw + _i * 8192), 16, 0, 0); } while (0)
#define PG8_LDA(dst, b, h) do { _Pragma("unroll") for (int m = 0; m < 4; ++m) _Pragma("unroll") for (int k = 0; k < 2; ++k) dst[m][k] = *(const LAS bf16x8*)(lds + PG8_SA(b, h) + aoff + m * 2048 + k * 1024); } while (0)
#define PG8_LDB(dst, b, h) do { _Pragma("unroll") for (int n = 0; n < 2; ++n) _Pragma("unroll") for (int k = 0; k < 2; ++k) dst[n][k] = *(const LAS bf16x8*)(lds + PG8_SB(b, h) + boff + n * 2048 + k * 1024); } while (0)
#define PG8_CAT(x, y) __builtin_shufflevector(__builtin_bit_cast(i32x4_t, x), __builtin_bit_cast(i32x4_t, y), 0, 1, 2, 3, 4, 5, 6, 7)
#define PG8_MMA(ai, bj, At, Bt) do { __builtin_amdgcn_s_setprio(1); _Pragma("unroll") for (int m = 0; m < 4; ++m) _Pragma("unroll") for (int n = 0; n < 2; ++n) { \
        if constexpr (F8) { const auto _a8 = PG8_CAT(Bt[n][0], Bt[n][1]); const auto _b8 = PG8_CAT(At[m][0], At[m][1]); \
          asm("v_mfma_scale_f32_16x16x128_f8f6f4 %0, %1, %2, %0, %3, %3 op_sel_hi:[0,0,0]" : "+v"(acc[ai][bj][m][n]) : "v"(_a8), "v"(_b8), "v"(mxs)); } \
        else { _Pragma("unroll") for (int k = 0; k < 2; ++k) acc[ai][bj][m][n] = __builtin_amdgcn_mfma_f32_16x16x32_bf16(Bt[n][k], At[m][k], acc[ai][bj][m][n], 0, 0, 0); } } \
        __builtin_amdgcn_s_setprio(0); } while (0)
#define PG8_WAIT_V(n) asm volatile("s_waitcnt vmcnt(" #n ")" ::: "memory")
#define PG8_WAIT_L(n) asm volatile("s_waitcnt lgkmcnt(" #n ")" ::: "memory")
#define PG8_BAR __builtin_amdgcn_s_barrier()
#define PG8_SCHED __builtin_amdgcn_sched_barrier(0)
    const int mxs = 0x7f7f7f7f;
    (void)mxs;
    Unit cur, nxt; int ui = 0;
    if (!S.next(0, cur)) return;
    unsigned vA[2][2], vN[2][2];
#define PG8_MKOFF(u, v) do { _Pragma("unroll") for (int _h = 0; _h < 2; ++_h) _Pragma("unroll") for (int _i = 0; _i < 2; ++_i) { int _R, _C; stage_rc(opaque_tid() * 16 + _i * 8192, _R, _C); \
        v[_h][_i] = (unsigned)((GATHER ? S.row(u, _h * HALF + _R) : (_h * HALF + _R)) * K + _C) * 2u; } } while (0)
    PG8_MKOFF(cur, vA);
    f32x4 acc[2][2][4][2];
#pragma unroll
    for (int a = 0; a < 2; ++a)
#pragma unroll
        for (int b = 0; b < 2; ++b)
#pragma unroll
            for (int m = 0; m < 4; ++m)
#pragma unroll
                for (int n = 0; n < 2; ++n) acc[a][b][m][n] = (f32x4){0.f, 0.f, 0.f, 0.f};
    bf16x8 At[4][2], B0[2][2], B1[2][2];
    const char* cA = cur.A; const char* cB = cur.B;
    PG8_STAGE(PG8_SB(0, 0), cB, voffB); PG8_STAGE(PG8_SB(0, 1), cB + hstep, voffB); PG8_STAGE(PG8_SA(0, 0), cA, vA[0]); PG8_STAGE(PG8_SA(0, 1), cA, vA[1]);
    if (wr == 1) PG8_BAR;
    PG8_WAIT_V(2); PG8_BAR;
    PG8_STAGE(PG8_SB(1, 0), cB + kstep, voffB); PG8_STAGE(PG8_SA(1, 0), cA + kstep, vA[0]); PG8_STAGE(PG8_SB(1, 1), cB + hstep + kstep, voffB);
    PG8_WAIT_V(6); PG8_BAR;
    for (;;) {
        const bool has_next = S.next(ui + 1, nxt);
        if (has_next) { PG8_MKOFF(nxt, vN); } else {
#pragma unroll
            for (int h = 0; h < 2; ++h)
#pragma unroll
                for (int i = 0; i < 2; ++i) vN[h][i] = vA[h][i]; }
        const char* nA = has_next ? nxt.A : cA; const char* nB = has_next ? nxt.B : cB;
        for (int t = 0; t < nt; t += 2) {
            const bool last = (t == nt - 2);
            const char* a1 = cA + (size_t)(t + 1) * kstep;
            const char* a2 = last ? nA : cA + (size_t)(t + 2) * kstep; const char* b2 = last ? nB : cB + (size_t)(t + 2) * kstep;
            const char* a3 = a2 + kstep; const char* b3 = b2 + kstep;
            unsigned w0[2], w1[2];
#pragma unroll
            for (int i = 0; i < 2; ++i) { w0[i] = last ? vN[0][i] : vA[0][i]; w1[i] = last ? vN[1][i] : vA[1][i]; }
            PG8_LDB(B0, 0, 0); PG8_LDB(B1, 0, 1); PG8_SCHED; PG8_LDA(At, 0, 0); PG8_STAGE(PG8_SA(1, 1), a1, vA[1]);
            PG8_WAIT_V(8); PG8_WAIT_L(0); PG8_BAR; PG8_MMA(0, 0, At, B0); PG8_MMA(0, 1, At, B1); PG8_BAR; PG8_SCHED;
            PG8_LDA(At, 0, 1); PG8_STAGE(PG8_SB(0, 0), b2, voffB); PG8_STAGE(PG8_SB(0, 1), b2 + hstep, voffB); PG8_STAGE(PG8_SA(0, 0), a2, w0);
            PG8_WAIT_V(8); PG8_WAIT_L(0); PG8_BAR; PG8_MMA(1, 0, At, B0); PG8_MMA(1, 1, At, B1); PG8_BAR; PG8_SCHED;
            PG8_LDB(B0, 1, 0); PG8_LDB(B1, 1, 1); PG8_SCHED; PG8_LDA(At, 1, 0); PG8_STAGE(PG8_SA(0, 1), a2, w1);
            PG8_WAIT_V(8); PG8_WAIT_L(0); PG8_BAR; PG8_MMA(0, 0, At, B0); PG8_MMA(0, 1, At, B1); PG8_BAR; PG8_SCHED;
            PG8_LDA(At, 1, 1); PG8_STAGE(PG8_SB(1, 0), b3, voffB); PG8_STAGE(PG8_SB(1, 1), b3 + hstep, voffB); PG8_STAGE(PG8_SA(1, 0), a3, w0);
            PG8_WAIT_V(8); PG8_WAIT_L(0); PG8_BAR; PG8_MMA(1, 0, At, B0); PG8_MMA(1, 1, At, B1); PG8_BAR; PG8_SCHED;
        }
        if constexpr (ALIGN_EPI) { if (wr == 0) PG8_BAR; }
        if constexpr (F8) asm volatile("s_nop 15\n\ts_nop 7" ::: "memory");
        E(acc, cur, wr, wc, fr, fq);
        if (!has_next) break;
#pragma unroll
        for (int a = 0; a < 2; ++a)
#pragma unroll
            for (int b = 0; b < 2; ++b)
#pragma unroll
                for (int m = 0; m < 4; ++m)
#pragma unroll
                    for (int n = 0; n < 2; ++n) acc[a][b][m][n] = (f32x4){0.f, 0.f, 0.f, 0.f};
        cur = nxt; cA = nA; cB = nB; ++ui;
#pragma unroll
        for (int h = 0; h < 2; ++h)
#pragma unroll
            for (int i = 0; i < 2; ++i) vA[h][i] = vN[h][i];
        if constexpr (ALIGN_EPI) { if (wr == 1) PG8_BAR; }
    }
    PG8_WAIT_V(0);
    if constexpr (!ALIGN_EPI) { if (wr == 0) PG8_BAR; }
    PG8_BAR;
#undef PG8_SA
#undef PG8_SB
#undef PG8_STAGE
#undef PG8_LDA
#undef PG8_LDB
#undef PG8_MMA
#undef PG8_CAT
#undef PG8_WAIT_V
#undef PG8_WAIT_L
#undef PG8_BAR
#undef PG8_SCHED
#undef PG8_MKOFF
}

struct SchedPlain {
    const char* A; const char* B; int nM, nN, nwg, G, c; size_t tstep;
    __device__ __forceinline__ SchedPlain(const void* A_, const void* B_, int M, int N, int K, int G_, int c_) : A((const char*)A_), B((const char*)B_), nM(M / BM), nN(N / BM), nwg((M / BM) * (N / BM)), G(G_), c(c_), tstep((size_t)BM * K * 2) {}
    __device__ __forceinline__ bool next(int i, Unit& u) const {
        const int L = i * G + c; if (L >= nwg) return false;
        const int wgid = xcd_remap(L, nwg);
        const int nig = WGM * nN, gid = wgid / nig, fm = gid * WGM, gsz = (nM - fm) < WGM ? (nM - fm) : WGM;
        u.pm = fm + ((wgid % nig) % gsz); u.pn = (wgid % nig) / gsz; u.e = 0; u.aux = 0;
        u.A = A + (size_t)u.pm * tstep; u.B = B + (size_t)u.pn * tstep; return true;
    }
    __device__ __forceinline__ int row(const Unit&, int r) const { return r; }
};
}

struct RowIdent { int base; __device__ __forceinline__ int operator()(int r) const { return base + r; } };

template <bool PERM_> struct EpiProj {
  static constexpr bool PERM = PERM_;
  unsigned char* ws; int pn_base;
  __device__ __forceinline__ void operator()(const f32x4 (&acc)[2][2][4][2], const pg8::Unit& u, int wr, int wc, int fr, int fq) const {
    const int pm = u.pm, pn = u.pn + pn_base;
    bf16_t* dst; int ld, cb; float* ssq = nullptr; int nss = 0, sidx = 0; int climit = 256; float osc = 1.0f;
    if (pn < 3) { dst = (bf16_t*)(ws + R_QLAT); ld = 768; cb = 256 * pn; ssq = (float*)(ws + WS_SSQ); nss = 12; sidx = 4 * pn + wc; }
    else if (pn < 5) { dst = (bf16_t*)(ws + R_KVLAT); ld = 512; cb = 256 * (pn - 3); ssq = (float*)(ws + WS_SSQ + 512 * 1024); nss = 8; sidx = 4 * (pn - 3) + wc; }
    else if (pn == 5) { dst = (bf16_t*)(ws + R_KPE); ld = 64; cb = 0; climit = 64; }
    else if (pn < 10) { dst = (bf16_t*)(ws + R_DQ); ld = 1024; cb = 256 * (pn - 6); osc = 0.125f * 1.4426950408889634f; }
    else if (pn < 14) { dst = (bf16_t*)(ws + R_DK); ld = 1024; cb = 256 * (pn - 10); }
    else { dst = (bf16_t*)(ws + R_DV); ld = 1024; cb = 256 * (pn - 14); }
#pragma unroll
    for (int ai = 0; ai < 2; ++ai)
#pragma unroll
      for (int m = 0; m < 4; ++m) {
        const int row = 256 * pm + acc_row(ai, wr, m, fr); float ss = 0.f;
#pragma unroll
        for (int bj = 0; bj < 2; ++bj) {
#pragma unroll
          for (int n = 0; n < 2; ++n) {
            const f32x4 v = acc[ai][bj][m][n];
            ss += v.x * v.x + v.y * v.y + v.z * v.z + v.w * v.w;
            if (!PERM) { const int c0 = acc_col<PERM>(bj, wc, n, fq); if (c0 < climit) { u32x2 o; o.x = cvtpk2(v.x * osc, v.y * osc); o.y = cvtpk2(v.z * osc, v.w * osc); *(u32x2*)(dst + (size_t)row * ld + cb + c0) = o; } }
          }
          if (PERM) { const int c0 = acc_col<PERM>(bj, wc, 0, fq); if (c0 < climit) *(u32x4*)(dst + (size_t)row * ld + cb + c0) = pack8(acc[ai][bj][m][0] * osc, acc[ai][bj][m][1] * osc); }
        }
        if (ssq) { ss += __shfl_xor(ss, 16); ss += __shfl_xor(ss, 32); if (fq == 0) ssq[(size_t)row * nss + sidx] = ss; }
      }
  }
};

template <bool PERM_> struct EpiRowScale {
  static constexpr bool PERM = PERM_;
  bf16_t* dst; int ld; const float* ssq; int nss; float invk; float post;
  __device__ __forceinline__ void operator()(const f32x4 (&acc)[2][2][4][2], const pg8::Unit& u, int wr, int wc, int fr, int fq) const {
    const int pm = u.pm, pn = u.pn;
#pragma unroll
    for (int ai = 0; ai < 2; ++ai)
#pragma unroll
      for (int m = 0; m < 4; ++m) {
        const int row = 256 * pm + acc_row(ai, wr, m, fr); float ss = 0.f;
        for (int i = 0; i < nss; ++i) ss += ssq[(size_t)row * nss + i];
        const float rstd = post / sqrtf(ss * invk + EPS);
#pragma unroll
        for (int bj = 0; bj < 2; ++bj) {
          if (PERM) *(u32x4*)(dst + (size_t)row * ld + 256 * pn + acc_col<PERM>(bj, wc, 0, fq)) = pack8(acc[ai][bj][m][0] * rstd, acc[ai][bj][m][1] * rstd);
          else {
#pragma unroll
            for (int n = 0; n < 2; ++n) {
              const f32x4 v = acc[ai][bj][m][n] * rstd; const int c0 = acc_col<PERM>(bj, wc, n, fq);
              u32x2 o; o.x = cvtpk2(v.x, v.y); o.y = cvtpk2(v.z, v.w); *(u32x2*)(dst + (size_t)row * ld + 256 * pn + c0) = o;
            }
          }
        }
      }
  }
};

template <bool PERM_> struct EpiF32 {
  static constexpr bool PERM = PERM_;
  float* dst; int ld;
  __device__ __forceinline__ void operator()(const f32x4 (&acc)[2][2][4][2], const pg8::Unit& u, int wr, int wc, int fr, int fq) const {
    const int pm = u.pm, pn = u.pn;
#pragma unroll
    for (int ai = 0; ai < 2; ++ai)
#pragma unroll
      for (int m = 0; m < 4; ++m) {
        const int row = 256 * pm + acc_row(ai, wr, m, fr);
#pragma unroll
        for (int bj = 0; bj < 2; ++bj)
#pragma unroll
          for (int n = 0; n < 2; ++n) *(f32x4*)(dst + (size_t)row * ld + 256 * pn + acc_col<PERM>(bj, wc, n, fq)) = acc[ai][bj][m][n];
      }
  }
};

template <bool PERM_> struct EpiBf16 {
  static constexpr bool PERM = PERM_;
  bf16_t* dst; int ld;
  __device__ __forceinline__ void operator()(const f32x4 (&acc)[2][2][4][2], const pg8::Unit& u, int wr, int wc, int fr, int fq) const {
    const int pm = u.pm, pn = u.pn;
#pragma unroll
    for (int ai = 0; ai < 2; ++ai)
#pragma unroll
      for (int m = 0; m < 4; ++m) {
        const int row = 256 * pm + acc_row(ai, wr, m, fr);
#pragma unroll
        for (int bj = 0; bj < 2; ++bj) {
          if (PERM) *(u32x4*)(dst + (size_t)row * ld + 256 * pn + acc_col<PERM>(bj, wc, 0, fq)) = pack8(acc[ai][bj][m][0], acc[ai][bj][m][1]);
          else {
#pragma unroll
            for (int n = 0; n < 2; ++n) { const f32x4 v = acc[ai][bj][m][n]; u32x2 o; o.x = cvtpk2(v.x, v.y); o.y = cvtpk2(v.z, v.w); *(u32x2*)(dst + (size_t)row * ld + 256 * pn + acc_col<PERM>(bj, wc, n, fq)) = o; }
          }
        }
      }
  }
};

template <bool PERM_> struct EpiSwiglu {
  static constexpr bool PERM = PERM_;
  bf16_t* act; float insc;
  __device__ __forceinline__ void operator()(const f32x4 (&acc)[2][2][4][2], const pg8::Unit& u, int wr, int wc, int fr, int fq) const {
    const int arow0 = 256 * u.pm, pn = u.pn;
#pragma unroll
    for (int ai = 0; ai < 2; ++ai)
#pragma unroll
      for (int m = 0; m < 4; ++m) {
        const int row = arow0 + acc_row(ai, wr, m, fr);
        f32x4 av[2];
#pragma unroll
        for (int n = 0; n < 2; ++n) {
          const f32x4 g = acc[ai][0][m][n] * insc, u = acc[ai][1][m][n] * insc; f32x4 a;
          a.x = g.x / (1.f + __expf(-g.x)) * u.x; a.y = g.y / (1.f + __expf(-g.y)) * u.y; a.z = g.z / (1.f + __expf(-g.z)) * u.z; a.w = g.w / (1.f + __expf(-g.w)) * u.w;
          av[n] = a;
          if (!PERM) *(unsigned*)((unsigned char*)act + (size_t)row * 512 + 128 * pn + acc_col<PERM>(0, wc, n, fq)) = pack8_fp8(a, a).x;
        }
        if (PERM) *(u32x2*)((unsigned char*)act + (size_t)row * 512 + 128 * pn + acc_col<PERM>(0, wc, 0, fq)) = pack8_fp8(av[0], av[1]);
      }
  }
};

template <bool PERM_> struct EpiRowsFp8 {
  static constexpr bool PERM = PERM_;
  unsigned char* yp; float insc;
  __device__ __forceinline__ void operator()(const f32x4 (&acc)[2][2][4][2], const pg8::Unit& u, int wr, int wc, int fr, int fq) const {
    const int pn = u.pn;
#pragma unroll
    for (int ai = 0; ai < 2; ++ai)
#pragma unroll
      for (int m = 0; m < 4; ++m) {
        const size_t row = (size_t)256 * u.pm + acc_row(ai, wr, m, fr);
#pragma unroll
        for (int bj = 0; bj < 2; ++bj) {
          if (PERM) *(u32x2*)(yp + row * 2048 + 256 * pn + acc_col<PERM>(bj, wc, 0, fq)) = pack8_fp8(acc[ai][bj][m][0] * insc, acc[ai][bj][m][1] * insc);
          else {
#pragma unroll
            for (int n = 0; n < 2; ++n) { const f32x4 v = acc[ai][bj][m][n] * insc; const u32x2 o = pack8_fp8(v, v); *(unsigned*)(yp + row * 2048 + 256 * pn + acc_col<PERM>(bj, wc, n, fq)) = o.x; }
          }
        }
      }
  }
};

__device__ __forceinline__ void rotary_rows(const Params& p) {
  const int tid = opaque_tid(), lane = tid & 63, wave = tid >> 6;
  const int gw = blockIdx.x * NWAVES + wave, NGW = gridDim.x * NWAVES;
  unsigned char* ws = p.ws;
  bf16_t* dq = (bf16_t*)(ws + R_DQ); bf16_t* dk = (bf16_t*)(ws + R_DK); bf16_t* kpe = (bf16_t*)(ws + R_KPE);
  const f32x2* rd = (const f32x2*)(ws + WS_ROPED); const f32x2* rm = (const f32x2*)(ws + WS_ROPEM);
  for (int row = gw; row < T; row += NGW) {
#pragma unroll
    for (int h = 0; h < 2; ++h) {
      const int pr = lane + 64 * h, comp = pr >> 3, i = pr & 7;
      const f32x2 cs = rd[row * 8 + i];
      const size_t i1 = (size_t)row * 1024 + comp * 64 + i, i2 = i1 + 8;
      { const float x1 = bf1(dq[i1]), x2 = bf1(dq[i2]); dq[i1] = (bf16_t)f2bf(x1 * cs.x - x2 * cs.y); dq[i2] = (bf16_t)f2bf(x2 * cs.x + x1 * cs.y); }
      { const float x1 = bf1(dk[i1]), x2 = bf1(dk[i2]); dk[i1] = (bf16_t)f2bf(x1 * cs.x - x2 * cs.y); dk[i2] = (bf16_t)f2bf(x2 * cs.x + x1 * cs.y); }
    }
    if (lane < 32) {
      const f32x2 cs = rm[row * 32 + lane];
      const size_t i1 = (size_t)row * 64 + lane, i2 = i1 + 32;
      const float x1 = bf1(kpe[i1]), x2 = bf1(kpe[i2]); kpe[i1] = (bf16_t)f2bf(x1 * cs.x - x2 * cs.y); kpe[i2] = (bf16_t)f2bf(x2 * cs.x + x1 * cs.y);
    }
  }
}

__device__ __forceinline__ void attn_mla_naive(const Params& p, int h, int ci, int vq, int lane) {
  unsigned char* ws = p.ws;
  const bf16_t* qm = (const bf16_t*)(ws + R_QM); const bf16_t* kvm = (const bf16_t*)(ws + R_KVM); const bf16_t* kpe = (const bf16_t*)(ws + R_KPE);
  const f32x2* rm = (const f32x2*)(ws + WS_ROPEM);
  const int t = 64 * ci + lane;
  unsigned qn[64], qp[32];
  { const u32x4* q4 = (const u32x4*)(qm + (size_t)t * NQ + 192 * h);
#pragma unroll
    for (int i = 0; i < 16; ++i) { const u32x4 v = q4[i]; qn[4 * i] = v.x; qn[4 * i + 1] = v.y; qn[4 * i + 2] = v.z; qn[4 * i + 3] = v.w; }
#pragma unroll
    for (int i = 0; i < 8; ++i) { const u32x4 v = q4[16 + i]; qp[4 * i] = v.x; qp[4 * i + 1] = v.y; qp[4 * i + 2] = v.z; qp[4 * i + 3] = v.w; }
#pragma unroll
    for (int w = 0; w < 16; ++w) {
      const f32x2 c0 = rm[t * 32 + 2 * w], c1 = rm[t * 32 + 2 * w + 1];
      const float a0 = bf_lo(qp[w]), a1 = bf_hi(qp[w]), b0 = bf_lo(qp[w + 16]), b1 = bf_hi(qp[w + 16]);
      qp[w] = pk2(a0 * c0.x - b0 * c0.y, a1 * c1.x - b1 * c1.y);
      qp[w + 16] = pk2(b0 * c0.x + a0 * c0.y, b1 * c1.x + a1 * c1.y);
    }
  }
  const float scale = 0.07216878364870322f;
  float mx = -INFINITY, l = 0.f, o[32];
#pragma unroll
  for (int j = 0; j < 32; ++j) o[j] = 0.f;
  const int nk = 64 * (ci + 1);
  for (int key = 0; key < nk; ++key) {
    const u32x4* k4 = (const u32x4*)(kvm + (size_t)key * NKV + 256 * h);
    const u32x4* p4 = (const u32x4*)(kpe + (size_t)key * 64);
    float s = 0.f;
#pragma unroll
    for (int i = 0; i < 16; ++i) { const u32x4 v = k4[i]; s = dot2bf(qn[4 * i], v.x, s); s = dot2bf(qn[4 * i + 1], v.y, s); s = dot2bf(qn[4 * i + 2], v.z, s); s = dot2bf(qn[4 * i + 3], v.w, s); }
#pragma unroll
    for (int i = 0; i < 8; ++i) { const u32x4 v = p4[i]; s = dot2bf(qp[4 * i], v.x, s); s = dot2bf(qp[4 * i + 1], v.y, s); s = dot2bf(qp[4 * i + 2], v.z, s); s = dot2bf(qp[4 * i + 3], v.w, s); }
    s *= scale;
    if (s > mx) { const float f = __expf(mx - s); l *= f;
#pragma unroll
      for (int j = 0; j < 32; ++j) o[j] *= f;
      mx = s; }
    const float pe = __expf(s - mx); l += pe;
    const u32x4* v4 = (const u32x4*)(kvm + (size_t)key * NKV + 256 * h + 128 + 32 * vq);
#pragma unroll
    for (int i = 0; i < 4; ++i) { const u32x4 v = v4[i];
      o[8 * i] += pe * bf_lo(v.x); o[8 * i + 1] += pe * bf_hi(v.x); o[8 * i + 2] += pe * bf_lo(v.y); o[8 * i + 3] += pe * bf_hi(v.y);
      o[8 * i + 4] += pe * bf_lo(v.z); o[8 * i + 5] += pe * bf_hi(v.z); o[8 * i + 6] += pe * bf_lo(v.w); o[8 * i + 7] += pe * bf_hi(v.w); }
  }
  const float il = 1.0f / l;
  bf16_t* oa = (bf16_t*)(ws + R_OATT) + (size_t)t * 2048 + 128 * h + 32 * vq;
#pragma unroll
  for (int i = 0; i < 4; ++i) { u32x4 w; w.x = pk2(o[8 * i] * il, o[8 * i + 1] * il); w.y = pk2(o[8 * i + 2] * il, o[8 * i + 3] * il); w.z = pk2(o[8 * i + 4] * il, o[8 * i + 5] * il); w.w = pk2(o[8 * i + 6] * il, o[8 * i + 7] * il);
    ((u32x4*)oa)[i] = w; }
}
__device__ __forceinline__ void attn_diff_naive(const Params& p, int h, int c, int ci, int vh, int lane) {
  unsigned char* ws = p.ws;
  const bf16_t* dq = (const bf16_t*)(ws + R_DQ); const bf16_t* dk = (const bf16_t*)(ws + R_DK); const bf16_t* dv = (const bf16_t*)(ws + R_DV);
  const int t = 64 * ci + lane;
  unsigned q[32];
  { const u32x4* q4 = (const u32x4*)(dq + (size_t)t * 1024 + 128 * h + 64 * c);
#pragma unroll
    for (int i = 0; i < 8; ++i) { const u32x4 v = q4[i]; q[4 * i] = v.x; q[4 * i + 1] = v.y; q[4 * i + 2] = v.z; q[4 * i + 3] = v.w; } }
  const float scale = 0.125f;
  float mx = -INFINITY, l = 0.f, o[64];
#pragma unroll
  for (int j = 0; j < 64; ++j) o[j] = 0.f;
  const int nk = 64 * (ci + 1);
  for (int key = 0; key < nk; ++key) {
    const u32x4* k4 = (const u32x4*)(dk + (size_t)key * 1024 + 128 * h + 64 * c);
    float s = 0.f;
#pragma unroll
    for (int i = 0; i < 8; ++i) { const u32x4 v = k4[i]; s = dot2bf(q[4 * i], v.x, s); s = dot2bf(q[4 * i + 1], v.y, s); s = dot2bf(q[4 * i + 2], v.z, s); s = dot2bf(q[4 * i + 3], v.w, s); }
    s *= scale;
    if (s > mx) { const float f = __expf(mx - s); l *= f;
#pragma unroll
      for (int j = 0; j < 64; ++j) o[j] *= f;
      mx = s; }
    const float pe = __expf(s - mx); l += pe;
    const u32x4* v4 = (const u32x4*)(dv + (size_t)key * 1024 + 128 * h + 64 * vh);
#pragma unroll
    for (int i = 0; i < 8; ++i) { const u32x4 v = v4[i];
      o[8 * i] += pe * bf_lo(v.x); o[8 * i + 1] += pe * bf_hi(v.x); o[8 * i + 2] += pe * bf_lo(v.y); o[8 * i + 3] += pe * bf_hi(v.y);
      o[8 * i + 4] += pe * bf_lo(v.z); o[8 * i + 5] += pe * bf_hi(v.z); o[8 * i + 6] += pe * bf_lo(v.w); o[8 * i + 7] += pe * bf_hi(v.w); }
  }
  const float il = 1.0f / l;
  float* oc = (float*)(ws + R_OC) + (size_t)c * T * 1024 + (size_t)t * 1024 + 128 * h + 64 * vh;
#pragma unroll
  for (int i = 0; i < 16; ++i) ((f32x4*)oc)[i] = (f32x4){o[4 * i] * il, o[4 * i + 1] * il, o[4 * i + 2] * il, o[4 * i + 3] * il};
}
__device__ __forceinline__ void phase3_naive(const Params& p) {
  const int tid = opaque_tid(), lane = tid & 63, wave = tid >> 6;
  const int gw = blockIdx.x * NWAVES + wave, NGW = gridDim.x * NWAVES;
  for (int u = gw; u < 4096; u += NGW) {
    const int uu = (u < 2048) ? u : (6143 - u);
    const int ci = uu & 127, hv = uu >> 7;
    attn_mla_naive(p, hv >> 2, ci, hv & 3, lane);
  }
  for (int u = gw; u < 4096; u += NGW) {
    const int uu = (u < 2048) ? u : (6143 - u);
    const int ci = uu & 127, r = uu >> 7;
    attn_diff_naive(p, r >> 2, (r >> 1) & 1, ci, r & 1, lane);
  }
}
__device__ __forceinline__ void phase3b_naive(const Params& p) {
  const int tid = opaque_tid(), lane = tid & 63, wave = tid >> 6;
  const int gw = blockIdx.x * NWAVES + wave, NGW = gridDim.x * NWAVES;
  unsigned char* ws = p.ws;
  const float lam = ((const float*)(ws + WS_MOD))[16384];
  const float* oc0 = (const float*)(ws + R_OC); const float* oc1 = oc0 + (size_t)T * 1024;
  const float* gsub = p.in[14];
  bf16_t* oa = (bf16_t*)(ws + R_OATT);
  for (int it = gw; it < T * 8; it += NGW) {
    const int t = it >> 3, h = it & 7;
    const size_t off = (size_t)t * 1024 + 128 * h + 2 * lane;
    const f32x2 a = *(const f32x2*)(oc0 + off), b = *(const f32x2*)(oc1 + off);
    const float v0 = a.x - lam * b.x, v1 = a.y - lam * b.y;
    const float rstd = 1.0f / sqrtf(wave_sum(v0 * v0 + v1 * v1) * (1.0f / 128.0f) + EPS);
    const f32x2 g = *(const f32x2*)(gsub + 2 * lane);
    *(unsigned*)(oa + (size_t)t * 2048 + 1024 + 128 * h + 2 * lane) = pk2(v0 * rstd * g.x * 0.8f, v1 * rstd * g.y * 0.8f);
  }
}


namespace fa {
typedef float f32x16 __attribute__((ext_vector_type(16)));
typedef short v4i16_t __attribute__((ext_vector_type(4)));
constexpr int VBYTES = 16384, WSF_OFF = 122880;
constexpr float THR = 8.0f;
__device__ __forceinline__ int crow(int r, int hi) { return (r & 3) + 8 * (r >> 2) + 4 * hi; }
__device__ __forceinline__ unsigned cvtpk(float lo, float hi) { f32x2 v = {lo, hi}; bf16x2_t b = __builtin_convertvector(v, bf16x2_t); return __builtin_bit_cast(unsigned, b); }
__device__ __forceinline__ void glds16(const void* gsrc, unsigned lds_dst) { unsigned keep;
  asm volatile("s_mov_b32 %0, m0\n\ts_mov_b32 m0, %2\n\ts_nop 0\n\tglobal_load_lds_dwordx4 %1, off\n\ts_mov_b32 m0, %0" : "=&s"(keep) : "v"(gsrc), "s"(lds_dst) : "memory"); }
__device__ __forceinline__ float max3f(float a, float b, float c) { float r; asm("v_max3_f32 %0, %1, %2, %3" : "=v"(r) : "v"(a), "v"(b), "v"(c)); return r; }
__device__ __forceinline__ float max2f(float a, float b) { float r; asm("v_max_f32_e32 %0, %1, %2" : "=v"(r) : "v"(a), "v"(b)); return r; }
__device__ __forceinline__ float fadd_s(float a, float b) { float r; asm("v_add_f32_e32 %0, %1, %2" : "=v"(r) : "v"(a), "v"(b)); return r; }
struct Src { const char* kb0; unsigned kp0; const char* kb1; unsigned kp1; const char* vb; unsigned vp; };

template <int NKC  >
__device__ __forceinline__ void attn_pass(LAS unsigned char* lds, const Src& S, const bf16x8* qf, const float qscale, const int NT, const int NTW, f32x16 (&o)[4], float& l_out) {
  constexpr int NKS = NKC * 4, KBYTES = NKC * 8192, STAGE = KBYTES + VBYTES;
  const int tid = opaque_tid(), lane = tid & 63, wid = __builtin_amdgcn_readfirstlane(tid >> 6), r32 = lane & 31, hi = lane >> 5;
  unsigned koff[NKC], voff[2]; unsigned kdst[NKC], vdst[2];
#pragma unroll
  for (int i = 0; i < NKC; ++i) {
    if (NKC == 3 && i == 2) { koff[i] = (unsigned)lane * S.kp1 + (unsigned)wid * 16u; kdst[i] = (unsigned)(16 + wid) * 1024u; }
    else { koff[i] = (unsigned)lane * S.kp0 + (unsigned)(wid + 8 * i) * 16u; kdst[i] = (unsigned)(wid + 8 * i) * 1024u; }
  }
#pragma unroll
  for (int i = 0; i < 2; ++i) { const int ii = 2 * wid + i, b = ii >> 2, kg = ii & 3; voff[i] = (unsigned)(16 * kg + (lane >> 2)) * S.vp + (unsigned)(32 * b + 8 * (lane & 3)) * 2u; vdst[i] = (unsigned)KBYTES + (unsigned)b * 4096u + (unsigned)kg * 1024u; }
#define FA_ISSUE(j, st) do { const size_t _j = (size_t)(j) * 64; const unsigned _so = (unsigned)(st) * STAGE; \
    _Pragma("unroll") for (int _i = 0; _i < NKC; ++_i) { const char* _b = (NKC == 3 && _i == 2) ? S.kb1 + _j * S.kp1 : S.kb0 + _j * S.kp0; \
      __builtin_amdgcn_global_load_lds((const unsigned*)(_b + koff[_i]), (LAS unsigned*)(lds + _so + kdst[_i]), 16, 0, 0); } \
    _Pragma("unroll") for (int _i = 0; _i < 2; ++_i) __builtin_amdgcn_global_load_lds((const unsigned*)(S.vb + _j * S.vp + voff[_i]), (LAS unsigned*)(lds + _so + vdst[_i]), 16, 0, 0); } while (0)
  LAS float* wsf = (LAS float*)(lds + WSF_OFF) + wid * 64;
  float m_ref = -INFINITY, l_part = 0.f;
#pragma unroll
  for (int b = 0; b < 4; ++b)
#pragma unroll
    for (int r = 0; r < 16; ++r) o[b][r] = 0.f;
  const unsigned kread = (unsigned)hi * 1024u + (unsigned)r32 * 16u;
  const unsigned vread = (unsigned)KBYTES + (unsigned)(((lane >> 4) & 1) * 32 + (lane & 3) * 8 + (4 * hi + ((lane & 15) >> 2)) * 64);
  FA_ISSUE(0, 0);
  if (NT > 1) FA_ISSUE(1, 1);
  int st = 0;
  for (int j = 0; j < NT; ++j) {
    if (j + 1 < NT) { if (NKC == 3) asm volatile("s_waitcnt vmcnt(5)" ::: "memory"); else asm volatile("s_waitcnt vmcnt(3)" ::: "memory"); }
    else asm volatile("s_waitcnt vmcnt(0)" ::: "memory");
    asm volatile("s_waitcnt lgkmcnt(0)\n\ts_barrier" ::: "memory");
    if (j + 2 < NT) { const int st2 = (st + 2 >= 3) ? st - 1 : st + 2; FA_ISSUE(j + 2, st2); }
    if (j < NTW) {
      const LAS unsigned char* kb = lds + (unsigned)st * STAGE + kread;
      f32x16 p0, p1;
#pragma unroll
      for (int r = 0; r < 16; ++r) { p0[r] = 0.f; p1[r] = 0.f; }
#pragma unroll
      for (int d0 = 0; d0 < NKS; ++d0) {
        const bf16x8 k0 = *(const LAS bf16x8*)(kb + d0 * 2048);
        const bf16x8 k1 = *(const LAS bf16x8*)(kb + d0 * 2048 + 512);
        p0 = __builtin_amdgcn_mfma_f32_32x32x16_bf16(k0, qf[d0], p0, 0, 0, 0);
        p1 = __builtin_amdgcn_mfma_f32_32x32x16_bf16(k1, qf[d0], p1, 0, 0, 0);
      }
      float rm = __builtin_fmaxf(p0[0], p1[0]);
#pragma unroll
      for (int r = 1; r < 16; ++r) rm = __builtin_fmaxf(rm, __builtin_fmaxf(p0[r], p1[r]));
      { auto rr = __builtin_amdgcn_permlane32_swap(__float_as_uint(rm), __float_as_uint(rm), false, false); rm = __builtin_fmaxf(__uint_as_float(rr[0]), __uint_as_float(rr[1])); }
      rm *= qscale;
      if (__any(rm > m_ref + THR)) {
        const float m_new = __builtin_fmaxf(m_ref, rm);
        const float alpha = __builtin_amdgcn_exp2f(m_ref - m_new);
        l_part *= alpha; m_ref = m_new;
        if (hi == 0) wsf[r32] = alpha;
        asm volatile("s_waitcnt lgkmcnt(0)" ::: "memory");
#pragma unroll
        for (int r = 0; r < 16; ++r) { const float a = wsf[crow(r, hi)];
#pragma unroll
          for (int b = 0; b < 4; ++b) o[b][r] *= a; }
      }
      float ls = 0.f;
#pragma unroll
      for (int r = 0; r < 16; ++r) { p0[r] = __builtin_amdgcn_exp2f(p0[r] * qscale - m_ref); p1[r] = __builtin_amdgcn_exp2f(p1[r] * qscale - m_ref); ls += p0[r] + p1[r]; }
      l_part += ls;
      u32x4 pw[4];
      pw[0] = (u32x4){cvtpk(p0[0], p0[1]), cvtpk(p0[2], p0[3]), cvtpk(p0[4], p0[5]), cvtpk(p0[6], p0[7])};
      pw[1] = (u32x4){cvtpk(p0[8], p0[9]), cvtpk(p0[10], p0[11]), cvtpk(p0[12], p0[13]), cvtpk(p0[14], p0[15])};
      pw[2] = (u32x4){cvtpk(p1[0], p1[1]), cvtpk(p1[2], p1[3]), cvtpk(p1[4], p1[5]), cvtpk(p1[6], p1[7])};
      pw[3] = (u32x4){cvtpk(p1[8], p1[9]), cvtpk(p1[10], p1[11]), cvtpk(p1[12], p1[13]), cvtpk(p1[14], p1[15])};
      const LAS unsigned char* vbp = lds + (unsigned)st * STAGE + vread;
#pragma unroll
      for (int ks = 0; ks < 4; ++ks)
#pragma unroll
        for (int b = 0; b < 4; ++b) {
          const v4i16_t lo = __builtin_amdgcn_ds_read_tr16_b64_v4i16((LAS v4i16_t*)(vbp + b * 4096 + ks * 1024));
          const v4i16_t hh = __builtin_amdgcn_ds_read_tr16_b64_v4i16((LAS v4i16_t*)(vbp + b * 4096 + ks * 1024 + 512));
          const bf16x8 vf = (bf16x8){lo[0], lo[1], lo[2], lo[3], hh[0], hh[1], hh[2], hh[3]};
          o[b] = __builtin_amdgcn_mfma_f32_32x32x16_bf16(__builtin_bit_cast(bf16x8, pw[ks]), vf, o[b], 0, 0, 0);
        }
    }
    st = (st == 2) ? 0 : st + 1;
  }
  asm volatile("s_waitcnt lgkmcnt(0)\n\ts_barrier" ::: "memory");
  { auto rr = __builtin_amdgcn_permlane32_swap(__float_as_uint(l_part), __float_as_uint(l_part), false, false); l_out = __uint_as_float(rr[0]) + __uint_as_float(rr[1]); }
#undef FA_ISSUE
}


template <int NKC>
__device__ __forceinline__ void attn_pass3(LAS unsigned char* lds, const Src& S, const bf16x8* qf, const float qscale, const int NT, const int NTW, f32x16 (&o)[4], float& l_out) {
  constexpr int NKS = NKC * 4, KBYTES = NKC * 8192, STAGE = KBYTES + VBYTES;
  const int tid = opaque_tid(), lane = tid & 63, wid = __builtin_amdgcn_readfirstlane(tid >> 6), r32 = lane & 31, hi = lane >> 5;
  unsigned koff[NKC], voff[2]; unsigned kdst[NKC], vdst[2];
#pragma unroll
  for (int i = 0; i < NKC; ++i) {
    if (NKC == 3 && i < 2) { const int pi = wid + 8 * i, row = 4 * pi + (lane >> 4); koff[i] = (unsigned)row * S.kp0 + (unsigned)(((lane & 15) ^ (row & 15)) * 16); kdst[i] = (unsigned)pi * 1024u; }
    else { const int row = 8 * wid + (lane >> 3); const unsigned kp = (NKC == 3) ? S.kp1 : S.kp0; koff[i] = (unsigned)row * kp + (unsigned)(((lane & 7) ^ ((row >> 1) & 7)) * 16); kdst[i] = (NKC == 3 ? 16384u : 0u) + (unsigned)wid * 1024u; }
  }
#pragma unroll
  for (int i = 0; i < 2; ++i) { const int ii = 2 * wid + i, b = ii >> 2, kg = ii & 3; voff[i] = (unsigned)(16 * kg + (lane >> 2)) * S.vp + (unsigned)(32 * b + 8 * (lane & 3)) * 2u; vdst[i] = (unsigned)KBYTES + (unsigned)b * 4096u + (unsigned)kg * 1024u; }
#define FA_ISSUE(j, st) do { const size_t _j = (size_t)(j) * 64; const unsigned _so = lds0 + (unsigned)(st) * STAGE; \
    _Pragma("unroll") for (int _i = 0; _i < NKC; ++_i) { const char* _b = (NKC == 3 && _i == 2) ? S.kb1 + _j * S.kp1 : S.kb0 + _j * S.kp0; \
      glds16(_b + koff[_i], (unsigned)__builtin_amdgcn_readfirstlane(_so + kdst[_i])); } \
    _Pragma("unroll") for (int _i = 0; _i < 2; ++_i) glds16(S.vb + _j * S.vp + voff[_i], (unsigned)__builtin_amdgcn_readfirstlane(_so + vdst[_i])); } while (0)
#define FA_EXP8(P, base, PW) do { float _e[8]; _Pragma("unroll") for (int _i = 0; _i < 8; ++_i) { _e[_i] = __builtin_amdgcn_exp2f(P[(base) + _i]); } \
      l_part = fadd_s(l_part, fadd_s(fadd_s(fadd_s(_e[0], _e[1]), fadd_s(_e[2], _e[3])), fadd_s(fadd_s(_e[4], _e[5]), fadd_s(_e[6], _e[7])))); \
      PW = (u32x4){cvtpk(_e[0], _e[1]), cvtpk(_e[2], _e[3]), cvtpk(_e[4], _e[5]), cvtpk(_e[6], _e[7])}; } while (0)
#define FA_VRD1(L, H, va, off) asm volatile("ds_read_b64_tr_b16 %0, %2 offset:%c3\n\tds_read_b64_tr_b16 %1, %2 offset:%c4" : "=&v"(L), "=&v"(H) : "v"(va), "i"(off), "i"((off) + 512) : "memory")
#define FA_VRD8(VL, VH, va, ks0) do { _Pragma("unroll") for (int _b = 0; _b < 4; ++_b) { FA_VRD1(VL[_b], VH[_b], va, _b * 4096 + (ks0) * 1024); } \
      _Pragma("unroll") for (int _b = 0; _b < 4; ++_b) { FA_VRD1(VL[4 + _b], VH[4 + _b], va, _b * 4096 + ((ks0) + 1) * 1024); } } while (0)
#define FA_FRAG(VL, VH, i) (bf16x8){VL[i][0], VL[i][1], VL[i][2], VL[i][3], VH[i][0], VH[i][1], VH[i][2], VH[i][3]}
#define FA_PV8(PWA, PWB, VL, VH) do { _Pragma("unroll") for (int _b = 0; _b < 4; ++_b) o[_b] = __builtin_amdgcn_mfma_f32_32x32x16_bf16(__builtin_bit_cast(bf16x8, PWA), FA_FRAG(VL, VH, _b), o[_b], 0, 0, 0); \
      _Pragma("unroll") for (int _b = 0; _b < 4; ++_b) o[_b] = __builtin_amdgcn_mfma_f32_32x32x16_bf16(__builtin_bit_cast(bf16x8, PWB), FA_FRAG(VL, VH, 4 + _b), o[_b], 0, 0, 0); } while (0)
#define FA_PV(PW, vbp, ks) do { _Pragma("unroll") for (int _b = 0; _b < 4; ++_b) { \
      const v4i16_t lo = __builtin_amdgcn_ds_read_tr16_b64_v4i16((LAS v4i16_t*)((vbp) + _b * 4096 + (ks) * 1024)); \
      const v4i16_t hh = __builtin_amdgcn_ds_read_tr16_b64_v4i16((LAS v4i16_t*)((vbp) + _b * 4096 + (ks) * 1024 + 512)); \
      const bf16x8 vf = (bf16x8){lo[0], lo[1], lo[2], lo[3], hh[0], hh[1], hh[2], hh[3]}; \
      o[_b] = __builtin_amdgcn_mfma_f32_32x32x16_bf16(__builtin_bit_cast(bf16x8, PW), vf, o[_b], 0, 0, 0); } } while (0)
  const unsigned lds0 = (unsigned)(uintptr_t)lds;
  LAS float* wsf = (LAS float*)(lds + WSF_OFF) + wid * 64;
  float m_ref = 0.f, l_part = 0.f;
  f32x16 negm;
#pragma unroll
  for (int r = 0; r < 16; ++r) negm[r] = 0.f;
#pragma unroll
  for (int b = 0; b < 4; ++b)
#pragma unroll
    for (int r = 0; r < 16; ++r) o[b][r] = 0.f;
  const unsigned kread_n = (unsigned)r32 * 256u + (unsigned)(((r32 & 15) ^ hi) * 16);
  const unsigned kread_p = (NKC == 3 ? 16384u : 0u) + (unsigned)r32 * 128u + (unsigned)((((r32 >> 1) & 7) ^ hi) * 16);
  const unsigned vread = (unsigned)KBYTES + (unsigned)(((lane >> 4) & 1) * 32 + (lane & 3) * 8 + (4 * hi + ((lane & 15) >> 2)) * 64);
  constexpr int NST = (NKC == 1) ? 4 : 3;
  FA_ISSUE(0, 0);
  if (NT > 1) FA_ISSUE(1, 1);
  if (NST == 4 && NT > 2) FA_ISSUE(2, 2);
  int st = 0;
  for (int j = 0; j < NT; ++j) {
    if (NST == 4) { if (j + 2 < NT) asm volatile("s_waitcnt vmcnt(6)" ::: "memory"); else if (j + 1 < NT) asm volatile("s_waitcnt vmcnt(3)" ::: "memory"); else asm volatile("s_waitcnt vmcnt(0)" ::: "memory"); }
    else { if (j + 1 < NT) asm volatile("s_waitcnt vmcnt(5)" ::: "memory"); else asm volatile("s_waitcnt vmcnt(0)" ::: "memory"); }
    asm volatile("s_waitcnt lgkmcnt(0)\n\ts_barrier" ::: "memory");
    if (j + NST - 1 < NT) { const int st2 = (st == 0) ? NST - 1 : st - 1; FA_ISSUE(j + NST - 1, st2); }
    if (j < NTW) {
      const unsigned ksb = (unsigned)st * STAGE;
      f32x16 p0, p1;
#pragma unroll
      for (int d0 = 0; d0 < NKS; ++d0) {
        const bool nope = (NKC == 3) && d0 < 8;
        const unsigned ka = ksb + (nope ? (kread_n ^ (unsigned)(d0 * 32)) : (kread_p ^ (unsigned)((NKC == 3 ? d0 - 8 : d0) * 32)));
        const bf16x8 k0 = *(const LAS bf16x8*)(lds + ka);
        const bf16x8 k1 = *(const LAS bf16x8*)(lds + ka + (nope ? 8192u : 4096u));
        if (d0 == 0) { p0 = __builtin_amdgcn_mfma_f32_32x32x16_bf16(k0, qf[d0], negm, 0, 0, 0); p1 = __builtin_amdgcn_mfma_f32_32x32x16_bf16(k1, qf[d0], negm, 0, 0, 0); }
        else { p0 = __builtin_amdgcn_mfma_f32_32x32x16_bf16(k0, qf[d0], p0, 0, 0, 0); p1 = __builtin_amdgcn_mfma_f32_32x32x16_bf16(k1, qf[d0], p1, 0, 0, 0); }
      }
      __builtin_amdgcn_sched_group_barrier(0x100, 4, 0);
#pragma unroll
      for (int d0 = 0; d0 < NKS - 2; ++d0) { __builtin_amdgcn_sched_group_barrier(0x008, 2, 0); __builtin_amdgcn_sched_group_barrier(0x100, 2, 0); }
      __builtin_amdgcn_sched_group_barrier(0x008, 4, 0);
      __builtin_amdgcn_sched_barrier(0);
      asm volatile("s_nop 15\n\ts_nop 7" : "+v"(p0), "+v"(p1));
      float rm;
      { float a = max3f(p0[0], p0[1], p1[0]), b = max3f(p0[2], p0[3], p1[1]); a = max3f(a, p1[2], p1[3]);
#pragma unroll
        for (int r = 4; r < 16; r += 4) { a = max3f(a, p0[r], p0[r + 1]); b = max3f(b, p0[r + 2], p0[r + 3]); a = max3f(a, p1[r], p1[r + 1]); b = max3f(b, p1[r + 2], p1[r + 3]); }
        rm = max2f(a, b);
        auto rr = __builtin_amdgcn_permlane32_swap(__float_as_uint(rm), __float_as_uint(rm), false, false); rm = max2f(__uint_as_float(rr[0]), __uint_as_float(rr[1])); }
      if (__builtin_expect(j == 0 || __any(rm > THR), 0)) {
        const float dl = (j == 0) ? rm : __builtin_fmaxf(rm, 0.f);
        m_ref += dl;
#pragma unroll
        for (int r = 0; r < 16; ++r) { p0[r] -= dl; p1[r] -= dl; negm[r] = -m_ref; }
        const float alpha = __builtin_amdgcn_exp2f(-dl);
        l_part *= alpha;
        if (hi == 0) wsf[r32] = alpha;
        asm volatile("s_waitcnt lgkmcnt(0)" ::: "memory");
#pragma unroll
        for (int r = 0; r < 16; ++r) { const float a = wsf[crow(r, hi)];
#pragma unroll
          for (int b = 0; b < 4; ++b) o[b][r] *= a; }
      }
      const unsigned vaddr = lds0 + (unsigned)st * STAGE + vread;
      u32x4 pw0, pw1, pw2, pw3;
      if constexpr (NKC == 1) {
        v4i16_t vl[8], vh[8], wl[8], wh[8];
        FA_VRD8(vl, vh, vaddr, 0);
        FA_EXP8(p0, 0, pw0); FA_EXP8(p0, 8, pw1);
        asm volatile("s_waitcnt lgkmcnt(0)" ::: "memory"); __builtin_amdgcn_sched_barrier(0);
        FA_VRD8(wl, wh, vaddr, 2);
        __builtin_amdgcn_sched_barrier(0);
        FA_PV8(pw0, pw1, vl, vh);
        FA_EXP8(p1, 0, pw2); FA_EXP8(p1, 8, pw3);
#pragma unroll
        for (int q = 0; q < 8; ++q) { __builtin_amdgcn_sched_group_barrier(0x008, 1, 4); __builtin_amdgcn_sched_group_barrier(0x402, 6, 4); }
        asm volatile("s_waitcnt lgkmcnt(0)" ::: "memory"); __builtin_amdgcn_sched_barrier(0);
        FA_PV8(pw2, pw3, wl, wh);
        __builtin_amdgcn_sched_barrier(0);
      } else
      { v4i16_t vl[8], vh[8];
        FA_VRD8(vl, vh, vaddr, 0);
        FA_EXP8(p0, 0, pw0); FA_EXP8(p0, 8, pw1);
        asm volatile("s_waitcnt lgkmcnt(0)" ::: "memory"); __builtin_amdgcn_sched_barrier(0);
        FA_PV8(pw0, pw1, vl, vh);
        __builtin_amdgcn_sched_barrier(0);
        FA_VRD8(vl, vh, vaddr, 2);
        FA_EXP8(p1, 0, pw2); FA_EXP8(p1, 8, pw3);
        asm volatile("s_waitcnt lgkmcnt(0)" ::: "memory"); __builtin_amdgcn_sched_barrier(0);
        FA_PV8(pw2, pw3, vl, vh);
        __builtin_amdgcn_sched_barrier(0);
      }
    }
    st = (st == NST - 1) ? 0 : st + 1;
  }
  asm volatile("s_waitcnt lgkmcnt(0)\n\ts_barrier" ::: "memory");
  { auto rr = __builtin_amdgcn_permlane32_swap(__float_as_uint(l_part), __float_as_uint(l_part), false, false); l_out = __uint_as_float(rr[0]) + __uint_as_float(rr[1]); }
#undef FA_ISSUE
#undef FA_EXP8
#undef FA_PV
#undef FA_VRD1
#undef FA_VRD8
#undef FA_FRAG
#undef FA_PV8
}

__device__ __forceinline__ void row_bcast(LAS float* wsf, float v, int r32, int hi, float (&out)[16]) {
  asm volatile("s_waitcnt lgkmcnt(0)" ::: "memory");
  if (hi == 0) wsf[r32] = v;
  asm volatile("s_waitcnt lgkmcnt(0)" ::: "memory");
#pragma unroll
  for (int r = 0; r < 16; ++r) out[r] = wsf[crow(r, hi)];
  asm volatile("s_waitcnt lgkmcnt(0)" ::: "memory");
}

__device__ __forceinline__ void mla_unit(const Params& p, LAS unsigned char* lds, int h, int qb) {
  unsigned char* ws = p.ws;
  const int tid = opaque_tid(), lane = tid & 63, wid = __builtin_amdgcn_readfirstlane(tid >> 6), r32 = lane & 31, hi = lane >> 5;
  const int t = 256 * qb + 32 * wid + r32;
  bf16x8 qf[12];
  { const bf16_t* q = (const bf16_t*)(ws + R_QM) + (size_t)t * NQ + 192 * h + 8 * hi;
#pragma unroll
    for (int d0 = 0; d0 < 12; ++d0) qf[d0] = *(const bf16x8*)(q + 16 * d0);
    const f32x2* rm = (const f32x2*)(ws + WS_ROPEM) + (size_t)t * 32;
#pragma unroll
    for (int s = 8; s < 10; ++s) {
      bf16x8 a = qf[s], b = qf[s + 2];
#pragma unroll
      for (int j = 0; j < 8; ++j) { const f32x2 cs = rm[16 * (s - 8) + 8 * hi + j];
        const float x1 = bf1((bf16_t)a[j]), x2 = bf1((bf16_t)b[j]);
        a[j] = (short)f2bf(x1 * cs.x - x2 * cs.y); b[j] = (short)f2bf(x2 * cs.x + x1 * cs.y); }
      qf[s] = a; qf[s + 2] = b;
    }
  }
  asm volatile("s_waitcnt vmcnt(0)" ::: "memory");
#pragma unroll
  for (int d0 = 0; d0 < 12; ++d0) asm volatile("" : "+v"(qf[d0]));
  Src S; S.kb0 = (const char*)(ws + R_KVM) + 256 * h * 2; S.kp0 = NKV * 2; S.kb1 = (const char*)(ws + R_KPE); S.kp1 = 128; S.vb = (const char*)(ws + R_KVM) + (256 * h + 128) * 2; S.vp = NKV * 2;
  f32x16 o[4]; float l;
  attn_pass3<3>(lds, S, qf, 1.0f, 4 * qb + 4, 4 * qb + 1 + (wid >> 1), o, l);
  LAS float* wsf = (LAS float*)(lds + WSF_OFF) + wid * 64;
  float il[16]; row_bcast(wsf, 1.0f / l, r32, hi, il);
  char* ob = (char*)((bf16_t*)(ws + R_OATT) + (size_t)(256 * qb + 32 * wid) * 2048 + 128 * h);
  const unsigned lo = (unsigned)(4 * hi * 2048 + r32) * 2u;
#pragma unroll
  for (int r = 0; r < 16; ++r)
#pragma unroll
    for (int b = 0; b < 4; ++b) *(bf16_t*)(ob + lo + (unsigned)((((r & 3) + 8 * (r >> 2)) * 2048 + 32 * b) * 2)) = (bf16_t)f2bf(o[b][r] * il[r]);
}

template <int C>
__device__ __forceinline__ void diff_comp(const Params& p, LAS unsigned char* lds, int h, int qb, f32x16 (&oacc)[4]) {
  unsigned char* ws = p.ws;
  const int tid = opaque_tid(), lane = tid & 63, wid = __builtin_amdgcn_readfirstlane(tid >> 6), r32 = lane & 31, hi = lane >> 5;
  const int t = 256 * qb + 32 * wid + r32;
  LAS float* wsf = (LAS float*)(lds + WSF_OFF) + wid * 64;
  bf16x8 qf[4];
  { const bf16_t* q = (const bf16_t*)(ws + R_DQ) + (size_t)t * 1024 + 128 * h + 64 * C + 8 * hi;
#pragma unroll
    for (int d0 = 0; d0 < 4; ++d0) qf[d0] = *(const bf16x8*)(q + 16 * d0); }
  asm volatile("s_waitcnt vmcnt(0)" ::: "memory");
#pragma unroll
  for (int d0 = 0; d0 < 4; ++d0) asm volatile("" : "+v"(qf[d0]));
  Src S; S.kb0 = (const char*)(ws + R_DK) + (128 * h + 64 * C) * 2; S.kp0 = 2048; S.kb1 = S.kb0; S.kp1 = 2048; S.vb = (const char*)(ws + R_DV) + 128 * h * 2; S.vp = 2048;
  f32x16 o[4]; float l;
  attn_pass3<1>(lds, S, qf, 1.0f, 4 * qb + 4, 4 * qb + 1 + (wid >> 1), o, l);
  const float lam = ((const float*)(ws + WS_MOD))[16384];
  float il[16]; row_bcast(wsf, (C == 0 ? 1.0f : -lam) / l, r32, hi, il);
  const char* park = (const char*)((float*)(ws + R_OC) + (size_t)(((h * 32 + qb) * 8 + wid)) * 4096);
  const unsigned pl = (unsigned)(opaque_tid() & 63) * 4u;
  if (C == 0) {
#pragma unroll
    for (int b = 0; b < 4; ++b) { const char* pb = park + b * 4096;
#pragma unroll
      for (int r = 0; r < 16; ++r) *(float*)(const_cast<char*>(pb) + pl + (unsigned)(r * 256)) = o[b][r] * il[r]; }
  } else {
#pragma unroll
    for (int b = 0; b < 4; ++b) { const char* pb = park + b * 4096;
#pragma unroll
      for (int r = 0; r < 16; ++r) oacc[b][r] = *(const float*)(pb + pl + (unsigned)(r * 256)) + o[b][r] * il[r]; }
  }
}

__device__ __forceinline__ void diff_unit(const Params& p, LAS unsigned char* lds, int h, int qb) {
  unsigned char* ws = p.ws;
  f32x16 oacc[4];
  diff_comp<0>(p, lds, h, qb, oacc);
  diff_comp<1>(p, lds, h, qb, oacc);
  const int tid = opaque_tid(), lane = tid & 63, wid = __builtin_amdgcn_readfirstlane(tid >> 6), r32 = lane & 31, hi = lane >> 5;
  const float* gsub = p.in[14];
  float g4[4];
#pragma unroll
  for (int b = 0; b < 4; ++b) g4[b] = gsub[32 * b + r32] * 0.8f;
  char* ob = (char*)((bf16_t*)(ws + R_OATT) + (size_t)(256 * qb + 32 * wid) * 2048 + 1024 + 128 * h);
  const unsigned lo = (unsigned)(4 * hi * 2048 + r32) * 2u;
#pragma unroll
  for (int r = 0; r < 16; ++r) {
    float ss = 0.f;
#pragma unroll
    for (int b = 0; b < 4; ++b) ss += oacc[b][r] * oacc[b][r];
    ss += __shfl_xor(ss, 1); ss += __shfl_xor(ss, 2); ss += __shfl_xor(ss, 4); ss += __shfl_xor(ss, 8); ss += __shfl_xor(ss, 16);
    const float rstd = 1.0f / sqrtf(ss * (1.0f / 128.0f) + EPS);
#pragma unroll
    for (int b = 0; b < 4; ++b) *(bf16_t*)(ob + lo + (unsigned)((((r & 3) + 8 * (r >> 2)) * 2048 + 32 * b) * 2)) = (bf16_t)f2bf(oacc[b][r] * rstd * g4[b]);
  }
}

struct AUnit { unsigned char kind, qb; };
struct AList { AUnit u[64]; };
constexpr AList make_alist() {
  AList L{}; int cost[64] = {}; int n = 0;
  for (int qb = 0; qb < 32; ++qb) { L.u[n].kind = 0; L.u[n].qb = (unsigned char)qb; cost[n] = 100 * (qb + 1); ++n; }
  for (int qb = 0; qb < 32; ++qb) { L.u[n].kind = 1; L.u[n].qb = (unsigned char)qb; cost[n] = 165 * (qb + 1); ++n; }
  for (int i = 1; i < 64; ++i) { const AUnit x = L.u[i]; const int c = cost[i]; int j = i - 1; while (j >= 0 && cost[j] < c) { L.u[j + 1] = L.u[j]; cost[j + 1] = cost[j]; --j; } L.u[j + 1] = x; cost[j + 1] = c; }
  return L;
}
__constant__ AList g_alist = make_alist();
constexpr int CW_AQ = 1024, CW_ROLE = 1280, CW_CQ = 1536;
constexpr int LDS_AQW = 147408;
constexpr unsigned N_CONVERTERS_PER_XCD = 7;

__device__ __forceinline__ int wg_pull(unsigned* head, unsigned limit, volatile LAS int* bw) {
  if (threadIdx.x == 0) {
    int idx = (int)limit;
    if (__hip_atomic_load(head, __ATOMIC_RELAXED, __HIP_MEMORY_SCOPE_AGENT) < limit) idx = (int)__hip_atomic_fetch_add(head, 1u, __ATOMIC_RELAXED, __HIP_MEMORY_SCOPE_AGENT);
    bw[0] = idx;
  }
  __syncthreads();
  const int idx = __builtin_amdgcn_readfirstlane(bw[0]);
  __syncthreads();
  return idx;
}
__device__ __forceinline__ void attn_queue_loop(const Params& p, LAS unsigned char* lds, unsigned* ctl, volatile LAS int* bw, unsigned x0) {
  for (unsigned k = 0; k < 8u; ++k) {
    const unsigned g = (x0 + k) & 7u;
    for (;;) {
      const int idx = wg_pull(ctl + CW_AQ + 16u * g, 64u, bw);
      if (idx >= 64) break;
      const AUnit u = g_alist.u[idx];
      const int kind = __builtin_amdgcn_readfirstlane((int)u.kind), qb = __builtin_amdgcn_readfirstlane((int)u.qb);
      if (kind == 0) mla_unit(p, lds, (int)g, qb); else diff_unit(p, lds, (int)g, qb);
    }
  }
}
__device__ __forceinline__ void conv_queue_loop(const Params& p, char* lds_generic, unsigned* ctl, volatile LAS int* bw) {
  for (;;) {
    const int c = wg_pull(ctl + CW_CQ, (unsigned)N_CONV_CHUNKS, bw);
    if (c >= N_CONV_CHUNKS) break;
    conv_chunk(p, lds_generic, c);
    __syncthreads();
  }
}
__device__ __forceinline__ void phase3_fast(const Params& p, LAS unsigned char* lds, char* lds_generic) {
  unsigned* ctl = (unsigned*)(p.ws + WS_CTL);
  volatile LAS int* bw = (volatile LAS int*)(lds + LDS_AQW);
  const unsigned x0 = (unsigned)__builtin_amdgcn_s_getreg((3 << 11) | 20) & 7u;
  const int ticket = wg_pull(ctl + CW_ROLE + 16u * x0, 0xffffffffu, bw);
  if ((unsigned)ticket < N_CONVERTERS_PER_XCD) { conv_queue_loop(p, lds_generic, ctl, bw); attn_queue_loop(p, lds, ctl, bw, x0); }
  else { attn_queue_loop(p, lds, ctl, bw, x0); conv_queue_loop(p, lds_generic, ctl, bw); }
}
}

constexpr int P5_STRIDE = 2052;
__device__ __forceinline__ void phase5(const Params& p, char* lds) {
  const int tid = opaque_tid(), lane = tid & 63, wave = tid >> 6;
  unsigned char* ws = p.ws;
  float* tile = (float*)lds;
  float* part = (float*)lds;
  int* lcnt = (int*)(lds + 135168);
  int* lbase = lcnt + 64;
  int* nent = lcnt + 128;
  int* ent = lcnt + 192;
  const float* mod = (const float*)(ws + WS_MOD);
  const float* x = p.in[0]; const bf16_t* y = (const bf16_t*)(ws + R_Y);
  const float* g_post = p.in[16]; const float* g_pre = p.in[17];
  const float* wr_ = p.in[18]; const float* br_ = p.in[19];
  unsigned char* h2 = (unsigned char*)(ws + WS_H2);
  float* topw = (float*)(ws + WS_TOPW);
  if (tid < 64) lcnt[tid] = 0;
  if (tid == 64) nent[0] = 0;
  __syncthreads();
  for (int ti = blockIdx.x; ti < T / 16; ti += gridDim.x) {
    const int row0 = 16 * ti;
#pragma unroll 1
    for (int rr = 0; rr < 2; ++rr) {
      const int lr = 2 * wave + rr, row = row0 + lr;
      f32x4 v[8]; float ss = 0.f;
#pragma unroll
      for (int j = 0; j < 8; ++j) { const u32x2 yy = *(const u32x2*)(y + (size_t)row * D + 256 * j + 4 * lane); v[j] = (f32x4){bf_lo(yy.x), bf_hi(yy.x), bf_lo(yy.y), bf_hi(yy.y)}; ss += v[j].x * v[j].x + v[j].y * v[j].y + v[j].z * v[j].z + v[j].w * v[j].w; }
      const float rstdy = 1.0f / sqrtf(wave_sum(ss) * (1.0f / D) + EPS);
      float s1 = 0.f;
#pragma unroll
      for (int j = 0; j < 8; ++j) {
        const int c0 = 256 * j + 4 * lane;
        const f32x4 xv = *(const f32x4*)(x + (size_t)row * D + c0), gp = *(const f32x4*)(g_post + c0), ga = *(const f32x4*)(mod + 4096 + c0);
        const f32x4 x1 = xv + ga * ((v[j] * rstdy) * gp);
        *(f32x4*)(p.out + (size_t)row * D + c0) = x1;
        v[j] = x1; s1 += x1.x * x1.x + x1.y * x1.y + x1.z * x1.z + x1.w * x1.w;
      }
      const float rstd1 = 1.0f / sqrtf(wave_sum(s1) * (1.0f / D) + EPS);
#pragma unroll
      for (int j = 0; j < 8; ++j) {
        const int c0 = 256 * j + 4 * lane;
        const f32x4 gf = *(const f32x4*)(g_pre + c0), sh = *(const f32x4*)(mod + 6144 + c0), sc = *(const f32x4*)(mod + 8192 + c0);
        const f32x4 hv = (v[j] * rstd1) * gf * (sc + 1.0f) + sh;
        *(unsigned*)(h2 + (size_t)row * D + c0) = pack8_fp8(hv, hv).x;
        float* tp = tile + lr * P5_STRIDE + c0; tp[0] = hv.x; tp[1] = hv.y; tp[2] = hv.z; tp[3] = hv.w;
      }
    }
    __syncthreads();
    f32x4 racc[4];
#pragma unroll
    for (int jt = 0; jt < 4; ++jt) racc[jt] = (f32x4){0.f, 0.f, 0.f, 0.f};
    const u32x4* wrh = (const u32x4*)(ws + WS_WRT); const u32x4* wrl = (const u32x4*)(ws + WS_WRT + 256 * 1024);
#pragma unroll 2
    for (int ks = 0; ks < 8; ++ks) {
      const int s = 8 * wave + ks;
      const float* ap = tile + (lane & 15) * P5_STRIDE + 32 * s + 8 * (lane >> 4);
      const f32x4 a0 = *(const f32x4*)ap, a1 = *(const f32x4*)(ap + 4);
      const float av[8] = {a0.x, a0.y, a0.z, a0.w, a1.x, a1.y, a1.z, a1.w};
      unsigned hw[4], lw[4];
#pragma unroll
      for (int j = 0; j < 4; ++j) {
        const unsigned h = cvtpk2(av[2 * j], av[2 * j + 1]);
        hw[j] = h; lw[j] = cvtpk2(av[2 * j] - bf_lo(h), av[2 * j + 1] - bf_hi(h));
      }
      const bf16x8 ah = __builtin_bit_cast(bf16x8, (u32x4){hw[0], hw[1], hw[2], hw[3]}), al = __builtin_bit_cast(bf16x8, (u32x4){lw[0], lw[1], lw[2], lw[3]});
#pragma unroll
      for (int jt = 0; jt < 4; ++jt) {
        const bf16x8 bh = __builtin_bit_cast(bf16x8, wrh[(s * 4 + jt) * 64 + lane]), bl = __builtin_bit_cast(bf16x8, wrl[(s * 4 + jt) * 64 + lane]);
        racc[jt] = __builtin_amdgcn_mfma_f32_16x16x32_bf16(ah, bh, racc[jt], 0, 0, 0);
        racc[jt] = __builtin_amdgcn_mfma_f32_16x16x32_bf16(ah, bl, racc[jt], 0, 0, 0);
        racc[jt] = __builtin_amdgcn_mfma_f32_16x16x32_bf16(al, bh, racc[jt], 0, 0, 0);
      }
    }
    __syncthreads();
#pragma unroll
    for (int jt = 0; jt < 4; ++jt)
#pragma unroll
      for (int r = 0; r < 4; ++r) part[(wave * 16 + (lane >> 4) * 4 + r) * 64 + 16 * jt + (lane & 15)] = racc[jt][r];
    __syncthreads();
#pragma unroll 1
    for (int rr = 0; rr < 2; ++rr) {
      const int lr = 2 * wave + rr, tok = row0 + lr;
      float logit = 0.f;
#pragma unroll
      for (int w = 0; w < 8; ++w) logit += part[(w * 16 + lr) * 64 + lane];
      const float score = 1.0f / (1.0f + expf(-logit));
      const float v = score + br_[lane];
      int rk = 0;
#pragma unroll
      for (int d = 1; d < 8; ++d) { const int ol = (lane & ~7) | ((lane + d) & 7); const float ov = __shfl(v, ol); rk += (ov > v || (ov == v && ol < lane)) ? 1 : 0; }
      float gs = rk < 2 ? v : 0.f;
      gs += __shfl_xor(gs, 1); gs += __shfl_xor(gs, 2); gs += __shfl_xor(gs, 4);
      int grk = 0; const int g = lane >> 3;
#pragma unroll
      for (int gg = 0; gg < 8; ++gg) { const float og = __shfl(gs, 8 * gg); grk += (og > gs || (og == gs && gg < g)) ? 1 : 0; }
      const float mv = grk < 4 ? v : -INFINITY;
      int erk = 0;
#pragma unroll 8
      for (int e2 = 0; e2 < 64; ++e2) { const float ov = __shfl(mv, e2); erk += (ov > mv || (ov == mv && e2 < lane)) ? 1 : 0; }
      const bool sel = (erk < 8) && (grk < 4);
      const float tot = wave_sum(sel ? score : 0.f);
      if (sel) {
        topw[tok * 8 + erk] = score / tot * 2.5f;
        const int lp = atomicAdd(&lcnt[lane], 1);
        const int ix = atomicAdd(&nent[0], 1);
        ent[ix] = (tok * 8 + erk) | (lane << 16) | (lp << 22);
      }
    }
    __syncthreads();
  }
  unsigned* gcnt = (unsigned*)(ws + WS_CTL) + CW_GCNT;
  if (tid < 64) lbase[tid] = (int)atomicAdd(&gcnt[tid], (unsigned)lcnt[tid]);
  __syncthreads();
  int* rowl = (int*)(ws + WS_ROWL);
  const int ne = nent[0];
  int* tpos = (int*)(ws + WS_TPOS);
  for (int i = tid; i < ne; i += NTHREADS) { const int w = ent[i]; const int code = w & 0xffff, e = (w >> 16) & 63, lp = (w >> 22) & 1023; const int pos = lbase[e] + lp; rowl[e * 8192 + pos] = code; tpos[code] = (e << 16) | pos; }
}

struct MoeMap { LAS int* cnt; LAS int* tstart; LAS unsigned char* t2e; };
__device__ __forceinline__ void moe_map_build(const Params& p, char* lds, MoeMap& mm) {
  mm.cnt = (LAS int*)((LAS char*)lds + 140000); mm.tstart = mm.cnt + 80; mm.t2e = (LAS unsigned char*)((LAS char*)lds + 141024);
  if (threadIdx.x == 0) {
    const unsigned* gcnt = (const unsigned*)(p.ws + WS_CTL) + CW_GCNT; int acc = 0;
    for (int e = 0; e < 65; ++e) { const int c = (e < 64) ? (int)__hip_atomic_load(&gcnt[e], __ATOMIC_RELAXED, __HIP_MEMORY_SCOPE_AGENT) : T; mm.cnt[e] = c; mm.tstart[e] = acc; acc += (c + 255) >> 8; }
    mm.tstart[65] = acc;
  }
  __syncthreads();
  for (int e = threadIdx.x; e < 65; e += NTHREADS) for (int t = mm.tstart[e]; t < mm.tstart[e + 1]; ++t) mm.t2e[t] = (unsigned char)e;
  __syncthreads();
}
__device__ __forceinline__ int moe_find(const MoeMap& mm, int mtg) { return (int)mm.t2e[mtg]; }

struct RowGather { const int* rl; int cnt, base; __device__ __forceinline__ int operator()(int r) const { const int i = base + r; return i < cnt ? (rl[i] >> 3) : 0; } };

__device__ __forceinline__ void phase8(const Params& p, const MoeMap& mm) {
  const int tid = opaque_tid(), lane = tid & 63, wave = tid >> 6;
  const int gw = blockIdx.x * NWAVES + wave, NGW = gridDim.x * NWAVES;
  unsigned char* ws = p.ws;
  const unsigned char* yp = (const unsigned char*)(ws + R_YSLOT); const float* topw = (const float*)(ws + WS_TOPW); const int* tpos = (const int*)(ws + WS_TPOS);
  const float* mod = (const float*)(ws + WS_MOD); const float* g = p.in[26];
  for (int row = gw; row < T; row += NGW) {
    float w[8]; const unsigned char* rp[9];
#pragma unroll
    for (int s = 0; s < 8; ++s) { w[s] = topw[row * 8 + s]; const int tp = tpos[row * 8 + s]; rp[s] = yp + ((size_t)256 * mm.tstart[tp >> 16] + (tp & 0xffff)) * 2048; }
    rp[8] = yp + ((size_t)256 * mm.tstart[64] + row) * 2048;
    f32x4 v[8]; float ss = 0.f;
#pragma unroll
    for (int j = 0; j < 8; ++j) {
      const int c0 = 256 * j + 4 * lane;
      f32x4 a = unpack4_fp8(*(const unsigned*)(rp[8] + c0));
#pragma unroll
      for (int s = 0; s < 8; ++s) a += unpack4_fp8(*(const unsigned*)(rp[s] + c0)) * w[s];
      v[j] = a; ss += a.x * a.x + a.y * a.y + a.z * a.z + a.w * a.w;
    }
    const float rstd = 1.0f / sqrtf(wave_sum(ss) * (1.0f / D) + EPS);
#pragma unroll
    for (int j = 0; j < 8; ++j) {
      const int c0 = 256 * j + 4 * lane;
      const f32x4 gt = *(const f32x4*)(mod + 10240 + c0), gv = *(const f32x4*)(g + c0);
      float* op = p.out + (size_t)row * D + c0;
      const f32x4 x1 = *(const f32x4*)op;
      *(f32x4*)op = x1 + gt * ((v[j] * rstd) * gv);
    }
  }
}

template <bool GATHER> struct SchedMoe {
  MoeMap mm; int shift, nwg, G, c; const char* Abase; const char* Bbase; size_t bstride, tstepB, tstepA; const int* rowl;
  __device__ __forceinline__ bool next(int i, pg8::Unit& u) const {
    const int L = i * G + c; if (L >= nwg) return false;
    const int wgid = pg8::xcd_remap(L, nwg);
    const int mtg = wgid >> shift, pn = wgid & ((1 << shift) - 1), e = moe_find(mm, mtg);
    u.pm = mtg; u.pn = pn; u.e = e; u.aux = mtg - mm.tstart[e];
    u.A = GATHER ? Abase : Abase + (size_t)mtg * tstepA; u.B = Bbase + (size_t)e * bstride + (size_t)pn * tstepB; return true;
  }
  __device__ __forceinline__ int row(const pg8::Unit& u, int r) const {
    const int i = 256 * u.aux + r;
    if (u.e == 64) return i;
    return i < mm.cnt[u.e] ? (rowl[u.e * 8192 + i] >> 3) : 0;
  }
};


#define XB_TMO      128
#define XB_XCNT(j)  (256  + 64 * (j))
#define XB_XSUB(j)  (1280 + 64 * (j))
#define XB_XGEN(j)  (2304 + 64 * (j))
#define XB_TOP      3328
#define XB_TOPGEN   3392
#define XCD_BAR_WORDS 3456
#define XB_SPIN_CAP (1u << 18)
__device__ __forceinline__ unsigned xb_ld(unsigned* p)              { return __hip_atomic_load(p, __ATOMIC_RELAXED, __HIP_MEMORY_SCOPE_AGENT); }
__device__ __forceinline__ unsigned xb_add(unsigned* p, unsigned v) { return __hip_atomic_fetch_add(p, v, __ATOMIC_RELAXED, __HIP_MEMORY_SCOPE_AGENT); }
__device__ __forceinline__ unsigned xb_xcc_id() { return (unsigned)__builtin_amdgcn_s_getreg((3 << 11) | 20) & 0xFu; }
#define XB_SPIN(cond, bar) do { unsigned _sp = 0; while (cond) { __builtin_amdgcn_s_sleep(1); \
    if ((++_sp & 255u) == 0u) { if (xb_ld(&(bar)[XB_TMO])) break; if (_sp > XB_SPIN_CAP) { atomicAdd(&(bar)[XB_TMO], 1u); break; } } } } while (0)
struct XcdBarrier { unsigned* bar; unsigned x; volatile LAS unsigned* st; };
__device__ __forceinline__ XcdBarrier xcd_barrier_post(unsigned* bar, volatile LAS unsigned* st) {
    XcdBarrier b; b.bar = bar; b.x = xb_xcc_id(); b.st = st;
    if (threadIdx.x == 0) (void)xb_add(&bar[XB_XCNT(b.x)], 1u);
    return b;
}
__device__ __forceinline__ void xcd_barrier_complete(unsigned* bar, unsigned x, unsigned& nloc, unsigned& nx) {
    const unsigned G = gridDim.x * gridDim.y * gridDim.z;
    unsigned sum, cnt, mine, sp = 0u;
    for (;;) {
        sum = 0u; cnt = 0u; mine = 0u;
#pragma unroll
        for (unsigned j = 0; j < 16; ++j) { const unsigned c = xb_ld(&bar[XB_XCNT(j)]); sum += c; cnt += (c > 0u) ? 1u : 0u; mine = (j == x) ? c : mine; }
        if (sum == G) break;
        __builtin_amdgcn_s_sleep(1);
        if ((++sp & 255u) == 0u) { if (xb_ld(&bar[XB_TMO])) break; if (sp > XB_SPIN_CAP) { atomicAdd(&bar[XB_TMO], 1u); break; } }
    }
    nloc = mine > 0u ? mine : 1u; nx = cnt > 0u ? cnt : 1u;
}
__device__ __forceinline__ void xcd_barrier(const XcdBarrier& b) {
    asm volatile("s_waitcnt vmcnt(0)" ::: "memory");
    __syncthreads();
    if (threadIdx.x == 0) {
        unsigned* bar = b.bar;
        __builtin_amdgcn_s_waitcnt(0);
        unsigned nloc = b.st[0], nx = b.st[1];
        if (nloc == 0u) { xcd_barrier_complete(bar, b.x, nloc, nx); b.st[0] = nloc; b.st[1] = nx; }
        const unsigned old = xb_add(&bar[XB_XSUB(b.x)], 1u);
        const unsigned gen = old / nloc;
        if (old + 1u == (gen + 1u) * nloc) {
            __builtin_amdgcn_fence(__ATOMIC_RELEASE, "agent");
            asm volatile("s_waitcnt vmcnt(0)" ::: "memory");
            const unsigned og = xb_add(&bar[XB_TOP], 1u);
            const unsigned tg = og / nx;
            if (og + 1u == (tg + 1u) * nx) xb_add(&bar[XB_TOPGEN], 1u);
            else XB_SPIN(xb_ld(&bar[XB_TOPGEN]) == tg, bar);
            __builtin_amdgcn_fence(__ATOMIC_ACQUIRE, "agent");
            xb_add(&bar[XB_XGEN(b.x)], 1u);
            asm volatile("s_waitcnt vmcnt(0)" ::: "memory");
        } else {
            XB_SPIN(xb_ld(&bar[XB_XGEN(b.x)]) == gen, bar);
            __builtin_amdgcn_fence(__ATOMIC_ACQUIRE, "agent");
            asm volatile("s_waitcnt vmcnt(0)" ::: "memory");
        }
    }
    __syncthreads();
}
constexpr int CW_BAR = 4096;
constexpr int LDS_BARST = 147392;

#ifndef FAST_GEMM
#define FAST_GEMM 1
#endif
#ifndef FAST_ATTN
#define FAST_ATTN 1
#endif

__global__ void __launch_bounds__(NTHREADS) fwd_megakernel(Params p) {
  extern __shared__ __attribute__((aligned(16))) char lds[];
  cg::grid_group grid = cg::this_grid();
  unsigned char* ws = p.ws;
  const int G = gridDim.x;
  LAS unsigned char* ring = (LAS unsigned char*)lds;
  if (threadIdx.x < 16) ((LAS unsigned*)(ring + LDS_BARST))[threadIdx.x] = 0u;
  __syncthreads();
  const XcdBarrier xbar = xcd_barrier_post((unsigned*)(ws + WS_CTL) + CW_BAR, (volatile LAS unsigned*)(ring + LDS_BARST));
#define GRID_BAR() xcd_barrier(xbar)

  phase0a(p, lds);
#if DUP_PHASE == 1
  GRID_BAR(); phase0a(p, lds);
#endif
  GRID_BAR();
  phase0b(p, lds);
  GRID_BAR();
  {
    EpiProj<true> E{ws, 0};
#if FAST_GEMM
    pg8::SchedPlain S(ws + WS_H2, ws + WS_WIN, T, 4096, D, G, (int)blockIdx.x);
    pg8::gemm_phase<EpiProj<true>, pg8::SchedPlain, true, false>(ring, D, S, E);
#if DUP_PHASE == 2
    GRID_BAR(); pg8::gemm_phase<EpiProj<true>, pg8::SchedPlain, true, false>(ring, D, S, E);
#endif
#else
    for (int u = blockIdx.x; u < 32 * 18; u += G) {
      pg8::Unit un{}; un.pm = u / 18; un.pn = u % 18;
      gemm_tile_naive<true>((const bf16_t*)(ws + WS_H2), D, (const bf16_t*)(ws + WS_WIN) + (size_t)256 * un.pn * D, D, RowIdent{256 * un.pm}, E, un);
    }
#endif
  }
  GRID_BAR();
  {
    EpiRowScale<true> EQ{(bf16_t*)(ws + R_QM), NQ, (const float*)(ws + WS_SSQ), 12, 1.0f / QR, 0.07216878364870322f * 1.4426950408889634f};
    EpiRowScale<true> EK{(bf16_t*)(ws + R_KVM), NKV, (const float*)(ws + WS_SSQ + 512 * 1024), 8, 1.0f / KVR, 1.0f};
#if FAST_GEMM
    const int bx = (int)blockIdx.x, NA = (G >= 128) ? 64 : 0;
    if (NA) { EpiProj<true> EV{ws, 16};
      pg8::SchedPlain S(ws + WS_H2, ws + WS_WIN + (size_t)4096 * D * 2, T, 512, D, NA, bx < NA ? bx : (1 << 20));
      pg8::gemm_phase<EpiProj<true>, pg8::SchedPlain, true, false>(ring, D, S, EV); }
    else { EpiProj<true> EV{ws, 16};
      pg8::SchedPlain S(ws + WS_H2, ws + WS_WIN + (size_t)4096 * D * 2, T, 512, D, G, bx);
      pg8::gemm_phase<EpiProj<true>, pg8::SchedPlain, true, false>(ring, D, S, EV); }
    { pg8::SchedPlain S(ws + R_QLAT, ws + WS_WUQ, T, NQ, QR, G - NA, bx >= NA ? bx - NA : (1 << 20));
      pg8::gemm_phase<EpiRowScale<true>, pg8::SchedPlain, true, false>(ring, QR, S, EQ); }
    { pg8::SchedPlain S(ws + R_KVLAT, ws + WS_WUKV, T, NKV, KVR, G - NA, bx >= NA ? bx - NA : (1 << 20));
      pg8::gemm_phase<EpiRowScale<true>, pg8::SchedPlain, true, false>(ring, KVR, S, EK); }
#else
    for (int u = blockIdx.x; u < 32 * 6 + 32 * 8; u += G) {
      pg8::Unit un{};
      if (u < 192) { un.pm = u / 6; un.pn = u % 6;
        gemm_tile_naive<true>((const bf16_t*)(ws + R_QLAT), QR, (const bf16_t*)(ws + WS_WUQ) + (size_t)256 * un.pn * QR, QR, RowIdent{256 * un.pm}, EQ, un);
      } else { const int v = u - 192; un.pm = v / 8; un.pn = v % 8;
        gemm_tile_naive<true>((const bf16_t*)(ws + R_KVLAT), KVR, (const bf16_t*)(ws + WS_WUKV) + (size_t)256 * un.pn * KVR, KVR, RowIdent{256 * un.pm}, EK, un);
      }
    }
#endif
  }
  rotary_rows(p);
  GRID_BAR();
#if FAST_ATTN
  fa::phase3_fast(p, ring, lds);
  GRID_BAR();
#else
  phase3_naive(p);
  GRID_BAR();
  phase3b_naive(p);
  GRID_BAR();
#endif
  {
    EpiBf16<true> E{(bf16_t*)(ws + R_Y), D};
#if FAST_GEMM
    pg8::SchedPlain S(ws + R_OATT, ws + WS_WOUT, T, D, D, G, (int)blockIdx.x);
    pg8::gemm_phase<EpiBf16<true>, pg8::SchedPlain, true, false>(ring, D, S, E);
#else
    for (int u = blockIdx.x; u < 32 * 8; u += G) {
      pg8::Unit un{}; un.pm = u / 8; un.pn = u % 8;
      gemm_tile_naive<true>((const bf16_t*)(ws + R_OATT), D, (const bf16_t*)(ws + WS_WOUT) + (size_t)256 * un.pn * D, D, RowIdent{256 * un.pm}, E, un);
    }
#endif
  }
  GRID_BAR();
  phase5(p, lds);
  GRID_BAR();
  {
    MoeMap mm; moe_map_build(p, lds, mm);
    const int nmt = mm.tstart[65];
    {
      EpiSwiglu<true> E{(bf16_t*)(ws + WS_ACT), 1.0f / 32.0f};
      SchedMoe<true> S{mm, 2, nmt * 4, G, (int)blockIdx.x, (const char*)(ws + WS_H2), (const char*)(ws + WS_WGU), (size_t)1024 * D, (size_t)256 * D, 0, (const int*)(ws + WS_ROWL)};
#if FAST_GEMM
      pg8::gemm_phase<EpiSwiglu<true>, SchedMoe<true>, true, true, true>(ring, D / 2, S, E);
#if DUP_PHASE == 6
      GRID_BAR(); pg8::gemm_phase<EpiSwiglu<true>, SchedMoe<true>, true, true, true>(ring, D / 2, S, E);
#endif
#else
      pg8::Unit un;
      for (int i = 0; S.next(i, un); ++i) {
        const int e = un.e, mt = un.aux;
        if (e < 64) gemm_tile_naive<true>((const bf16_t*)(ws + WS_H2), D, (const bf16_t*)un.B, D, RowGather{(const int*)(ws + WS_ROWL) + e * 8192, mm.cnt[e], 256 * mt}, E, un);
        else gemm_tile_naive<true>((const bf16_t*)(ws + WS_H2), D, (const bf16_t*)un.B, D, RowIdent{256 * mt}, E, un);
      }
#endif
    }
    GRID_BAR();
    {
      EpiRowsFp8<true> E{(unsigned char*)(ws + R_YSLOT), 1.0f / 32.0f};
      SchedMoe<false> S{mm, 3, nmt * 8, G, (int)blockIdx.x, (const char*)(ws + WS_ACT), (const char*)(ws + WS_WD), (size_t)2048 * DE, (size_t)256 * DE, (size_t)256 * DE, (const int*)(ws + WS_ROWL)};
#if FAST_GEMM
      pg8::gemm_phase<EpiRowsFp8<true>, SchedMoe<false>, true, false, true>(ring, DE / 2, S, E);
#if DUP_PHASE == 7
      GRID_BAR(); pg8::gemm_phase<EpiRowsFp8<true>, SchedMoe<false>, true, false, true>(ring, DE / 2, S, E);
#endif
#else
      pg8::Unit un;
      for (int i = 0; S.next(i, un); ++i)
        gemm_tile_naive<true>((const bf16_t*)(ws + WS_ACT), DE, (const bf16_t*)un.B, DE, RowIdent{256 * un.pm}, E, un);
#endif
    }
  }
  GRID_BAR();
  { MoeMap mm8; mm8.cnt = (LAS int*)((LAS char*)lds + 140000); mm8.tstart = mm8.cnt + 80; mm8.t2e = (LAS unsigned char*)((LAS char*)lds + 141024); phase8(p, mm8); }
}

extern "C" void kernel_launch(void* const* d_in, const int* in_sizes, int n_in, void* d_out, int out_size, void* d_ws, size_t ws_size, hipStream_t stream) {
  static int grid_blocks = 0;
  if (grid_blocks == 0) {
    if (n_in != 27 || out_size != T * D || ws_size < WS_END) { fprintf(stderr, "kernel_launch: unexpected shapes (n_in %d out %d ws %zu)\n", n_in, out_size, ws_size); grid_blocks = -1; return; }
    int dev = 0, cus = 0, per_cu = 0;
    hipGetDevice(&dev);
    hipDeviceGetAttribute(&cus, hipDeviceAttributeMultiprocessorCount, dev);
    hipFuncSetAttribute((const void*)fwd_megakernel, hipFuncAttributeMaxDynamicSharedMemorySize, LDS_BYTES);
    hipOccupancyMaxActiveBlocksPerMultiprocessor(&per_cu, (const void*)fwd_megakernel, NTHREADS, LDS_BYTES);
    if (per_cu < 1) { fprintf(stderr, "kernel_launch: occupancy query says %d\n", per_cu); per_cu = 1; }
    if (per_cu > 1) per_cu = 1;
    grid_blocks = cus * per_cu;
  }
  if (grid_blocks < 0) return;
  hipMemsetAsync((char*)d_ws + WS_CTL, 0, CTL_BYTES, stream);
  Params p{};
  for (int i = 0; i < 27; ++i) p.in[i] = (const float*)d_in[i];
  p.out = (float*)d_out; p.ws = (unsigned char*)d_ws;
  void* args[] = {&p};
  hipError_t e = hipLaunchCooperativeKernel((const void*)fwd_megakernel, dim3(grid_blocks), dim3(NTHREADS), args, LDS_BYTES, stream);
  if (e != hipSuccess) fprintf(stderr, "cooperative launch failed: %s (grid %d)\n", hipGetErrorString(e), grid_blocks);
}
```

```cpp
#include <hip/hip_runtime.h>
#include <hip/hip_cooperative_groups.h>
#include <cstdio>
#include <cstdint>
namespace cg = cooperative_groups;
#ifndef DUP_PHASE
#define DUP_PHASE 0
#endif

typedef unsigned short bf16_t;
typedef short bf16x8 __attribute__((ext_vector_type(8)));
typedef float f32x4 __attribute__((ext_vector_type(4)));
typedef float f32x2 __attribute__((ext_vector_type(2)));
typedef unsigned u32x4 __attribute__((ext_vector_type(4)));
typedef unsigned u32x2 __attribute__((ext_vector_type(2)));
typedef __bf16 bf16x2_t __attribute__((ext_vector_type(2)));

constexpr int T = 8192, D = 2048;
constexpr int NIN = 4608;
constexpr int QR = 768, KVR = 512;
constexpr int NQ = 1536, NKV = 2048;
constexpr int NE = 64, DE = 512;
constexpr float EPS = 1e-6f;
constexpr int NTHREADS = 512, NWAVES = 8;
constexpr int LDS_BYTES = 147456;

constexpr size_t MiB = 1u << 20;
constexpr size_t WS_CTL = 0, CTL_BYTES = 1 * MiB;
constexpr size_t WS_MODP = 1 * MiB;
constexpr size_t WS_MOD = 3 * MiB;
constexpr size_t WS_WRT = 7 * MiB;
constexpr size_t WS_ROPEM = 4 * MiB;
constexpr size_t WS_ROPED = 6 * MiB;
constexpr size_t WS_WIN = 8 * MiB;
constexpr size_t WS_WUQ = 26 * MiB;
constexpr size_t WS_WUKV = 29 * MiB;
constexpr size_t WS_WOUT = 31 * MiB;
constexpr size_t WS_WGU = 40 * MiB;
constexpr size_t WS_WD = 300 * MiB;
constexpr size_t WS_H2 = 430 * MiB;
constexpr size_t WS_ACT = 462 * MiB;
constexpr size_t WS_ROWL = 550 * MiB;
constexpr size_t WS_TOPW = 552 * MiB;
constexpr size_t WS_TPOS = 554 * MiB;
constexpr size_t WS_SSQ = 553 * MiB;
constexpr size_t WS_R1 = 556 * MiB;
constexpr size_t R_QLAT = WS_R1 + 0 * MiB;
constexpr size_t R_KVLAT = WS_R1 + 12 * MiB;
constexpr size_t R_KPE = WS_R1 + 20 * MiB;
constexpr size_t R_DQ = WS_R1 + 21 * MiB;
constexpr size_t R_DK = WS_R1 + 37 * MiB;
constexpr size_t R_DV = WS_R1 + 53 * MiB;
constexpr size_t R_QM = WS_R1 + 69 * MiB;
constexpr size_t R_KVM = WS_R1 + 93 * MiB;
constexpr size_t R_OATT = WS_R1 + 125 * MiB;
constexpr size_t R_Y = WS_R1 + 157 * MiB;
constexpr size_t R_OC = WS_R1 + 221 * MiB;
constexpr size_t R_X1 = WS_R1 + 224 * MiB;
constexpr size_t R_YSLOT = WS_R1;
constexpr size_t WS_END = WS_R1 + 288 * MiB;

constexpr int CW_GCNT = 64;

struct Params {
  const float* in[27];
  float* out;
  unsigned char* ws;
};

__device__ __forceinline__ unsigned f2bf(float f) { unsigned u = __builtin_bit_cast(unsigned, f); return (u + 0x7fffu + ((u >> 16) & 1u)) >> 16; }
__device__ __forceinline__ unsigned pk2(float lo, float hi) { return f2bf(lo) | (f2bf(hi) << 16); }
__device__ __forceinline__ unsigned cvtpk2(float lo, float hi) { f32x2 v = {lo, hi}; bf16x2_t b = __builtin_convertvector(v, bf16x2_t); return __builtin_bit_cast(unsigned, b); }
__device__ __forceinline__ u32x4 pack8(const f32x4& a, const f32x4& b) { return (u32x4){cvtpk2(a.x, a.y), cvtpk2(a.z, a.w), cvtpk2(b.x, b.y), cvtpk2(b.z, b.w)}; }
__device__ __forceinline__ u32x2 pack8_fp8(const f32x4& a, const f32x4& b) {
  int lo = __builtin_amdgcn_cvt_pk_fp8_f32(a.x, a.y, 0, false); lo = __builtin_amdgcn_cvt_pk_fp8_f32(a.z, a.w, lo, true);
  int hi = __builtin_amdgcn_cvt_pk_fp8_f32(b.x, b.y, 0, false); hi = __builtin_amdgcn_cvt_pk_fp8_f32(b.z, b.w, hi, true);
  return (u32x2){(unsigned)lo, (unsigned)hi};
}
__device__ __forceinline__ f32x4 unpack4_fp8(unsigned v) { const f32x2 a = __builtin_amdgcn_cvt_pk_f32_fp8((int)v, false), b = __builtin_amdgcn_cvt_pk_f32_fp8((int)v, true); return (f32x4){a.x, a.y, b.x, b.y}; }
__device__ __forceinline__ float bf_lo(unsigned u) { return __uint_as_float(u << 16); }
__device__ __forceinline__ float bf_hi(unsigned u) { return __uint_as_float(u & 0xffff0000u); }
__device__ __forceinline__ float bf1(bf16_t h) { return __uint_as_float(((unsigned)h) << 16); }
__device__ __forceinline__ float wave_sum(float v) {
#pragma unroll
  for (int o = 1; o < 64; o <<= 1) v += __shfl_xor(v, o);
  return v;
}
__device__ __forceinline__ float dot2bf(unsigned a, unsigned b, float c) {
  return __builtin_amdgcn_fdot2_f32_bf16(__builtin_bit_cast(bf16x2_t, a), __builtin_bit_cast(bf16x2_t, b), c, false);
}
__device__ __forceinline__ void sincos_rev(float ang, float& c, float& s) {
  float rev = ang * 0.15915494309189535f;
  rev = rev - floorf(rev);
  s = __builtin_amdgcn_sinf(rev);
  c = __builtin_amdgcn_cosf(rev);
}
__device__ __forceinline__ int opaque_tid() { int t = threadIdx.x; asm volatile("" : "+v"(t)); return t; }
__device__ __forceinline__ int perm32(int rho) { const int n = rho >> 4, i = rho & 15; return 8 * (i >> 2) + 4 * n + (i & 3); }

struct TrDesc { const float* src; bf16_t* dst; const float* gs; int ldw, ldt; int f8; };
template <bool NT> __device__ __forceinline__ void tr_load(const TrDesc& d, f32x4 (&v)[8], int lane) {
  const float* s = d.src + (size_t)(lane >> 3) * d.ldw + 4 * (lane & 7);
#pragma unroll
  for (int i = 0; i < 8; ++i) { const f32x4* q = (const f32x4*)(s + (size_t)(8 * i) * d.ldw); v[i] = NT ? __builtin_nontemporal_load(q) : *q; }
}
template <bool NT> __device__ __forceinline__ void tr_load_pair(const TrDesc& d, f32x4 (&v)[8], int lane) {
  const float* s = d.src + (size_t)(2 * (lane >> 3)) * d.ldw + 4 * (lane & 7);
#pragma unroll
  for (int i = 0; i < 8; ++i) { const f32x4* q = (const f32x4*)(s + (size_t)(16 * (i >> 1) + (i & 1)) * d.ldw); v[i] = NT ? __builtin_nontemporal_load(q) : *q; }
}
template <bool NT> __device__ __forceinline__ void tr_finish_pair(const TrDesc& d, f32x4 (&v)[8], float* scr, int lane) {
  const int r8 = lane >> 3, c4 = lane & 7;
  const unsigned sb = (unsigned)(uintptr_t)scr;
  const unsigned wa = sb + (unsigned)((c4 >> 2) * 1024 + r8 * 32 + 8 * (c4 & 3));
#pragma unroll
  for (int j = 0; j < 4; ++j) {
    const f32x4 a = v[2 * j] * 32.0f, b = v[2 * j + 1] * 32.0f;
    int d0 = __builtin_amdgcn_cvt_pk_fp8_f32(a.x, b.x, 0, false); d0 = __builtin_amdgcn_cvt_pk_fp8_f32(a.y, b.y, d0, true);
    int d1 = __builtin_amdgcn_cvt_pk_fp8_f32(a.z, b.z, 0, false); d1 = __builtin_amdgcn_cvt_pk_fp8_f32(a.w, b.w, d1, true);
    const u32x2 w = (u32x2){(unsigned)d0, (unsigned)d1};
    asm volatile("ds_write_b64 %0, %1 offset:%c2" :: "v"(wa), "v"(w), "i"(256 * j) : "memory");
  }
  const int g = lane >> 4, q = lane & 15, r = q >> 2, c = q & 3, odd = g & 1;
  const unsigned ra = sb + (unsigned)((2 * g + odd) * 128 + r * 32 + 8 * c), rb = sb + (unsigned)((2 * g + 1 - odd) * 128 + r * 32 + 8 * c);
  u32x2 R0, R1, R2, R3;
  asm volatile("ds_read_b64_tr_b16 %0, %4\n\tds_read_b64_tr_b16 %1, %5\n\tds_read_b64_tr_b16 %2, %4 offset:1024\n\tds_read_b64_tr_b16 %3, %5 offset:1024\n\ts_waitcnt lgkmcnt(0)"
               : "=&v"(R0), "=&v"(R1), "=&v"(R2), "=&v"(R3) : "v"(ra), "v"(rb) : "memory");
  unsigned char* o = (unsigned char*)d.dst + (size_t)q * d.ldt + 16 * g;
  const u32x4 o0 = odd ? (u32x4){R1.x, R1.y, R0.x, R0.y} : (u32x4){R0.x, R0.y, R1.x, R1.y}, o1 = odd ? (u32x4){R3.x, R3.y, R2.x, R2.y} : (u32x4){R2.x, R2.y, R3.x, R3.y};
  u32x4* q0 = (u32x4*)o; u32x4* q1 = (u32x4*)(o + (size_t)16 * d.ldt);
  if (NT) { __builtin_nontemporal_store(o0, q0); __builtin_nontemporal_store(o1, q1); } else { *q0 = o0; *q1 = o1; }
}
template <bool NT> __device__ __forceinline__ void tr_finish(const TrDesc& d, f32x4 (&v)[8], float* scr, int lane) {
  const int r8 = lane >> 3, c4 = lane & 7;
  if (d.gs) {
#pragma unroll
    for (int i = 0; i < 8; ++i) v[i] *= d.gs[8 * i + r8];
  }
#pragma unroll
  for (int i = 0; i < 8; ++i) { float* t = scr + (8 * i + r8) * 33 + 4 * c4; t[0] = v[i].x; t[1] = v[i].y; t[2] = v[i].z; t[3] = v[i].w; }
  asm volatile("s_waitcnt lgkmcnt(0)" ::: "memory");
  const int c = lane & 7;
  if (d.f8) {
#pragma unroll
    for (int j = 0; j < 4; ++j) {
      const int n = (lane >> 3) + 8 * j; const float* s = scr + (8 * c) * 33 + n;
      const f32x4 a = (f32x4){s[0 * 33], s[1 * 33], s[2 * 33], s[3 * 33]} * 32.0f, b = (f32x4){s[4 * 33], s[5 * 33], s[6 * 33], s[7 * 33]} * 32.0f;
      const u32x2 o = pack8_fp8(a, b);
      u32x2* q = (u32x2*)((unsigned char*)d.dst + (size_t)n * d.ldt + 8 * c);
      if (NT) __builtin_nontemporal_store(o, q); else *q = o;
    }
  } else {
#pragma unroll
    for (int j = 0; j < 4; ++j) {
      const int n = (lane >> 3) + 8 * j; const float* s = scr + (8 * c) * 33 + n;
      u32x4 o; o.x = cvtpk2(s[0 * 33], s[1 * 33]); o.y = cvtpk2(s[2 * 33], s[3 * 33]); o.z = cvtpk2(s[4 * 33], s[5 * 33]); o.w = cvtpk2(s[6 * 33], s[7 * 33]);
      u32x4* q = (u32x4*)(d.dst + (size_t)n * d.ldt + 8 * c);
      if (NT) __builtin_nontemporal_store(o, q); else *q = o;
    }
  }
  asm volatile("s_waitcnt lgkmcnt(0)" ::: "memory");
}
constexpr int I_WIN = 32 * 138, I_WUQ = 12 * 48, I_WUKV = 8 * 64, I_WOUT = 32 * 64, I_GU = 65 * 1024, I_DN = 65 * 512;
constexpr int TR_SMALL = I_WIN + I_WUQ + I_WUKV + I_WOUT, TOTAL_TR = TR_SMALL + I_GU + I_DN;
constexpr int TR_FG = TR_SMALL - I_WOUT;
constexpr int CONV_CHUNK = 64, N_CONV_CHUNKS = (I_WOUT + I_GU + I_DN) / CONV_CHUNK;
static_assert((I_WOUT + I_GU + I_DN) % CONV_CHUNK == 0, "chunking");
__device__ __forceinline__ TrDesc tr_decode(const Params& p, int r) {
  unsigned char* ws = p.ws; TrDesc d; d.gs = nullptr; d.f8 = 0;
  if (r < I_WIN) {
    const int kb = r / 138, nb = r % 138, n0 = 32 * nb, k0 = 64 * kb;
    const int d0 = n0 < 1344 ? n0 : n0 + 192;
    d.src = p.in[5] + (size_t)k0 * 4416 + n0; d.ldw = 4416; d.dst = (bf16_t*)(ws + WS_WIN) + (size_t)d0 * 2048 + k0; d.ldt = 2048; return d;
  }
  r -= I_WIN;
  if (r < I_WUQ) { const int kb = r / 48, nb = r % 48, k0 = 64 * kb, n0 = 32 * nb;
    d.src = p.in[7] + (size_t)k0 * 1536 + n0; d.ldw = 1536; d.dst = (bf16_t*)(ws + WS_WUQ) + (size_t)n0 * 768 + k0; d.ldt = 768; d.gs = p.in[6] + k0; return d; }
  r -= I_WUQ;
  if (r < I_WUKV) { const int kb = r / 64, nb = r % 64, k0 = 64 * kb, n0 = 32 * nb;
    d.src = p.in[9] + (size_t)k0 * 2048 + n0; d.ldw = 2048; d.dst = (bf16_t*)(ws + WS_WUKV) + (size_t)n0 * 512 + k0; d.ldt = 512; d.gs = p.in[8] + k0; return d; }
  r -= I_WUKV;
  if (r < I_WOUT) { const int kb = r / 64, nb = r % 64, k0 = 64 * kb, n0 = 32 * nb;
    d.src = p.in[15] + (size_t)k0 * 2048 + n0; d.ldw = 2048; d.dst = (bf16_t*)(ws + WS_WOUT) + (size_t)n0 * 2048 + k0; d.ldt = 2048; return d; }
  r -= I_WOUT;
  if (r < I_GU) {
    const int e = r >> 10, q = r & 1023, up = q >> 9, idx = q & 511, kb = idx >> 4, nb = idx & 15, n0 = 32 * nb, k0 = 64 * kb;
    const float* s = (e < 64) ? (p.in[up ? 21 : 20] + (size_t)e * 2048 * 512) : p.in[up ? 24 : 23];
    const int d0 = 256 * (n0 >> 7) + (n0 & 127) + 128 * up;
    d.src = s + (size_t)k0 * 512 + n0; d.ldw = 512; d.dst = (bf16_t*)(ws + WS_WGU + (size_t)e * 1024 * 2048 + (size_t)d0 * 2048 + k0); d.ldt = 2048; d.f8 = 1; return d;
  }
  r -= I_GU;
  { const int e = r >> 9, idx = r & 511, kb = idx >> 6, nb = idx & 63, k0 = 64 * kb, n0 = 32 * nb;
    const float* s = (e < 64) ? (p.in[22] + (size_t)e * 512 * 2048) : p.in[25];
    d.src = s + (size_t)k0 * 2048 + n0; d.ldw = 2048; d.dst = (bf16_t*)(ws + WS_WD + (size_t)e * 2048 * 512 + (size_t)n0 * 512 + k0); d.ldt = 512; d.f8 = 1; return d; }
}
__device__ __forceinline__ void phase0a(const Params& p, char* lds) {
  const int tid = opaque_tid(), lane = tid & 63, wave = tid >> 6;
  const int gw = blockIdx.x * NWAVES + wave, NGW = gridDim.x * NWAVES;
  float* scr = (float*)(lds + wave * 16384);
  unsigned char* ws = p.ws;
  for (int r = gw; r < 48 * 32; r += NGW) {
    const int nt = r % 48, ks = r / 48;
    const float* c = p.in[1]; const float* w = p.in[2] + (size_t)(64 * ks) * 12288 + 256 * nt + 4 * lane;
    f32x4 acc = {0.f, 0.f, 0.f, 0.f};
    const float cl = c[64 * ks + lane]; const float sl = cl / (1.f + expf(-cl));
#pragma unroll
    for (int k = 0; k < 64; ++k) {
      const float sv = __int_as_float(__builtin_amdgcn_readlane(__float_as_int(sl), k));
      const f32x4 wv = *(const f32x4*)(w + (size_t)k * 12288);
      acc += wv * sv;
    }
    *(f32x4*)((float*)(ws + WS_MODP) + (size_t)ks * 12288 + 256 * nt + 4 * lane) = acc;
  }
  {
    f32x4 vA[8], vB[8]; TrDesc dA, dB;
    int it = gw;
    if (it < TR_FG) {
      dA = tr_decode(p, it); tr_load<false>(dA, vA, lane);
      for (;;) {
        const int itB = it + NGW; const bool hasB = itB < TR_FG;
        if (hasB) { dB = tr_decode(p, itB); tr_load<false>(dB, vB, lane); }
        tr_finish<false>(dA, vA, scr, lane);
        if (!hasB) break;
        const int itA = itB + NGW; const bool hasA = itA < TR_FG;
        if (hasA) { dA = tr_decode(p, itA); tr_load<false>(dA, vA, lane); }
        tr_finish<false>(dB, vB, scr, lane);
        if (!hasA) break;
        it = itA;
      }
    }
  }
  const int gt = blockIdx.x * NTHREADS + tid, NGT = gridDim.x * NTHREADS;
  for (int i = gt; i < T * 40; i += NGT) {
    if (i < T * 32) {
      const int pos = i >> 5, f = i & 31;
      const float inv = powf(500000.0f, -(float)(2 * f) / 64.0f);
      float c, s; sincos_rev((float)pos * inv, c, s);
      ((f32x2*)(ws + WS_ROPEM))[i] = (f32x2){c, s};
    } else {
      const int j = i - T * 32, pos = j >> 3, f = j & 7;
      const float inv = powf(500000.0f, -(float)(2 * f) / 16.0f);
      float c, s; sincos_rev((float)pos * inv, c, s);
      ((f32x2*)(ws + WS_ROPED))[j] = (f32x2){c, s};
    }
  }
  for (int i = gt; i < 64 * 4 * 64; i += NGT) {
    const int l = i & 63, jt = (i >> 6) & 3, s = i >> 8;
    const float* w = p.in[18] + (size_t)(32 * s + 8 * (l >> 4)) * 64 + 16 * jt + (l & 15);
    float v[8], lo[8];
#pragma unroll
    for (int j = 0; j < 8; ++j) { v[j] = w[(size_t)j * 64]; lo[j] = v[j] - bf1((bf16_t)f2bf(v[j])); }
    ((u32x4*)(ws + WS_WRT))[i] = (u32x4){pk2(v[0], v[1]), pk2(v[2], v[3]), pk2(v[4], v[5]), pk2(v[6], v[7])};
    ((u32x4*)(ws + WS_WRT + 256 * 1024))[i] = (u32x4){pk2(lo[0], lo[1]), pk2(lo[2], lo[3]), pk2(lo[4], lo[5]), pk2(lo[6], lo[7])};
  }
  if (blockIdx.x == 0 && tid == 0) {
    float a = 0.f, b = 0.f;
    for (int i = 0; i < 64; ++i) { a += p.in[10][i] * p.in[11][i]; b += p.in[12][i] * p.in[13][i]; }
    ((float*)(ws + WS_MOD))[16384] = expf(a) - expf(b) + 0.2f;
  }
}


__device__ __forceinline__ void conv_chunk(const Params& p, char* lds, int chunk) {
  const int tid = opaque_tid(), lane = tid & 63, wave = tid >> 6;
  float* scr = (float*)(lds + wave * 16384);
  const int base = TR_FG + chunk * CONV_CHUNK + wave * 8;
  f32x4 vA[8], vB[8], vC[8], vD[8]; TrDesc dA, dB, dC, dD;
  if (chunk * CONV_CHUNK >= I_WOUT) {
    dA = tr_decode(p, base + 0); tr_load_pair<true>(dA, vA, lane);
    dB = tr_decode(p, base + 1); tr_load_pair<true>(dB, vB, lane);
    dC = tr_decode(p, base + 2); tr_load_pair<true>(dC, vC, lane);
    dD = tr_decode(p, base + 3); tr_load_pair<true>(dD, vD, lane);
    tr_finish_pair<true>(dA, vA, scr, lane); dA = tr_decode(p, base + 4); tr_load_pair<true>(dA, vA, lane);
    tr_finish_pair<true>(dB, vB, scr, lane); dB = tr_decode(p, base + 5); tr_load_pair<true>(dB, vB, lane);
    tr_finish_pair<true>(dC, vC, scr, lane); dC = tr_decode(p, base + 6); tr_load_pair<true>(dC, vC, lane);
    tr_finish_pair<true>(dD, vD, scr, lane); dD = tr_decode(p, base + 7); tr_load_pair<true>(dD, vD, lane);
    tr_finish_pair<true>(dA, vA, scr, lane);
    tr_finish_pair<true>(dB, vB, scr, lane);
    tr_finish_pair<true>(dC, vC, scr, lane);
    tr_finish_pair<true>(dD, vD, scr, lane);
    return;
  }
  dA = tr_decode(p, base + 0); tr_load<true>(dA, vA, lane);
  dB = tr_decode(p, base + 1); tr_load<true>(dB, vB, lane);
  dC = tr_decode(p, base + 2); tr_load<true>(dC, vC, lane);
  dD = tr_decode(p, base + 3); tr_load<true>(dD, vD, lane);
  tr_finish<true>(dA, vA, scr, lane); dA = tr_decode(p, base + 4); tr_load<true>(dA, vA, lane);
  tr_finish<true>(dB, vB, scr, lane); dB = tr_decode(p, base + 5); tr_load<true>(dB, vB, lane);
  tr_finish<true>(dC, vC, scr, lane); dC = tr_decode(p, base + 6); tr_load<true>(dC, vC, lane);
  tr_finish<true>(dD, vD, scr, lane); dD = tr_decode(p, base + 7); tr_load<true>(dD, vD, lane);
  tr_finish<true>(dA, vA, scr, lane);
  tr_finish<true>(dB, vB, scr, lane);
  tr_finish<true>(dC, vC, scr, lane);
  tr_finish<true>(dD, vD, scr, lane);
}

__device__ __forceinline__ void phase0b(const Params& p, char* lds) {
  const int tid = opaque_tid(), lane = tid & 63, wave = tid >> 6;
  const int gw = blockIdx.x * NWAVES + wave, NGW = gridDim.x * NWAVES;
  unsigned char* ws = p.ws;
  const float* modp = (const float*)(ws + WS_MODP);
  float* shsc = (float*)lds;
  {
    float acc8[8];
#pragma unroll
    for (int i = 0; i < 8; ++i) acc8[i] = p.in[3][tid + NTHREADS * i];
#pragma unroll 8
    for (int k = 0; k < 32; ++k)
#pragma unroll
      for (int i = 0; i < 8; ++i) acc8[i] += modp[(size_t)k * 12288 + tid + NTHREADS * i];
#pragma unroll
    for (int i = 0; i < 8; ++i) shsc[tid + NTHREADS * i] = acc8[i];
  }
  for (int n = blockIdx.x * NTHREADS + tid; n < 12288; n += gridDim.x * NTHREADS) { float s = p.in[3][n]; for (int k = 0; k < 32; ++k) s += modp[(size_t)k * 12288 + n]; ((float*)(ws + WS_MOD))[n] = s; }
  __syncthreads();
  const float* x = p.in[0]; const float* g = p.in[4];
  bf16_t* xn = (bf16_t*)(ws + WS_H2);
  f32x4 v[8]; int row = gw;
  if (row < T) {
#pragma unroll
    for (int j = 0; j < 8; ++j) v[j] = *(const f32x4*)(x + (size_t)row * D + 256 * j + 4 * lane);
  }
  for (; row < T; row += NGW) {
    f32x4 vn[8]; const int nrow = row + NGW;
    if (nrow < T) {
#pragma unroll
      for (int j = 0; j < 8; ++j) vn[j] = *(const f32x4*)(x + (size_t)nrow * D + 256 * j + 4 * lane);
    }
    float ss = 0.f;
#pragma unroll
    for (int j = 0; j < 8; ++j) ss += v[j].x * v[j].x + v[j].y * v[j].y + v[j].z * v[j].z + v[j].w * v[j].w;
    const float rstd = 1.0f / sqrtf(wave_sum(ss) * (1.0f / D) + EPS);
#pragma unroll
    for (int j = 0; j < 8; ++j) {
      const int c0 = 256 * j + 4 * lane;
      const f32x4 gv = *(const f32x4*)(g + c0);
      const f32x4 sh = *(const f32x4*)(shsc + c0), sc = *(const f32x4*)(shsc + 2048 + c0);
      const f32x4 h = (v[j] * rstd) * gv * (sc + 1.0f) + sh;
      u32x2 o; o.x = pk2(h.x, h.y); o.y = pk2(h.z, h.w);
      *(u32x2*)(xn + (size_t)row * D + c0) = o;
    }
#pragma unroll
    for (int j = 0; j < 8; ++j) v[j] = vn[j];
  }
}

template <bool PERM> __device__ __forceinline__ int acc_col(int bj, int wc, int n, int fq) { return 128 * bj + 32 * wc + (PERM ? 8 * fq + 4 * n : 16 * n + 4 * fq); }
__device__ __forceinline__ int acc_row(int ai, int wr, int m, int fr) { return 128 * ai + 64 * wr + 16 * m + fr; }

template <bool PERM, class RowMap, class Epi, class U>
__device__ __forceinline__ void gemm_tile_naive(const bf16_t* A, int lda, const bf16_t* Bt, int K, const RowMap& rm, const Epi& epi, const U& unit) {
  const int tid = opaque_tid(), lane = tid & 63, wid = tid >> 6, wr = wid >> 2, wc = wid & 3, fr = lane & 15, fq = lane >> 4;
  f32x4 acc[2][2][4][2];
#pragma unroll
  for (int a = 0; a < 2; ++a)
#pragma unroll
    for (int b = 0; b < 2; ++b)
#pragma unroll
      for (int m = 0; m < 4; ++m)
#pragma unroll
        for (int n = 0; n < 2; ++n) acc[a][b][m][n] = (f32x4){0.f, 0.f, 0.f, 0.f};
  unsigned aoff[2][4], boff[2][2];
#pragma unroll
  for (int a = 0; a < 2; ++a)
#pragma unroll
    for (int m = 0; m < 4; ++m) aoff[a][m] = (unsigned)rm(acc_row(a, wr, m, fr)) * (unsigned)lda + 8u * fq;
#pragma unroll
  for (int b = 0; b < 2; ++b)
#pragma unroll
    for (int n = 0; n < 2; ++n) { const int rho = 16 * n + fr; boff[b][n] = (unsigned)(128 * b + 32 * wc + (PERM ? perm32(rho) : rho)) * (unsigned)K + 8u * fq; }
  for (int k0 = 0; k0 < K; k0 += 32) {
    bf16x8 af[2][4], bfr[2][2];
#pragma unroll
    for (int a = 0; a < 2; ++a)
#pragma unroll
      for (int m = 0; m < 4; ++m) af[a][m] = *(const bf16x8*)(A + aoff[a][m] + k0);
#pragma unroll
    for (int b = 0; b < 2; ++b)
#pragma unroll
      for (int n = 0; n < 2; ++n) bfr[b][n] = *(const bf16x8*)(Bt + boff[b][n] + k0);
#pragma unroll
    for (int a = 0; a < 2; ++a)
#pragma unroll
      for (int b = 0; b < 2; ++b)
#pragma unroll
        for (int m = 0; m < 4; ++m)
#pragma unroll
          for (int n = 0; n < 2; ++n) acc[a][b][m][n] = __builtin_amdgcn_mfma_f32_16x16x32_bf16(bfr[b][n], af[a][m], acc[a][b][m][n], 0, 0, 0);
  }
  epi(acc, unit, wr, wc, fr, fq);
}


#define LAS __attribute__((address_space(3)))
namespace pg8 {
typedef int i32x4_t __attribute__((ext_vector_type(4)));
constexpr int BM = 256, BK = 64, HALF = 128, HTB = HALF * BK * 2, STAGE_BYTES = 8 * HTB, NXCD = 8, WGM = 8;
__host__ __device__ __forceinline__ int lds_byte(int r, int c) { const int st = (r >> 4) * 2 + (c >> 5), rr = r & 15, cc = c & 31, ob = rr * 64 + cc * 2; return st * 1024 + (ob ^ (((ob >> 9) & 1) << 5)); }
__host__ __device__ __forceinline__ void stage_rc(int b, int& R, int& C) { const int st = b / 1024, sb = b % 1024, swz = sb ^ (((sb >> 9) & 1) << 5); R = (st >> 1) * 16 + swz / 64; C = (st & 1) * 32 + (swz % 64) / 2; }
struct Unit { const char* A; const char* B; int pm, pn, e, aux; };

__device__ __forceinline__ int xcd_remap(int L, int nwg) { const int q = nwg / NXCD, r = nwg % NXCD, xcd = L % NXCD, off = L / NXCD; return (xcd < r ? xcd * (q + 1) : r * (q + 1) + (xcd - r) * q) + off; }

template <class Epi, class Sched, bool ALIGN_EPI, bool GATHER, bool F8 = false, bool MERGEB = false>
__device__ __forceinline__ void gemm_phase(LAS unsigned char* lds, const int K, const Sched& S, const Epi& E) {
    const int tid = opaque_tid(), wid = __builtin_amdgcn_readfirstlane(tid >> 6), lane = tid & 63, wr = wid >> 2, wc = wid & 3, fr = lane & 15, fq = lane >> 4;
    const int nt = K / BK;
    unsigned voffB[2];
#pragma unroll
    for (int i = 0; i < 2; ++i) { int R, C; stage_rc(tid * 16 + i * 8192, R, C); const int Rb = MERGEB ? (64 * (R >> 5) + 16 * ((R >> 2) & 3) + 4 * ((R >> 4) & 1) + (R & 3)) : Epi::PERM ? ((R & ~31) + perm32(R & 31)) : R; voffB[i] = (unsigned)(Rb * K + C) * 2u; }
    const size_t kstep = (size_t)(BK * 2);
    const size_t hstep = MERGEB ? (size_t)8 * K * 2 : (size_t)HALF * K * 2;
    const unsigned ldsw = (unsigned)wid * 1024u;
    const int aoff = lds_byte(wr * 64 + fr, fq * 8), boff = lds_byte(wc * 32 + fr, fq * 8);
#define PG8_SA(b, h) (((b) * 2 + (h)) * HTB)
#define PG8_SB(b, h) ((4 + (b) * 2 + (h)) * HTB)
#define PG8_STAGE(bufoff, gbase, voff) do { _Pragma("unroll") for (int _i = 0; _i < 2; ++_i) \
        __builtin_amdgcn_global_load_lds((const unsigned*)((const char*)(gbase) + (voff)[_i]), (LAS unsigned*)(lds + (bufoff) + ldsw + _i * 8192), 16, 0, 0); } while (0)
#define PG8_LDA(dst, b, h) do { _Pragma("unroll") for (int m = 0; m < 4; ++m) _Pragma("unroll") for (int k = 0; k < 2; ++k) dst[m][k] = *(const LAS bf16x8*)(lds + PG8_SA(b, h) + aoff + m * 2048 + k * 1024); } while (0)
#define PG8_LDB(dst, b, h) do { _Pragma("unroll") for (int n = 0; n < 2; ++n) _Pragma("unroll") for (int k = 0; k < 2; ++k) dst[n][k] = *(const LAS bf16x8*)(lds + PG8_SB(b, h) + boff + n * 2048 + k * 1024); } while (0)
#define PG8_CAT(x, y) __builtin_shufflevector(__builtin_bit_cast(i32x4_t, x), __builtin_bit_cast(i32x4_t, y), 0, 1, 2, 3, 4, 5, 6, 7)
#define PG8_MMA(ai, bj, At, Bt) do { __builtin_amdgcn_s_setprio(1); _Pragma("unroll") for (int m = 0; m < 4; ++m) _Pragma("unroll") for (int n = 0; n < 2; ++n) { \
        if constexpr (F8) { const auto _a8 = PG8_CAT(Bt[n][0], Bt[n][1]); const auto _b8 = PG8_CAT(At[m][0], At[m][1]); \
          asm("v_mfma_scale_f32_16x16x128_f8f6f4 %0, %1, %2, %0, %3, %3 op_sel_hi:[0,0,0]" : "+v"(acc[ai][bj][m][n]) : "v"(_a8), "v"(_b8), "v"(mxs)); } \
        else { _Pragma("unroll") for (int k = 0; k < 2; ++k) acc[ai][bj][m][n] = __builtin_amdgcn_mfma_f32_16x16x32_bf16(Bt[n][k], At[m][k], acc[ai][bj][m][n], 0, 0, 0); } } \
        __builtin_amdgcn_s_setprio(0); } while (0)
#define PG8_WAIT_V(n) asm volatile("s_waitcnt vmcnt(" #n ")" ::: "memory")
#define PG8_WAIT_L(n) asm volatile("s_waitcnt lgkmcnt(" #n ")" ::: "memory")
#define PG8_WAIT_V8_UNLESS(f) asm volatile("s_cmp_lg_u32 %0, 0\n\ts_cbranch_scc1 .Lpg8skip%=\n\ts_waitcnt vmcnt(8)\n.Lpg8skip%=:" :: "s"(f) : "memory", "scc")
#define PG8_BAR __builtin_amdgcn_s_barrier()
#define PG8_SCHED __builtin_amdgcn_sched_barrier(0)
    const int mxs = 0x7f7f7f7f;
    (void)mxs;
    Unit cur, nxt; int ui = 0;
    if (!S.next(0, cur)) return;
    unsigned vA[2][2], vN[2][2];
#define PG8_MKOFF(u, v) do { _Pragma("unroll") for (int _h = 0; _h < 2; ++_h) _Pragma("unroll") for (int _i = 0; _i < 2; ++_i) { int _R, _C; stage_rc(opaque_tid() * 16 + _i * 8192, _R, _C); \
        v[_h][_i] = (unsigned)((GATHER ? S.row(u, _h * HALF + _R) : (_h * HALF + _R)) * K + _C) * 2u; } } while (0)
    PG8_MKOFF(cur, vA);
    f32x4 acc[2][2][4][2];
#pragma unroll
    for (int a = 0; a < 2; ++a)
#pragma unroll
        for (int b = 0; b < 2; ++b)
#pragma unroll
            for (int m = 0; m < 4; ++m)
#pragma unroll
                for (int n = 0; n < 2; ++n) acc[a][b][m][n] = (f32x4){0.f, 0.f, 0.f, 0.f};
    bf16x8 At[4][2], B0[2][2], B1[2][2];
    const char* cA = cur.A; const char* cB = cur.B;
    PG8_STAGE(PG8_SB(0, 0), cB, voffB); PG8_STAGE(PG8_SB(0, 1), cB + hstep, voffB); PG8_STAGE(PG8_SA(0, 0), cA, vA[0]); PG8_STAGE(PG8_SA(0, 1), cA, vA[1]);
    if (wr == 1) PG8_BAR;
    PG8_WAIT_V(2); PG8_BAR;
    PG8_STAGE(PG8_SB(1, 0), cB + kstep, voffB); PG8_STAGE(PG8_SA(1, 0), cA + kstep, vA[0]); PG8_STAGE(PG8_SB(1, 1), cB + hstep + kstep, voffB);
    PG8_WAIT_V(6); PG8_BAR;
    for (;;) {
        const bool has_next = S.next(ui + 1, nxt);
        if (has_next) { PG8_MKOFF(nxt, vN); } else {
#pragma unroll
            for (int h = 0; h < 2; ++h)
#pragma unroll
                for (int i = 0; i < 2; ++i) vN[h][i] = vA[h][i]; }
        const char* nA = has_next ? nxt.A : cA; const char* nB = has_next ? nxt.B : cB;
        for (int t = 0; t < nt; t += 2) {
            const bool last = (t == nt - 2); const int seam = __builtin_amdgcn_readfirstlane((t == 0 && ui > 0) ? 1 : 0);
            const char* a1 = cA + (size_t)(t + 1) * kstep;
            const char* a2 = last ? nA : cA + (size_t)(t + 2) * kstep; const char* b2 = last ? nB : cB + (size_t)(t + 2) * kstep;
            const char* a3 = a2 + kstep; const char* b3 = b2 + kstep;
            unsigned w0[2], w1[2];
#pragma unroll
            for (int i = 0; i < 2; ++i) { w0[i] = last ? vN[0][i] : vA[0][i]; w1[i] = last ? vN[1][i] : vA[1][i]; }
            PG8_LDB(B0, 0, 0); PG8_LDB(B1, 0, 1); PG8_SCHED; PG8_LDA(At, 0, 0); PG8_STAGE(PG8_SA(1, 1), a1, vA[1]);
            PG8_WAIT_V8_UNLESS(seam);
            PG8_WAIT_L(0); PG8_BAR; PG8_MMA(0, 0, At, B0); PG8_MMA(0, 1, At, B1); PG8_BAR; PG8_SCHED;
            PG8_LDA(At, 0, 1); PG8_STAGE(PG8_SB(0, 0), b2, voffB); PG8_STAGE(PG8_SB(0, 1), b2 + hstep, voffB); PG8_STAGE(PG8_SA(0, 0), a2, w0);
            PG8_WAIT_V8_UNLESS(seam);
            PG8_WAIT_L(0); PG8_BAR; PG8_MMA(1, 0, At, B0); PG8_MMA(1, 1, At, B1); PG8_BAR; PG8_SCHED;
            PG8_LDB(B0, 1, 0); PG8_LDB(B1, 1, 1); PG8_SCHED; PG8_LDA(At, 1, 0); PG8_STAGE(PG8_SA(0, 1), a2, w1);
            PG8_WAIT_V(8); PG8_WAIT_L(0); PG8_BAR; PG8_MMA(0, 0, At, B0); PG8_MMA(0, 1, At, B1); PG8_BAR; PG8_SCHED;
            PG8_LDA(At, 1, 1); PG8_STAGE(PG8_SB(1, 0), b3, voffB); PG8_STAGE(PG8_SB(1, 1), b3 + hstep, voffB); PG8_STAGE(PG8_SA(1, 0), a3, w0);
            PG8_WAIT_V(8); PG8_WAIT_L(0); PG8_BAR; PG8_MMA(1, 0, At, B0); PG8_MMA(1, 1, At, B1); PG8_BAR; PG8_SCHED;
        }
        PG8_WAIT_V(0);
        if constexpr (ALIGN_EPI) { if (wr == 0) PG8_BAR; }
        if constexpr (F8) asm volatile("s_nop 15\n\ts_nop 7" ::: "memory");
        E(acc, cur, wr, wc, fr, fq);
        if (!has_next) break;
#pragma unroll
        for (int a = 0; a < 2; ++a)
#pragma unroll
            for (int b = 0; b < 2; ++b)
#pragma unroll
                for (int m = 0; m < 4; ++m)
#pragma unroll
                    for (int n = 0; n < 2; ++n) acc[a][b][m][n] = (f32x4){0.f, 0.f, 0.f, 0.f};
        cur = nxt; cA = nA; cB = nB; ++ui;
#pragma unroll
        for (int h = 0; h < 2; ++h)
#pragma unroll
            for (int i = 0; i < 2; ++i) vA[h][i] = vN[h][i];
        if constexpr (ALIGN_EPI) { if (wr == 1) PG8_BAR; }
    }
    PG8_WAIT_V(0);
    if constexpr (!ALIGN_EPI) { if (wr == 0) PG8_BAR; }
    PG8_BAR;
#undef PG8_SA
#undef PG8_SB
#undef PG8_STAGE
#undef PG8_LDA
#undef PG8_LDB
#undef PG8_MMA
#undef PG8_CAT
#undef PG8_WAIT_V
#undef PG8_WAIT_L
#undef PG8_WAIT_V8_UNLESS
#undef PG8_BAR
#undef PG8_SCHED
#undef PG8_MKOFF
}

struct SchedPlain {
    const char* A; const char* B; int nM, nN, nwg, G, c; size_t tstep;
    __device__ __forceinline__ SchedPlain(const void* A_, const void* B_, int M, int N, int K, int G_, int c_) : A((const char*)A_), B((const char*)B_), nM(M / BM), nN(N / BM), nwg((M / BM) * (N / BM)), G(G_), c(c_), tstep((size_t)BM * K * 2) {}
    __device__ __forceinline__ bool next(int i, Unit& u) const {
        const int L = i * G + c; if (L >= nwg) return false;
        const int wgid = xcd_remap(L, nwg);
        const int nig = WGM * nN, gid = wgid / nig, fm = gid * WGM, gsz = (nM - fm) < WGM ? (nM - fm) : WGM;
        u.pm = fm + ((wgid % nig) % gsz); u.pn = (wgid % nig) / gsz; u.e = 0; u.aux = 0;
        u.A = A + (size_t)u.pm * tstep; u.B = B + (size_t)u.pn * tstep; return true;
    }
    __device__ __forceinline__ int row(const Unit&, int r) const { return r; }
};
}

struct RowIdent { int base; __device__ __forceinline__ int operator()(int r) const { return base + r; } };

template <bool PERM_> struct EpiProj {
  static constexpr bool PERM = PERM_;
  unsigned char* ws; int pn_base;
  __device__ __forceinline__ void operator()(const f32x4 (&acc)[2][2][4][2], const pg8::Unit& u, int wr, int wc, int fr, int fq) const {
    const int pm = u.pm, pn = u.pn + pn_base;
    bf16_t* dst; int ld, cb; float* ssq = nullptr; int nss = 0, sidx = 0; int climit = 256; float osc = 1.0f;
    if (pn < 3) { dst = (bf16_t*)(ws + R_QLAT); ld = 768; cb = 256 * pn; ssq = (float*)(ws + WS_SSQ); nss = 12; sidx = 4 * pn + wc; }
    else if (pn < 5) { dst = (bf16_t*)(ws + R_KVLAT); ld = 512; cb = 256 * (pn - 3); ssq = (float*)(ws + WS_SSQ + 512 * 1024); nss = 8; sidx = 4 * (pn - 3) + wc; }
    else if (pn == 5) { dst = (bf16_t*)(ws + R_KPE); ld = 64; cb = 0; climit = 64; }
    else if (pn < 10) { dst = (bf16_t*)(ws + R_DQ); ld = 1024; cb = 256 * (pn - 6); osc = 0.125f * 1.4426950408889634f; }
    else if (pn < 14) { dst = (bf16_t*)(ws + R_DK); ld = 1024; cb = 256 * (pn - 10); }
    else { dst = (bf16_t*)(ws + R_DV); ld = 1024; cb = 256 * (pn - 14); }
#pragma unroll
    for (int ai = 0; ai < 2; ++ai)
#pragma unroll
      for (int m = 0; m < 4; ++m) {
        const int row = 256 * pm + acc_row(ai, wr, m, fr); float ss = 0.f;
#pragma unroll
        for (int bj = 0; bj < 2; ++bj) {
#pragma unroll
          for (int n = 0; n < 2; ++n) {
            const f32x4 v = acc[ai][bj][m][n];
            ss += v.x * v.x + v.y * v.y + v.z * v.z + v.w * v.w;
            if (!PERM) { const int c0 = acc_col<PERM>(bj, wc, n, fq); if (c0 < climit) { u32x2 o; o.x = cvtpk2(v.x * osc, v.y * osc); o.y = cvtpk2(v.z * osc, v.w * osc); *(u32x2*)(dst + (size_t)row * ld + cb + c0) = o; } }
          }
          if (PERM) { const int c0 = acc_col<PERM>(bj, wc, 0, fq); if (c0 < climit) *(u32x4*)(dst + (size_t)row * ld + cb + c0) = pack8(acc[ai][bj][m][0] * osc, acc[ai][bj][m][1] * osc); }
        }
        if (ssq) { ss += __shfl_xor(ss, 16); ss += __shfl_xor(ss, 32); if (fq == 0) ssq[(size_t)row * nss + sidx] = ss; }
      }
  }
};

template <bool PERM_> struct EpiRowScale {
  static constexpr bool PERM = PERM_;
  bf16_t* dst; int ld; const float* ssq; int nss; float invk; float post;
  __device__ __forceinline__ void operator()(const f32x4 (&acc)[2][2][4][2], const pg8::Unit& u, int wr, int wc, int fr, int fq) const {
    const int pm = u.pm, pn = u.pn;
#pragma unroll
    for (int ai = 0; ai < 2; ++ai)
#pragma unroll
      for (int m = 0; m < 4; ++m) {
        const int row = 256 * pm + acc_row(ai, wr, m, fr); float ss = 0.f;
        { const f32x4* sp = (const f32x4*)(ssq + (size_t)row * nss);
          const f32x4 s0 = sp[0], s1 = sp[1]; f32x4 s2 = {0.f, 0.f, 0.f, 0.f}; if (nss == 12) s2 = sp[2];
          const f32x4 sv = s0 + s1 + s2; ss = (sv.x + sv.y) + (sv.z + sv.w); }
        const float rstd = post * __builtin_amdgcn_rsqf(ss * invk + EPS);
#pragma unroll
        for (int bj = 0; bj < 2; ++bj) {
          if (PERM) *(u32x4*)(dst + (size_t)row * ld + 256 * pn + acc_col<PERM>(bj, wc, 0, fq)) = pack8(acc[ai][bj][m][0] * rstd, acc[ai][bj][m][1] * rstd);
          else {
#pragma unroll
            for (int n = 0; n < 2; ++n) {
              const f32x4 v = acc[ai][bj][m][n] * rstd; const int c0 = acc_col<PERM>(bj, wc, n, fq);
              u32x2 o; o.x = cvtpk2(v.x, v.y); o.y = cvtpk2(v.z, v.w); *(u32x2*)(dst + (size_t)row * ld + 256 * pn + c0) = o;
            }
          }
        }
      }
  }
};

template <bool PERM_> struct EpiF32 {
  static constexpr bool PERM = PERM_;
  float* dst; int ld;
  __device__ __forceinline__ void operator()(const f32x4 (&acc)[2][2][4][2], const pg8::Unit& u, int wr, int wc, int fr, int fq) const {
    const int pm = u.pm, pn = u.pn;
#pragma unroll
    for (int ai = 0; ai < 2; ++ai)
#pragma unroll
      for (int m = 0; m < 4; ++m) {
        const int row = 256 * pm + acc_row(ai, wr, m, fr);
#pragma unroll
        for (int bj = 0; bj < 2; ++bj)
#pragma unroll
          for (int n = 0; n < 2; ++n) *(f32x4*)(dst + (size_t)row * ld + 256 * pn + acc_col<PERM>(bj, wc, n, fq)) = acc[ai][bj][m][n];
      }
  }
};

template <bool PERM_> struct EpiBf16 {
  static constexpr bool PERM = PERM_;
  bf16_t* dst; int ld;
  __device__ __forceinline__ void operator()(const f32x4 (&acc)[2][2][4][2], const pg8::Unit& u, int wr, int wc, int fr, int fq) const {
    const int pm = u.pm, pn = u.pn;
#pragma unroll
    for (int ai = 0; ai < 2; ++ai)
#pragma unroll
      for (int m = 0; m < 4; ++m) {
        const int row = 256 * pm + acc_row(ai, wr, m, fr);
#pragma unroll
        for (int bj = 0; bj < 2; ++bj) {
          if (PERM) *(u32x4*)(dst + (size_t)row * ld + 256 * pn + acc_col<PERM>(bj, wc, 0, fq)) = pack8(acc[ai][bj][m][0], acc[ai][bj][m][1]);
          else {
#pragma unroll
            for (int n = 0; n < 2; ++n) { const f32x4 v = acc[ai][bj][m][n]; u32x2 o; o.x = cvtpk2(v.x, v.y); o.y = cvtpk2(v.z, v.w); *(u32x2*)(dst + (size_t)row * ld + 256 * pn + acc_col<PERM>(bj, wc, n, fq)) = o; }
          }
        }
      }
  }
};

template <bool PERM_> struct EpiSwiglu {
  static constexpr bool PERM = PERM_;
  bf16_t* act; float insc;
  __device__ __forceinline__ void operator()(const f32x4 (&acc)[2][2][4][2], const pg8::Unit& u, int wr, int wc, int fr, int fq) const {
    const int arow0 = 256 * u.pm, pn = u.pn;
#pragma unroll
    for (int ai = 0; ai < 2; ++ai)
#pragma unroll
      for (int m = 0; m < 4; ++m) {
        const int row = arow0 + acc_row(ai, wr, m, fr);
        f32x4 av[2];
#pragma unroll
        for (int n = 0; n < 2; ++n) {
          const f32x4 g = acc[ai][0][m][n] * insc, u = acc[ai][1][m][n] * insc; f32x4 a;
#define SWG(gv, uv) ((gv) * __builtin_amdgcn_rcpf(1.f + __builtin_amdgcn_exp2f(-1.4426950408889634f * (gv))) * (uv))
          a.x = SWG(g.x, u.x); a.y = SWG(g.y, u.y); a.z = SWG(g.z, u.z); a.w = SWG(g.w, u.w);
#undef SWG
          av[n] = a;
          if (!PERM) *(unsigned*)((unsigned char*)act + (size_t)row * 512 + 128 * pn + acc_col<PERM>(0, wc, n, fq)) = pack8_fp8(a, a).x;
        }
        if (PERM) *(u32x2*)((unsigned char*)act + (size_t)row * 512 + 128 * pn + acc_col<PERM>(0, wc, 0, fq)) = pack8_fp8(av[0], av[1]);
      }
  }
};

template <bool PERM_> struct EpiRowsFp8M {
  static constexpr bool PERM = PERM_;
  unsigned char* yp; float insc;
  __device__ __forceinline__ void operator()(const f32x4 (&acc)[2][2][4][2], const pg8::Unit& u, int wr, int wc, int fr, int fq) const {
    const int pn = u.pn;
#pragma unroll
    for (int ai = 0; ai < 2; ++ai)
#pragma unroll
      for (int m = 0; m < 4; ++m) {
        const size_t row = (size_t)256 * u.pm + acc_row(ai, wr, m, fr);
        const u32x2 lo = pack8_fp8(acc[ai][0][m][0] * insc, acc[ai][0][m][1] * insc), hi = pack8_fp8(acc[ai][1][m][0] * insc, acc[ai][1][m][1] * insc);
        *(u32x4*)(yp + row * 2048 + 256 * pn + 64 * wc + 16 * fq) = (u32x4){lo.x, lo.y, hi.x, hi.y};
      }
  }
};
template <bool PERM_> struct EpiRowsFp8 {
  static constexpr bool PERM = PERM_;
  unsigned char* yp; float insc;
  __device__ __forceinline__ void operator()(const f32x4 (&acc)[2][2][4][2], const pg8::Unit& u, int wr, int wc, int fr, int fq) const {
    const int pn = u.pn;
#pragma unroll
    for (int ai = 0; ai < 2; ++ai)
#pragma unroll
      for (int m = 0; m < 4; ++m) {
        const size_t row = (size_t)256 * u.pm + acc_row(ai, wr, m, fr);
#pragma unroll
        for (int bj = 0; bj < 2; ++bj) {
          if (PERM) *(u32x2*)(yp + row * 2048 + 256 * pn + acc_col<PERM>(bj, wc, 0, fq)) = pack8_fp8(acc[ai][bj][m][0] * insc, acc[ai][bj][m][1] * insc);
          else {
#pragma unroll
            for (int n = 0; n < 2; ++n) { const f32x4 v = acc[ai][bj][m][n] * insc; const u32x2 o = pack8_fp8(v, v); *(unsigned*)(yp + row * 2048 + 256 * pn + acc_col<PERM>(bj, wc, n, fq)) = o.x; }
          }
        }
      }
  }
};

__device__ __forceinline__ void rot8(u32x4& lo, u32x4& hi, const f32x4 (&cs)[4]) {
  unsigned* l = (unsigned*)&lo; unsigned* h = (unsigned*)&hi;
#pragma unroll
  for (int w = 0; w < 4; ++w) {
    const float ca = cs[w].x, sa = cs[w].y, cb = cs[w].z, sb = cs[w].w;
    const float x1a = bf_lo(l[w]), x1b = bf_hi(l[w]), x2a = bf_lo(h[w]), x2b = bf_hi(h[w]);
    l[w] = pk2(x1a * ca - x2a * sa, x1b * cb - x2b * sb);
    h[w] = pk2(x2a * ca + x1a * sa, x2b * cb + x1b * sb);
  }
}
__device__ __forceinline__ void rotary_rows(const Params& p) {
  const int tid = opaque_tid(), lane = tid & 63, wave = tid >> 6;
  const int gw = blockIdx.x * NWAVES + wave, NGW = gridDim.x * NWAVES;
  unsigned char* ws = p.ws;
  bf16_t* dq = (bf16_t*)(ws + R_DQ); bf16_t* dk = (bf16_t*)(ws + R_DK); bf16_t* kpe = (bf16_t*)(ws + R_KPE);
  const float* rd = (const float*)(ws + WS_ROPED); const float* rm = (const float*)(ws + WS_ROPEM);
  for (int it = gw; it < T / 2; it += NGW) {
    const int row = 2 * it + (lane >> 5), q = lane & 31, comp = q & 15;
    bf16_t* base = ((q >> 4) ? dk : dq) + (size_t)row * 1024 + comp * 64;
    u32x4 lo = *(const u32x4*)base, hi = *(const u32x4*)(base + 8);
    f32x4 cs[4];
#pragma unroll
    for (int w = 0; w < 4; ++w) cs[w] = *(const f32x4*)(rd + (size_t)row * 16 + 4 * w);
    rot8(lo, hi, cs);
    *(u32x4*)base = lo; *(u32x4*)(base + 8) = hi;
  }
  for (int it = gw; it < T / 16; it += NGW) {
    const int row = 16 * it + (lane >> 2), l4 = lane & 3;
    bf16_t* base = kpe + (size_t)row * 64 + 8 * l4;
    u32x4 lo = *(const u32x4*)base, hi = *(const u32x4*)(base + 32);
    f32x4 cs[4];
#pragma unroll
    for (int w = 0; w < 4; ++w) cs[w] = *(const f32x4*)(rm + (size_t)row * 64 + 16 * l4 + 4 * w);
    rot8(lo, hi, cs);
    *(u32x4*)base = lo; *(u32x4*)(base + 32) = hi;
  }
}

__device__ __forceinline__ void attn_mla_naive(const Params& p, int h, int ci, int vq, int lane) {
  unsigned char* ws = p.ws;
  const bf16_t* qm = (const bf16_t*)(ws + R_QM); const bf16_t* kvm = (const bf16_t*)(ws + R_KVM); const bf16_t* kpe = (const bf16_t*)(ws + R_KPE);
  const f32x2* rm = (const f32x2*)(ws + WS_ROPEM);
  const int t = 64 * ci + lane;
  unsigned qn[64], qp[32];
  { const u32x4* q4 = (const u32x4*)(qm + (size_t)t * NQ + 192 * h);
#pragma unroll
    for (int i = 0; i < 16; ++i) { const u32x4 v = q4[i]; qn[4 * i] = v.x; qn[4 * i + 1] = v.y; qn[4 * i + 2] = v.z; qn[4 * i + 3] = v.w; }
#pragma unroll
    for (int i = 0; i < 8; ++i) { const u32x4 v = q4[16 + i]; qp[4 * i] = v.x; qp[4 * i + 1] = v.y; qp[4 * i + 2] = v.z; qp[4 * i + 3] = v.w; }
#pragma unroll
    for (int w = 0; w < 16; ++w) {
      const f32x2 c0 = rm[t * 32 + 2 * w], c1 = rm[t * 32 + 2 * w + 1];
      const float a0 = bf_lo(qp[w]), a1 = bf_hi(qp[w]), b0 = bf_lo(qp[w + 16]), b1 = bf_hi(qp[w + 16]);
      qp[w] = pk2(a0 * c0.x - b0 * c0.y, a1 * c1.x - b1 * c1.y);
      qp[w + 16] = pk2(b0 * c0.x + a0 * c0.y, b1 * c1.x + a1 * c1.y);
    }
  }
  const float scale = 0.07216878364870322f;
  float mx = -INFINITY, l = 0.f, o[32];
#pragma unroll
  for (int j = 0; j < 32; ++j) o[j] = 0.f;
  const int nk = 64 * (ci + 1);
  for (int key = 0; key < nk; ++key) {
    const u32x4* k4 = (const u32x4*)(kvm + (size_t)key * NKV + 256 * h);
    const u32x4* p4 = (const u32x4*)(kpe + (size_t)key * 64);
    float s = 0.f;
#pragma unroll
    for (int i = 0; i < 16; ++i) { const u32x4 v = k4[i]; s = dot2bf(qn[4 * i], v.x, s); s = dot2bf(qn[4 * i + 1], v.y, s); s = dot2bf(qn[4 * i + 2], v.z, s); s = dot2bf(qn[4 * i + 3], v.w, s); }
#pragma unroll
    for (int i = 0; i < 8; ++i) { const u32x4 v = p4[i]; s = dot2bf(qp[4 * i], v.x, s); s = dot2bf(qp[4 * i + 1], v.y, s); s = dot2bf(qp[4 * i + 2], v.z, s); s = dot2bf(qp[4 * i + 3], v.w, s); }
    s *= scale;
    if (s > mx) { const float f = __expf(mx - s); l *= f;
#pragma unroll
      for (int j = 0; j < 32; ++j) o[j] *= f;
      mx = s; }
    const float pe = __expf(s - mx); l += pe;
    const u32x4* v4 = (const u32x4*)(kvm + (size_t)key * NKV + 256 * h + 128 + 32 * vq);
#pragma unroll
    for (int i = 0; i < 4; ++i) { const u32x4 v = v4[i];
      o[8 * i] += pe * bf_lo(v.x); o[8 * i + 1] += pe * bf_hi(v.x); o[8 * i + 2] += pe * bf_lo(v.y); o[8 * i + 3] += pe * bf_hi(v.y);
      o[8 * i + 4] += pe * bf_lo(v.z); o[8 * i + 5] += pe * bf_hi(v.z); o[8 * i + 6] += pe * bf_lo(v.w); o[8 * i + 7] += pe * bf_hi(v.w); }
  }
  const float il = 1.0f / l;
  bf16_t* oa = (bf16_t*)(ws + R_OATT) + (size_t)t * 2048 + 128 * h + 32 * vq;
#pragma unroll
  for (int i = 0; i < 4; ++i) { u32x4 w; w.x = pk2(o[8 * i] * il, o[8 * i + 1] * il); w.y = pk2(o[8 * i + 2] * il, o[8 * i + 3] * il); w.z = pk2(o[8 * i + 4] * il, o[8 * i + 5] * il); w.w = pk2(o[8 * i + 6] * il, o[8 * i + 7] * il);
    ((u32x4*)oa)[i] = w; }
}
__device__ __forceinline__ void attn_diff_naive(const Params& p, int h, int c, int ci, int vh, int lane) {
  unsigned char* ws = p.ws;
  const bf16_t* dq = (const bf16_t*)(ws + R_DQ); const bf16_t* dk = (const bf16_t*)(ws + R_DK); const bf16_t* dv = (const bf16_t*)(ws + R_DV);
  const int t = 64 * ci + lane;
  unsigned q[32];
  { const u32x4* q4 = (const u32x4*)(dq + (size_t)t * 1024 + 128 * h + 64 * c);
#pragma unroll
    for (int i = 0; i < 8; ++i) { const u32x4 v = q4[i]; q[4 * i] = v.x; q[4 * i + 1] = v.y; q[4 * i + 2] = v.z; q[4 * i + 3] = v.w; } }
  const float scale = 0.125f;
  float mx = -INFINITY, l = 0.f, o[64];
#pragma unroll
  for (int j = 0; j < 64; ++j) o[j] = 0.f;
  const int nk = 64 * (ci + 1);
  for (int key = 0; key < nk; ++key) {
    const u32x4* k4 = (const u32x4*)(dk + (size_t)key * 1024 + 128 * h + 64 * c);
    float s = 0.f;
#pragma unroll
    for (int i = 0; i < 8; ++i) { const u32x4 v = k4[i]; s = dot2bf(q[4 * i], v.x, s); s = dot2bf(q[4 * i + 1], v.y, s); s = dot2bf(q[4 * i + 2], v.z, s); s = dot2bf(q[4 * i + 3], v.w, s); }
    s *= scale;
    if (s > mx) { const float f = __expf(mx - s); l *= f;
#pragma unroll
      for (int j = 0; j < 64; ++j) o[j] *= f;
      mx = s; }
    const float pe = __expf(s - mx); l += pe;
    const u32x4* v4 = (const u32x4*)(dv + (size_t)key * 1024 + 128 * h + 64 * vh);
#pragma unroll
    for (int i = 0; i < 8; ++i) { const u32x4 v = v4[i];
      o[8 * i] += pe * bf_lo(v.x); o[8 * i + 1] += pe * bf_hi(v.x); o[8 * i + 2] += pe * bf_lo(v.y); o[8 * i + 3] += pe * bf_hi(v.y);
      o[8 * i + 4] += pe * bf_lo(v.z); o[8 * i + 5] += pe * bf_hi(v.z); o[8 * i + 6] += pe * bf_lo(v.w); o[8 * i + 7] += pe * bf_hi(v.w); }
  }
  const float il = 1.0f / l;
  float* oc = (float*)(ws + R_OC) + (size_t)c * T * 1024 + (size_t)t * 1024 + 128 * h + 64 * vh;
#pragma unroll
  for (int i = 0; i < 16; ++i) ((f32x4*)oc)[i] = (f32x4){o[4 * i] * il, o[4 * i + 1] * il, o[4 * i + 2] * il, o[4 * i + 3] * il};
}
__device__ __forceinline__ void phase3_naive(const Params& p) {
  const int tid = opaque_tid(), lane = tid & 63, wave = tid >> 6;
  const int gw = blockIdx.x * NWAVES + wave, NGW = gridDim.x * NWAVES;
  for (int u = gw; u < 4096; u += NGW) {
    const int uu = (u < 2048) ? u : (6143 - u);
    const int ci = uu & 127, hv = uu >> 7;
    attn_mla_naive(p, hv >> 2, ci, hv & 3, lane);
  }
  for (int u = gw; u < 4096; u += NGW) {
    const int uu = (u < 2048) ? u : (6143 - u);
    const int ci = uu & 127, r = uu >> 7;
    attn_diff_naive(p, r >> 2, (r >> 1) & 1, ci, r & 1, lane);
  }
}
__device__ __forceinline__ void phase3b_naive(const Params& p) {
  const int tid = opaque_tid(), lane = tid & 63, wave = tid >> 6;
  const int gw = blockIdx.x * NWAVES + wave, NGW = gridDim.x * NWAVES;
  unsigned char* ws = p.ws;
  const float lam = ((const float*)(ws + WS_MOD))[16384];
  const float* oc0 = (const float*)(ws + R_OC); const float* oc1 = oc0 + (size_t)T * 1024;
  const float* gsub = p.in[14];
  bf16_t* oa = (bf16_t*)(ws + R_OATT);
  for (int it = gw; it < T * 8; it += NGW) {
    const int t = it >> 3, h = it & 7;
    const size_t off = (size_t)t * 1024 + 128 * h + 2 * lane;
    const f32x2 a = *(const f32x2*)(oc0 + off), b = *(const f32x2*)(oc1 + off);
    const float v0 = a.x - lam * b.x, v1 = a.y - lam * b.y;
    const float rstd = 1.0f / sqrtf(wave_sum(v0 * v0 + v1 * v1) * (1.0f / 128.0f) + EPS);
    const f32x2 g = *(const f32x2*)(gsub + 2 * lane);
    *(unsigned*)(oa + (size_t)t * 2048 + 1024 + 128 * h + 2 * lane) = pk2(v0 * rstd * g.x * 0.8f, v1 * rstd * g.y * 0.8f);
  }
}


namespace fa {
typedef float f32x16 __attribute__((ext_vector_type(16)));
typedef short v4i16_t __attribute__((ext_vector_type(4)));
constexpr int VBYTES = 16384, WSF_OFF = 122880;
constexpr float THR = 8.0f;
__device__ __forceinline__ int crow(int r, int hi) { return (r & 3) + 8 * (r >> 2) + 4 * hi; }
__device__ __forceinline__ unsigned cvtpk(float lo, float hi) { f32x2 v = {lo, hi}; bf16x2_t b = __builtin_convertvector(v, bf16x2_t); return __builtin_bit_cast(unsigned, b); }
__device__ __forceinline__ void glds16(const void* gsrc, unsigned lds_dst) { unsigned keep;
  asm volatile("s_mov_b32 %0, m0\n\ts_mov_b32 m0, %2\n\ts_nop 0\n\tglobal_load_lds_dwordx4 %1, off\n\ts_mov_b32 m0, %0" : "=&s"(keep) : "v"(gsrc), "s"(lds_dst) : "memory"); }
__device__ __forceinline__ float max3f(float a, float b, float c) { float r; asm("v_max3_f32 %0, %1, %2, %3" : "=v"(r) : "v"(a), "v"(b), "v"(c)); return r; }
__device__ __forceinline__ float max2f(float a, float b) { float r; asm("v_max_f32_e32 %0, %1, %2" : "=v"(r) : "v"(a), "v"(b)); return r; }
__device__ __forceinline__ float fadd_s(float a, float b) { float r; asm("v_add_f32_e32 %0, %1, %2" : "=v"(r) : "v"(a), "v"(b)); return r; }
struct Src { const char* kb0; unsigned kp0; const char* kb1; unsigned kp1; const char* vb; unsigned vp; };

template <int NKC  >
__device__ __forceinline__ void attn_pass(LAS unsigned char* lds, const Src& S, const bf16x8* qf, const float qscale, const int NT, const int NTW, f32x16 (&o)[4], float& l_out) {
  constexpr int NKS = NKC * 4, KBYTES = NKC * 8192, STAGE = KBYTES + VBYTES;
  const int tid = opaque_tid(), lane = tid & 63, wid = __builtin_amdgcn_readfirstlane(tid >> 6), r32 = lane & 31, hi = lane >> 5;
  unsigned koff[NKC], voff[2]; unsigned kdst[NKC], vdst[2];
#pragma unroll
  for (int i = 0; i < NKC; ++i) {
    if (NKC == 3 && i == 2) { koff[i] = (unsigned)lane * S.kp1 + (unsigned)wid * 16u; kdst[i] = (unsigned)(16 + wid) * 1024u; }
    else { koff[i] = (unsigned)lane * S.kp0 + (unsigned)(wid + 8 * i) * 16u; kdst[i] = (unsigned)(wid + 8 * i) * 1024u; }
  }
#pragma unroll
  for (int i = 0; i < 2; ++i) { const int ii = 2 * wid + i, b = ii >> 2, kg = ii & 3; voff[i] = (unsigned)(16 * kg + (lane >> 2)) * S.vp + (unsigned)(32 * b + 8 * (lane & 3)) * 2u; vdst[i] = (unsigned)KBYTES + (unsigned)b * 4096u + (unsigned)kg * 1024u; }
#define FA_ISSUE(j, st) do { const size_t _j = (size_t)(j) * 64; const unsigned _so = (unsigned)(st) * STAGE; \
    _Pragma("unroll") for (int _i = 0; _i < NKC; ++_i) { const char* _b = (NKC == 3 && _i == 2) ? S.kb1 + _j * S.kp1 : S.kb0 + _j * S.kp0; \
      __builtin_amdgcn_global_load_lds((const unsigned*)(_b + koff[_i]), (LAS unsigned*)(lds + _so + kdst[_i]), 16, 0, 0); } \
    _Pragma("unroll") for (int _i = 0; _i < 2; ++_i) __builtin_amdgcn_global_load_lds((const unsigned*)(S.vb + _j * S.vp + voff[_i]), (LAS unsigned*)(lds + _so + vdst[_i]), 16, 0, 0); } while (0)
  LAS float* wsf = (LAS float*)(lds + WSF_OFF) + wid * 64;
  float m_ref = -INFINITY, l_part = 0.f;
#pragma unroll
  for (int b = 0; b < 4; ++b)
#pragma unroll
    for (int r = 0; r < 16; ++r) o[b][r] = 0.f;
  const unsigned kread = (unsigned)hi * 1024u + (unsigned)r32 * 16u;
  const unsigned vread = (unsigned)KBYTES + (unsigned)(((lane >> 4) & 1) * 32 + (lane & 3) * 8 + (4 * hi + ((lane & 15) >> 2)) * 64);
  FA_ISSUE(0, 0);
  if (NT > 1) FA_ISSUE(1, 1);
  int st = 0;
  for (int j = 0; j < NT; ++j) {
    if (j + 1 < NT) { if (NKC == 3) asm volatile("s_waitcnt vmcnt(5)" ::: "memory"); else asm volatile("s_waitcnt vmcnt(3)" ::: "memory"); }
    else asm volatile("s_waitcnt vmcnt(0)" ::: "memory");
    asm volatile("s_waitcnt lgkmcnt(0)\n\ts_barrier" ::: "memory");
    if (j + 2 < NT) { const int st2 = (st + 2 >= 3) ? st - 1 : st + 2; FA_ISSUE(j + 2, st2); }
    if (j < NTW) {
      const LAS unsigned char* kb = lds + (unsigned)st * STAGE + kread;
      f32x16 p0, p1;
#pragma unroll
      for (int r = 0; r < 16; ++r) { p0[r] = 0.f; p1[r] = 0.f; }
#pragma unroll
      for (int d0 = 0; d0 < NKS; ++d0) {
        const bf16x8 k0 = *(const LAS bf16x8*)(kb + d0 * 2048);
        const bf16x8 k1 = *(const LAS bf16x8*)(kb + d0 * 2048 + 512);
        p0 = __builtin_amdgcn_mfma_f32_32x32x16_bf16(k0, qf[d0], p0, 0, 0, 0);
        p1 = __builtin_amdgcn_mfma_f32_32x32x16_bf16(k1, qf[d0], p1, 0, 0, 0);
      }
      float rm = __builtin_fmaxf(p0[0], p1[0]);
#pragma unroll
      for (int r = 1; r < 16; ++r) rm = __builtin_fmaxf(rm, __builtin_fmaxf(p0[r], p1[r]));
      { auto rr = __builtin_amdgcn_permlane32_swap(__float_as_uint(rm), __float_as_uint(rm), false, false); rm = __builtin_fmaxf(__uint_as_float(rr[0]), __uint_as_float(rr[1])); }
      rm *= qscale;
      if (__any(rm > m_ref + THR)) {
        const float m_new = __builtin_fmaxf(m_ref, rm);
        const float alpha = __builtin_amdgcn_exp2f(m_ref - m_new);
        l_part *= alpha; m_ref = m_new;
        if (hi == 0) wsf[r32] = alpha;
        asm volatile("s_waitcnt lgkmcnt(0)" ::: "memory");
#pragma unroll
        for (int r = 0; r < 16; ++r) { const float a = wsf[crow(r, hi)];
#pragma unroll
          for (int b = 0; b < 4; ++b) o[b][r] *= a; }
      }
      float ls = 0.f;
#pragma unroll
      for (int r = 0; r < 16; ++r) { p0[r] = __builtin_amdgcn_exp2f(p0[r] * qscale - m_ref); p1[r] = __builtin_amdgcn_exp2f(p1[r] * qscale - m_ref); ls += p0[r] + p1[r]; }
      l_part += ls;
      u32x4 pw[4];
      pw[0] = (u32x4){cvtpk(p0[0], p0[1]), cvtpk(p0[2], p0[3]), cvtpk(p0[4], p0[5]), cvtpk(p0[6], p0[7])};
      pw[1] = (u32x4){cvtpk(p0[8], p0[9]), cvtpk(p0[10], p0[11]), cvtpk(p0[12], p0[13]), cvtpk(p0[14], p0[15])};
      pw[2] = (u32x4){cvtpk(p1[0], p1[1]), cvtpk(p1[2], p1[3]), cvtpk(p1[4], p1[5]), cvtpk(p1[6], p1[7])};
      pw[3] = (u32x4){cvtpk(p1[8], p1[9]), cvtpk(p1[10], p1[11]), cvtpk(p1[12], p1[13]), cvtpk(p1[14], p1[15])};
      const LAS unsigned char* vbp = lds + (unsigned)st * STAGE + vread;
#pragma unroll
      for (int ks = 0; ks < 4; ++ks)
#pragma unroll
        for (int b = 0; b < 4; ++b) {
          const v4i16_t lo = __builtin_amdgcn_ds_read_tr16_b64_v4i16((LAS v4i16_t*)(vbp + b * 4096 + ks * 1024));
          const v4i16_t hh = __builtin_amdgcn_ds_read_tr16_b64_v4i16((LAS v4i16_t*)(vbp + b * 4096 + ks * 1024 + 512));
          const bf16x8 vf = (bf16x8){lo[0], lo[1], lo[2], lo[3], hh[0], hh[1], hh[2], hh[3]};
          o[b] = __builtin_amdgcn_mfma_f32_32x32x16_bf16(__builtin_bit_cast(bf16x8, pw[ks]), vf, o[b], 0, 0, 0);
        }
    }
    st = (st == 2) ? 0 : st + 1;
  }
  asm volatile("s_waitcnt lgkmcnt(0)\n\ts_barrier" ::: "memory");
  { auto rr = __builtin_amdgcn_permlane32_swap(__float_as_uint(l_part), __float_as_uint(l_part), false, false); l_out = __uint_as_float(rr[0]) + __uint_as_float(rr[1]); }
#undef FA_ISSUE
}


template <int NKC>
__device__ __forceinline__ void attn_pass3(LAS unsigned char* lds, const Src& S, const bf16x8* qf, const float qscale, const int NT, const int NTW, f32x16 (&o)[4], float& l_out) {
  constexpr int NKS = NKC * 4, KBYTES = NKC * 8192, STAGE = KBYTES + VBYTES;
  const int tid = opaque_tid(), lane = tid & 63, wid = __builtin_amdgcn_readfirstlane(tid >> 6), r32 = lane & 31, hi = lane >> 5;
  unsigned koff[NKC], voff[2]; unsigned kdst[NKC], vdst[2];
#pragma unroll
  for (int i = 0; i < NKC; ++i) {
    if (NKC == 3 && i < 2) { const int pi = wid + 8 * i, row = 4 * pi + (lane >> 4); koff[i] = (unsigned)row * S.kp0 + (unsigned)(((lane & 15) ^ (row & 15)) * 16); kdst[i] = (unsigned)pi * 1024u; }
    else { const int row = 8 * wid + (lane >> 3); const unsigned kp = (NKC == 3) ? S.kp1 : S.kp0; koff[i] = (unsigned)row * kp + (unsigned)(((lane & 7) ^ ((row >> 1) & 7)) * 16); kdst[i] = (NKC == 3 ? 16384u : 0u) + (unsigned)wid * 1024u; }
  }
#pragma unroll
  for (int i = 0; i < 2; ++i) { const int ii = 2 * wid + i, b = ii >> 2, kg = ii & 3; voff[i] = (unsigned)(16 * kg + (lane >> 2)) * S.vp + (unsigned)(32 * b + 8 * (lane & 3)) * 2u; vdst[i] = (unsigned)KBYTES + (unsigned)b * 4096u + (unsigned)kg * 1024u; }
#define FA_ISSUE(j, st) do { const size_t _j = (size_t)(j) * 64; const unsigned _so = lds0 + (unsigned)(st) * STAGE; \
    _Pragma("unroll") for (int _i = 0; _i < NKC; ++_i) { const char* _b = (NKC == 3 && _i == 2) ? S.kb1 + _j * S.kp1 : S.kb0 + _j * S.kp0; \
      glds16(_b + koff[_i], (unsigned)__builtin_amdgcn_readfirstlane(_so + kdst[_i])); } \
    _Pragma("unroll") for (int _i = 0; _i < 2; ++_i) glds16(S.vb + _j * S.vp + voff[_i], (unsigned)__builtin_amdgcn_readfirstlane(_so + vdst[_i])); } while (0)
#define FA_EXP8(P, base, PW) do { float _e[8]; _Pragma("unroll") for (int _i = 0; _i < 8; ++_i) { _e[_i] = __builtin_amdgcn_exp2f(P[(base) + _i]); } \
      l_part = fadd_s(l_part, fadd_s(fadd_s(fadd_s(_e[0], _e[1]), fadd_s(_e[2], _e[3])), fadd_s(fadd_s(_e[4], _e[5]), fadd_s(_e[6], _e[7])))); \
      PW = (u32x4){cvtpk(_e[0], _e[1]), cvtpk(_e[2], _e[3]), cvtpk(_e[4], _e[5]), cvtpk(_e[6], _e[7])}; } while (0)
#define FA_VRD1(L, H, va, off) asm volatile("ds_read_b64_tr_b16 %0, %2 offset:%c3\n\tds_read_b64_tr_b16 %1, %2 offset:%c4" : "=&v"(L), "=&v"(H) : "v"(va), "i"(off), "i"((off) + 512) : "memory")
#define FA_VRD8(VL, VH, va, ks0) do { _Pragma("unroll") for (int _b = 0; _b < 4; ++_b) { FA_VRD1(VL[_b], VH[_b], va, _b * 4096 + (ks0) * 1024); } \
      _Pragma("unroll") for (int _b = 0; _b < 4; ++_b) { FA_VRD1(VL[4 + _b], VH[4 + _b], va, _b * 4096 + ((ks0) + 1) * 1024); } } while (0)
#define FA_FRAG(VL, VH, i) (bf16x8){VL[i][0], VL[i][1], VL[i][2], VL[i][3], VH[i][0], VH[i][1], VH[i][2], VH[i][3]}
#define FA_PV8(PWA, PWB, VL, VH) do { _Pragma("unroll") for (int _b = 0; _b < 4; ++_b) o[_b] = __builtin_amdgcn_mfma_f32_32x32x16_bf16(__builtin_bit_cast(bf16x8, PWA), FA_FRAG(VL, VH, _b), o[_b], 0, 0, 0); \
      _Pragma("unroll") for (int _b = 0; _b < 4; ++_b) o[_b] = __builtin_amdgcn_mfma_f32_32x32x16_bf16(__builtin_bit_cast(bf16x8, PWB), FA_FRAG(VL, VH, 4 + _b), o[_b], 0, 0, 0); } while (0)
#define FA_PV(PW, vbp, ks) do { _Pragma("unroll") for (int _b = 0; _b < 4; ++_b) { \
      const v4i16_t lo = __builtin_amdgcn_ds_read_tr16_b64_v4i16((LAS v4i16_t*)((vbp) + _b * 4096 + (ks) * 1024)); \
      const v4i16_t hh = __builtin_amdgcn_ds_read_tr16_b64_v4i16((LAS v4i16_t*)((vbp) + _b * 4096 + (ks) * 1024 + 512)); \
      const bf16x8 vf = (bf16x8){lo[0], lo[1], lo[2], lo[3], hh[0], hh[1], hh[2], hh[3]}; \
      o[_b] = __builtin_amdgcn_mfma_f32_32x32x16_bf16(__builtin_bit_cast(bf16x8, PW), vf, o[_b], 0, 0, 0); } } while (0)
  const unsigned lds0 = (unsigned)(uintptr_t)lds;
  LAS float* wsf = (LAS float*)(lds + WSF_OFF) + wid * 64;
  float m_ref = 0.f, l_part = 0.f;
  f32x16 negm;
#pragma unroll
  for (int r = 0; r < 16; ++r) negm[r] = 0.f;
#pragma unroll
  for (int b = 0; b < 4; ++b)
#pragma unroll
    for (int r = 0; r < 16; ++r) o[b][r] = 0.f;
  const unsigned kread_n = (unsigned)r32 * 256u + (unsigned)(((r32 & 15) ^ hi) * 16);
  const unsigned kread_p = (NKC == 3 ? 16384u : 0u) + (unsigned)r32 * 128u + (unsigned)((((r32 >> 1) & 7) ^ hi) * 16);
  const unsigned vread = (unsigned)KBYTES + (unsigned)(((lane >> 4) & 1) * 32 + (lane & 3) * 8 + (4 * hi + ((lane & 15) >> 2)) * 64);
  constexpr int NST = (NKC == 1) ? 4 : 3;
  FA_ISSUE(0, 0);
  if (NT > 1) FA_ISSUE(1, 1);
  if (NST == 4 && NT > 2) FA_ISSUE(2, 2);
  int st = 0;
  for (int j = 0; j < NT; ++j) {
    if (NST == 4) { if (j + 2 < NT) asm volatile("s_waitcnt vmcnt(6)" ::: "memory"); else if (j + 1 < NT) asm volatile("s_waitcnt vmcnt(3)" ::: "memory"); else asm volatile("s_waitcnt vmcnt(0)" ::: "memory"); }
    else { if (j + 1 < NT) asm volatile("s_waitcnt vmcnt(5)" ::: "memory"); else asm volatile("s_waitcnt vmcnt(0)" ::: "memory"); }
    asm volatile("s_waitcnt lgkmcnt(0)\n\ts_barrier" ::: "memory");
    if (j + NST - 1 < NT) { const int st2 = (st == 0) ? NST - 1 : st - 1; FA_ISSUE(j + NST - 1, st2); }
    if (j < NTW) {
      const unsigned ksb = (unsigned)st * STAGE;
      f32x16 p0, p1;
#pragma unroll
      for (int d0 = 0; d0 < NKS; ++d0) {
        const bool nope = (NKC == 3) && d0 < 8;
        const unsigned ka = ksb + (nope ? (kread_n ^ (unsigned)(d0 * 32)) : (kread_p ^ (unsigned)((NKC == 3 ? d0 - 8 : d0) * 32)));
        const bf16x8 k0 = *(const LAS bf16x8*)(lds + ka);
        const bf16x8 k1 = *(const LAS bf16x8*)(lds + ka + (nope ? 8192u : 4096u));
        if (d0 == 0) { p0 = __builtin_amdgcn_mfma_f32_32x32x16_bf16(k0, qf[d0], negm, 0, 0, 0); p1 = __builtin_amdgcn_mfma_f32_32x32x16_bf16(k1, qf[d0], negm, 0, 0, 0); }
        else { p0 = __builtin_amdgcn_mfma_f32_32x32x16_bf16(k0, qf[d0], p0, 0, 0, 0); p1 = __builtin_amdgcn_mfma_f32_32x32x16_bf16(k1, qf[d0], p1, 0, 0, 0); }
      }
      __builtin_amdgcn_sched_group_barrier(0x100, 4, 0);
#pragma unroll
      for (int d0 = 0; d0 < NKS - 2; ++d0) { __builtin_amdgcn_sched_group_barrier(0x008, 2, 0); __builtin_amdgcn_sched_group_barrier(0x100, 2, 0); }
      __builtin_amdgcn_sched_group_barrier(0x008, 4, 0);
      __builtin_amdgcn_sched_barrier(0);
      asm volatile("s_nop 15\n\ts_nop 7" : "+v"(p0), "+v"(p1));
      float rm;
      { float a = max3f(p0[0], p0[1], p1[0]), b = max3f(p0[2], p0[3], p1[1]); a = max3f(a, p1[2], p1[3]);
#pragma unroll
        for (int r = 4; r < 16; r += 4) { a = max3f(a, p0[r], p0[r + 1]); b = max3f(b, p0[r + 2], p0[r + 3]); a = max3f(a, p1[r], p1[r + 1]); b = max3f(b, p1[r + 2], p1[r + 3]); }
        rm = max2f(a, b);
        auto rr = __builtin_amdgcn_permlane32_swap(__float_as_uint(rm), __float_as_uint(rm), false, false); rm = max2f(__uint_as_float(rr[0]), __uint_as_float(rr[1])); }
      if (__builtin_expect(j == 0 || __any(rm > THR), 0)) {
        const float dl = (j == 0) ? rm : __builtin_fmaxf(rm, 0.f);
        m_ref += dl;
#pragma unroll
        for (int r = 0; r < 16; ++r) { p0[r] -= dl; p1[r] -= dl; negm[r] = -m_ref; }
        const float alpha = __builtin_amdgcn_exp2f(-dl);
        l_part *= alpha;
        if (hi == 0) wsf[r32] = alpha;
        asm volatile("s_waitcnt lgkmcnt(0)" ::: "memory");
#pragma unroll
        for (int r = 0; r < 16; ++r) { const float a = wsf[crow(r, hi)];
#pragma unroll
          for (int b = 0; b < 4; ++b) o[b][r] *= a; }
      }
      const unsigned vaddr = lds0 + (unsigned)st * STAGE + vread;
      u32x4 pw0, pw1, pw2, pw3;
      if constexpr (NKC == 1) {
        v4i16_t vl[8], vh[8], wl[8], wh[8];
        FA_VRD8(vl, vh, vaddr, 0);
        FA_EXP8(p0, 0, pw0); FA_EXP8(p0, 8, pw1);
        asm volatile("s_waitcnt lgkmcnt(0)" ::: "memory"); __builtin_amdgcn_sched_barrier(0);
        FA_VRD8(wl, wh, vaddr, 2);
        __builtin_amdgcn_sched_barrier(0);
        FA_PV8(pw0, pw1, vl, vh);
        FA_EXP8(p1, 0, pw2); FA_EXP8(p1, 8, pw3);
#pragma unroll
        for (int q = 0; q < 8; ++q) { __builtin_amdgcn_sched_group_barrier(0x008, 1, 4); __builtin_amdgcn_sched_group_barrier(0x402, 6, 4); }
        asm volatile("s_waitcnt lgkmcnt(0)" ::: "memory"); __builtin_amdgcn_sched_barrier(0);
        FA_PV8(pw2, pw3, wl, wh);
        __builtin_amdgcn_sched_barrier(0);
      } else
      { v4i16_t vl[8], vh[8];
        FA_VRD8(vl, vh, vaddr, 0);
        FA_EXP8(p0, 0, pw0); FA_EXP8(p0, 8, pw1);
        asm volatile("s_waitcnt lgkmcnt(0)" ::: "memory"); __builtin_amdgcn_sched_barrier(0);
        FA_PV8(pw0, pw1, vl, vh);
        __builtin_amdgcn_sched_barrier(0);
        FA_VRD8(vl, vh, vaddr, 2);
        FA_EXP8(p1, 0, pw2); FA_EXP8(p1, 8, pw3);
        asm volatile("s_waitcnt lgkmcnt(0)" ::: "memory"); __builtin_amdgcn_sched_barrier(0);
        FA_PV8(pw2, pw3, vl, vh);
        __builtin_amdgcn_sched_barrier(0);
      }
    }
    st = (st == NST - 1) ? 0 : st + 1;
  }
  asm volatile("s_waitcnt lgkmcnt(0)\n\ts_barrier" ::: "memory");
  { auto rr = __builtin_amdgcn_permlane32_swap(__float_as_uint(l_part), __float_as_uint(l_part), false, false); l_out = __uint_as_float(rr[0]) + __uint_as_float(rr[1]); }
#undef FA_ISSUE
#undef FA_EXP8
#undef FA_PV
#undef FA_VRD1
#undef FA_VRD8
#undef FA_FRAG
#undef FA_PV8
}

__device__ __forceinline__ void row_bcast(LAS float* wsf, float v, int r32, int hi, float (&out)[16]) {
  asm volatile("s_waitcnt lgkmcnt(0)" ::: "memory");
  if (hi == 0) wsf[r32] = v;
  asm volatile("s_waitcnt lgkmcnt(0)" ::: "memory");
#pragma unroll
  for (int r = 0; r < 16; ++r) out[r] = wsf[crow(r, hi)];
  asm volatile("s_waitcnt lgkmcnt(0)" ::: "memory");
}

__device__ __forceinline__ void mla_unit(const Params& p, LAS unsigned char* lds, int h, int qb) {
  unsigned char* ws = p.ws;
  const int tid = opaque_tid(), lane = tid & 63, wid = __builtin_amdgcn_readfirstlane(tid >> 6), r32 = lane & 31, hi = lane >> 5;
  const int t = 256 * qb + 32 * wid + r32;
  bf16x8 qf[12];
  { const bf16_t* q = (const bf16_t*)(ws + R_QM) + (size_t)t * NQ + 192 * h + 8 * hi;
#pragma unroll
    for (int d0 = 0; d0 < 12; ++d0) qf[d0] = *(const bf16x8*)(q + 16 * d0);
    const f32x2* rm = (const f32x2*)(ws + WS_ROPEM) + (size_t)t * 32;
#pragma unroll
    for (int s = 8; s < 10; ++s) {
      bf16x8 a = qf[s], b = qf[s + 2];
#pragma unroll
      for (int j = 0; j < 8; ++j) { const f32x2 cs = rm[16 * (s - 8) + 8 * hi + j];
        const float x1 = bf1((bf16_t)a[j]), x2 = bf1((bf16_t)b[j]);
        a[j] = (short)f2bf(x1 * cs.x - x2 * cs.y); b[j] = (short)f2bf(x2 * cs.x + x1 * cs.y); }
      qf[s] = a; qf[s + 2] = b;
    }
  }
  asm volatile("s_waitcnt vmcnt(0)" ::: "memory");
#pragma unroll
  for (int d0 = 0; d0 < 12; ++d0) asm volatile("" : "+v"(qf[d0]));
  Src S; S.kb0 = (const char*)(ws + R_KVM) + 256 * h * 2; S.kp0 = NKV * 2; S.kb1 = (const char*)(ws + R_KPE); S.kp1 = 128; S.vb = (const char*)(ws + R_KVM) + (256 * h + 128) * 2; S.vp = NKV * 2;
  f32x16 o[4]; float l;
  attn_pass3<3>(lds, S, qf, 1.0f, 4 * qb + 4, 4 * qb + 1 + (wid >> 1), o, l);
  LAS float* wsf = (LAS float*)(lds + WSF_OFF) + wid * 64;
  float il[16]; row_bcast(wsf, 1.0f / l, r32, hi, il);
  char* ob = (char*)((bf16_t*)(ws + R_OATT) + (size_t)(256 * qb + 32 * wid) * 2048 + 128 * h);
  const unsigned lo = (unsigned)(4 * hi * 2048 + r32) * 2u;
#pragma unroll
  for (int r = 0; r < 16; ++r)
#pragma unroll
    for (int b = 0; b < 4; ++b) *(bf16_t*)(ob + lo + (unsigned)((((r & 3) + 8 * (r >> 2)) * 2048 + 32 * b) * 2)) = (bf16_t)f2bf(o[b][r] * il[r]);
}

template <int C>
__device__ __forceinline__ void diff_comp(const Params& p, LAS unsigned char* lds, int h, int qb, f32x16 (&oacc)[4]) {
  unsigned char* ws = p.ws;
  const int tid = opaque_tid(), lane = tid & 63, wid = __builtin_amdgcn_readfirstlane(tid >> 6), r32 = lane & 31, hi = lane >> 5;
  const int t = 256 * qb + 32 * wid + r32;
  LAS float* wsf = (LAS float*)(lds + WSF_OFF) + wid * 64;
  bf16x8 qf[4];
  { const bf16_t* q = (const bf16_t*)(ws + R_DQ) + (size_t)t * 1024 + 128 * h + 64 * C + 8 * hi;
#pragma unroll
    for (int d0 = 0; d0 < 4; ++d0) qf[d0] = *(const bf16x8*)(q + 16 * d0); }
  asm volatile("s_waitcnt vmcnt(0)" ::: "memory");
#pragma unroll
  for (int d0 = 0; d0 < 4; ++d0) asm volatile("" : "+v"(qf[d0]));
  Src S; S.kb0 = (const char*)(ws + R_DK) + (128 * h + 64 * C) * 2; S.kp0 = 2048; S.kb1 = S.kb0; S.kp1 = 2048; S.vb = (const char*)(ws + R_DV) + 128 * h * 2; S.vp = 2048;
  f32x16 o[4]; float l;
  attn_pass3<1>(lds, S, qf, 1.0f, 4 * qb + 4, 4 * qb + 1 + (wid >> 1), o, l);
  const float lam = ((const float*)(ws + WS_MOD))[16384];
  float il[16]; row_bcast(wsf, (C == 0 ? 1.0f : -lam) / l, r32, hi, il);
  const char* park = (const char*)((float*)(ws + R_OC) + (size_t)(((h * 32 + qb) * 8 + wid)) * 4096);
  const unsigned pl = (unsigned)(opaque_tid() & 63) * 4u;
  if (C == 0) {
#pragma unroll
    for (int b = 0; b < 4; ++b) { const char* pb = park + b * 4096;
#pragma unroll
      for (int r = 0; r < 16; ++r) *(float*)(const_cast<char*>(pb) + pl + (unsigned)(r * 256)) = o[b][r] * il[r]; }
  } else {
#pragma unroll
    for (int b = 0; b < 4; ++b) { const char* pb = park + b * 4096;
#pragma unroll
      for (int r = 0; r < 16; ++r) oacc[b][r] = *(const float*)(pb + pl + (unsigned)(r * 256)) + o[b][r] * il[r]; }
  }
}

__device__ __forceinline__ void diff_unit(const Params& p, LAS unsigned char* lds, int h, int qb) {
  unsigned char* ws = p.ws;
  f32x16 oacc[4];
  diff_comp<0>(p, lds, h, qb, oacc);
  diff_comp<1>(p, lds, h, qb, oacc);
  const int tid = opaque_tid(), lane = tid & 63, wid = __builtin_amdgcn_readfirstlane(tid >> 6), r32 = lane & 31, hi = lane >> 5;
  const float* gsub = p.in[14];
  float g4[4];
#pragma unroll
  for (int b = 0; b < 4; ++b) g4[b] = gsub[32 * b + r32] * 0.8f;
  char* ob = (char*)((bf16_t*)(ws + R_OATT) + (size_t)(256 * qb + 32 * wid) * 2048 + 1024 + 128 * h);
  const unsigned lo = (unsigned)(4 * hi * 2048 + r32) * 2u;
#pragma unroll
  for (int r = 0; r < 16; ++r) {
    float ss = 0.f;
#pragma unroll
    for (int b = 0; b < 4; ++b) ss += oacc[b][r] * oacc[b][r];
    ss += __shfl_xor(ss, 1); ss += __shfl_xor(ss, 2); ss += __shfl_xor(ss, 4); ss += __shfl_xor(ss, 8); ss += __shfl_xor(ss, 16);
    const float rstd = 1.0f / sqrtf(ss * (1.0f / 128.0f) + EPS);
#pragma unroll
    for (int b = 0; b < 4; ++b) *(bf16_t*)(ob + lo + (unsigned)((((r & 3) + 8 * (r >> 2)) * 2048 + 32 * b) * 2)) = (bf16_t)f2bf(oacc[b][r] * rstd * g4[b]);
  }
}

struct AUnit { unsigned char kind, qb; };
struct AList { AUnit u[64]; };
constexpr AList make_alist() {
  AList L{}; int cost[64] = {}; int n = 0;
  for (int qb = 0; qb < 32; ++qb) { L.u[n].kind = 0; L.u[n].qb = (unsigned char)qb; cost[n] = 100 * (qb + 1); ++n; }
  for (int qb = 0; qb < 32; ++qb) { L.u[n].kind = 1; L.u[n].qb = (unsigned char)qb; cost[n] = 165 * (qb + 1); ++n; }
  for (int i = 1; i < 64; ++i) { const AUnit x = L.u[i]; const int c = cost[i]; int j = i - 1; while (j >= 0 && cost[j] < c) { L.u[j + 1] = L.u[j]; cost[j + 1] = cost[j]; --j; } L.u[j + 1] = x; cost[j + 1] = c; }
  return L;
}
__constant__ AList g_alist = make_alist();
constexpr int CW_AQ = 1024, CW_ROLE = 1280, CW_CQ = 1536;
constexpr int LDS_AQW = 147408;
constexpr unsigned N_CONVERTERS_PER_XCD = 7;

__device__ __forceinline__ int wg_pull(unsigned* head, unsigned limit, volatile LAS int* bw) {
  if (threadIdx.x == 0) {
    int idx = (int)limit;
    if (__hip_atomic_load(head, __ATOMIC_RELAXED, __HIP_MEMORY_SCOPE_AGENT) < limit) idx = (int)__hip_atomic_fetch_add(head, 1u, __ATOMIC_RELAXED, __HIP_MEMORY_SCOPE_AGENT);
    bw[0] = idx;
  }
  __syncthreads();
  const int idx = __builtin_amdgcn_readfirstlane(bw[0]);
  __syncthreads();
  return idx;
}
__device__ __forceinline__ int wg_bcast(int v, volatile LAS int* bw) {
  if (threadIdx.x == 0) bw[0] = v;
  __syncthreads();
  const int r = __builtin_amdgcn_readfirstlane(bw[0]);
  __syncthreads();
  return r;
}
__device__ __forceinline__ int q_take(unsigned* head) { const unsigned t = __hip_atomic_fetch_add(head, 1u, __ATOMIC_RELAXED, __HIP_MEMORY_SCOPE_AGENT); return (int)(t < 0xffffu ? t : 0xffffu); }
__device__ __forceinline__ void attn_queue_loop(const Params& p, LAS unsigned char* lds, unsigned* ctl, volatile LAS int* bw, unsigned x0) {
  const bool t0 = threadIdx.x == 0;
  unsigned g = x0 & 7u; int nxt = 0; bool have = false;
  for (;;) {
    if (t0 && !have) nxt = q_take(ctl + CW_AQ + 16u * g);
    have = false;
    const int idx = wg_bcast(nxt, bw);
    if (idx >= 64) {
      int pick = -1;
      if (t0) {
        unsigned hv[8];
#pragma unroll
        for (unsigned k = 1; k < 8u; ++k) hv[k] = __hip_atomic_load(ctl + CW_AQ + 16u * ((x0 + k) & 7u), __ATOMIC_RELAXED, __HIP_MEMORY_SCOPE_AGENT);
#pragma unroll
        for (unsigned k = 1; k < 8u; ++k) if (pick < 0 && hv[k] < 64u) pick = (int)((x0 + k) & 7u);
        if (pick >= 0) { nxt = q_take(ctl + CW_AQ + 16u * (unsigned)pick); have = true; }
      }
      const int pk = wg_bcast(pick, bw);
      if (pk < 0) break;
      g = (unsigned)pk;
      continue;
    }
    const AUnit u = g_alist.u[idx];
    const int kind = __builtin_amdgcn_readfirstlane((int)u.kind), qb = __builtin_amdgcn_readfirstlane((int)u.qb);
    if (kind == 0) mla_unit(p, lds, (int)g, qb); else diff_unit(p, lds, (int)g, qb);
  }
}
__device__ __forceinline__ void conv_queue_loop(const Params& p, char* lds_generic, unsigned* ctl, volatile LAS int* bw) {
  const bool t0 = threadIdx.x == 0;
  int nxt = 0;
  if (t0) nxt = q_take(ctl + CW_CQ);
  for (;;) {
    const int c = wg_bcast(nxt, bw);
    if (c >= N_CONV_CHUNKS) break;
    if (t0) nxt = q_take(ctl + CW_CQ);
    conv_chunk(p, lds_generic, c);
    __syncthreads();
  }
}

__device__ __forceinline__ void phase3_fast(const Params& p, LAS unsigned char* lds, char* lds_generic) {
  unsigned* ctl = (unsigned*)(p.ws + WS_CTL);
  volatile LAS int* bw = (volatile LAS int*)(lds + LDS_AQW);
  const unsigned x0 = (unsigned)__builtin_amdgcn_s_getreg((3 << 11) | 20) & 7u;
  const int ticket = wg_pull(ctl + CW_ROLE + 16u * x0, 0xffffffffu, bw);
  if ((unsigned)ticket < N_CONVERTERS_PER_XCD) { conv_queue_loop(p, lds_generic, ctl, bw); attn_queue_loop(p, lds, ctl, bw, x0); }
  else { attn_queue_loop(p, lds, ctl, bw, x0); conv_queue_loop(p, lds_generic, ctl, bw); }
}
}

constexpr int P5_STRIDE = 2052;
__device__ __forceinline__ void phase5(const Params& p, char* lds) {
  const int tid = opaque_tid(), lane = tid & 63, wave = tid >> 6;
  unsigned char* ws = p.ws;
  float* tile = (float*)lds;
  float* part = (float*)lds;
  int* lcnt = (int*)(lds + 135168);
  int* lbase = lcnt + 64;
  int* nent = lcnt + 128;
  int* ent = lcnt + 192;
  const float* mod = (const float*)(ws + WS_MOD);
  const float* x = p.in[0]; const bf16_t* y = (const bf16_t*)(ws + R_Y);
  const float* g_post = p.in[16]; const float* g_pre = p.in[17];
  const float* wr_ = p.in[18]; const float* br_ = p.in[19];
  unsigned char* h2 = (unsigned char*)(ws + WS_H2);
  float* topw = (float*)(ws + WS_TOPW);
  if (tid < 64) lcnt[tid] = 0;
  if (tid == 64) nent[0] = 0;
  __syncthreads();
  const u32x4* wrh = (const u32x4*)(ws + WS_WRT); const u32x4* wrl = (const u32x4*)(ws + WS_WRT + 256 * 1024);
#define P5_LOADB(ks, H, L) do { _Pragma("unroll") for (int _jt = 0; _jt < 4; ++_jt) { H[_jt] = wrh[((8 * wave + (ks)) * 4 + _jt) * 64 + lqb]; L[_jt] = wrl[((8 * wave + (ks)) * 4 + _jt) * 64 + lqb]; } } while (0)
  for (int ti = blockIdx.x; ti < T / 16; ti += gridDim.x) {
    const int row0 = 16 * ti;
    u32x4 bH0[4], bL0[4], bH1[4], bL1[4], bH2[4], bL2[4], bH3[4], bL3[4];
    int lqb = lane; asm volatile("" : "+v"(lqb));
    {
      int lq = lane; asm volatile("" : "+v"(lq));
      const int lr0 = 2 * wave, rowa = row0 + lr0;
      u32x2 yy[2][8]; f32x4 xv[2][8];
#pragma unroll
      for (int rr = 0; rr < 2; ++rr)
#pragma unroll
        for (int j = 0; j < 8; ++j) yy[rr][j] = *(const u32x2*)(y + (size_t)(rowa + rr) * D + 256 * j + 4 * lq);
#pragma unroll
      for (int rr = 0; rr < 2; ++rr)
#pragma unroll
        for (int j = 0; j < 8; ++j) xv[rr][j] = *(const f32x4*)(x + (size_t)(rowa + rr) * D + 256 * j + 4 * lq);
      float ss[2] = {0.f, 0.f};
#pragma unroll
      for (int rr = 0; rr < 2; ++rr)
#pragma unroll
        for (int j = 0; j < 8; ++j) { const u32x2 q = yy[rr][j]; const float a = bf_lo(q.x), b = bf_hi(q.x), c = bf_lo(q.y), d = bf_hi(q.y); ss[rr] += a * a + b * b + c * c + d * d; }
      float rstdy[2], s1[2] = {0.f, 0.f};
#pragma unroll
      for (int rr = 0; rr < 2; ++rr) rstdy[rr] = 1.0f / sqrtf(wave_sum(ss[rr]) * (1.0f / D) + EPS);
#pragma unroll
      for (int j = 0; j < 8; ++j) {
        const int c0 = 256 * j + 4 * lq;
        const f32x4 gp = *(const f32x4*)(g_post + c0), ga = *(const f32x4*)(mod + 4096 + c0);
#pragma unroll
        for (int rr = 0; rr < 2; ++rr) {
          const u32x2 q = yy[rr][j]; const f32x4 yv = (f32x4){bf_lo(q.x), bf_hi(q.x), bf_lo(q.y), bf_hi(q.y)};
          const f32x4 x1 = xv[rr][j] + ga * ((yv * rstdy[rr]) * gp);
          { u32x2 xb; xb.x = pk2(x1.x, x1.y); xb.y = pk2(x1.z, x1.w); *(u32x2*)((bf16_t*)(ws + R_X1) + (size_t)(rowa + rr) * D + c0) = xb; }
          xv[rr][j] = x1; s1[rr] += x1.x * x1.x + x1.y * x1.y + x1.z * x1.z + x1.w * x1.w;
        }
      }
      float rstd1[2];
#pragma unroll
      for (int rr = 0; rr < 2; ++rr) rstd1[rr] = 1.0f / sqrtf(wave_sum(s1[rr]) * (1.0f / D) + EPS);
#pragma unroll
      for (int j = 0; j < 8; ++j) {
        const int c0 = 256 * j + 4 * lq;
        const f32x4 gf = *(const f32x4*)(g_pre + c0), sh = *(const f32x4*)(mod + 6144 + c0), sc = *(const f32x4*)(mod + 8192 + c0);
#pragma unroll
        for (int rr = 0; rr < 2; ++rr) {
          const f32x4 hv = (xv[rr][j] * rstd1[rr]) * gf * (sc + 1.0f) + sh;
          *(unsigned*)(h2 + (size_t)(rowa + rr) * D + c0) = pack8_fp8(hv, hv).x;
          float* tp = tile + (lr0 + rr) * P5_STRIDE + c0; tp[0] = hv.x; tp[1] = hv.y; tp[2] = hv.z; tp[3] = hv.w;
        }
      }
    }
    asm volatile("" ::: "memory");
    P5_LOADB(0, bH0, bL0); P5_LOADB(1, bH1, bL1); P5_LOADB(2, bH2, bL2); P5_LOADB(3, bH3, bL3);
    __syncthreads();
    f32x4 racc[4];
#pragma unroll
    for (int jt = 0; jt < 4; ++jt) racc[jt] = (f32x4){0.f, 0.f, 0.f, 0.f};
#define P5_STEP(ks, H, L) do { \
      const float* ap = tile + (lane & 15) * P5_STRIDE + 32 * (8 * wave + (ks)) + 8 * (lane >> 4); \
      const f32x4 a0 = *(const f32x4*)ap, a1 = *(const f32x4*)(ap + 4); \
      const float av[8] = {a0.x, a0.y, a0.z, a0.w, a1.x, a1.y, a1.z, a1.w}; \
      unsigned hw[4], lw[4]; \
      _Pragma("unroll") for (int j = 0; j < 4; ++j) { const unsigned h = cvtpk2(av[2 * j], av[2 * j + 1]); hw[j] = h; lw[j] = cvtpk2(av[2 * j] - bf_lo(h), av[2 * j + 1] - bf_hi(h)); } \
      const bf16x8 ah = __builtin_bit_cast(bf16x8, (u32x4){hw[0], hw[1], hw[2], hw[3]}), al = __builtin_bit_cast(bf16x8, (u32x4){lw[0], lw[1], lw[2], lw[3]}); \
      _Pragma("unroll") for (int jt = 0; jt < 4; ++jt) { \
        const bf16x8 bh = __builtin_bit_cast(bf16x8, H[jt]), bl = __builtin_bit_cast(bf16x8, L[jt]); \
        racc[jt] = __builtin_amdgcn_mfma_f32_16x16x32_bf16(ah, bh, racc[jt], 0, 0, 0); \
        racc[jt] = __builtin_amdgcn_mfma_f32_16x16x32_bf16(ah, bl, racc[jt], 0, 0, 0); \
        racc[jt] = __builtin_amdgcn_mfma_f32_16x16x32_bf16(al, bh, racc[jt], 0, 0, 0); } } while (0)
    P5_STEP(0, bH0, bL0); P5_LOADB(4, bH0, bL0);
    P5_STEP(1, bH1, bL1); P5_LOADB(5, bH1, bL1);
    P5_STEP(2, bH2, bL2); P5_LOADB(6, bH2, bL2);
    P5_STEP(3, bH3, bL3); P5_LOADB(7, bH3, bL3);
    P5_STEP(4, bH0, bL0); P5_STEP(5, bH1, bL1); P5_STEP(6, bH2, bL2); P5_STEP(7, bH3, bL3);
#undef P5_STEP
    __syncthreads();
#pragma unroll
    for (int jt = 0; jt < 4; ++jt)
#pragma unroll
      for (int r = 0; r < 4; ++r) part[(wave * 16 + (lane >> 4) * 4 + r) * 64 + 16 * jt + (lane & 15)] = racc[jt][r];
    __syncthreads();
#pragma unroll 1
    for (int rr = 0; rr < 2; ++rr) {
      const int lr = 2 * wave + rr, tok = row0 + lr;
      float logit = 0.f;
#pragma unroll
      for (int w = 0; w < 8; ++w) logit += part[(w * 16 + lr) * 64 + lane];
      const float score = 1.0f / (1.0f + expf(-logit));
      const float v = score + br_[lane];
      int rk = 0;
#pragma unroll
      for (int d = 1; d < 8; ++d) { const int ol = (lane & ~7) | ((lane + d) & 7); const float ov = __shfl(v, ol); rk += (ov > v || (ov == v && ol < lane)) ? 1 : 0; }
      float gs = rk < 2 ? v : 0.f;
      gs += __shfl_xor(gs, 1); gs += __shfl_xor(gs, 2); gs += __shfl_xor(gs, 4);
      int grk = 0; const int g = lane >> 3;
#pragma unroll
      for (int gg = 0; gg < 8; ++gg) { const float og = __shfl(gs, 8 * gg); grk += (og > gs || (og == gs && gg < g)) ? 1 : 0; }
      const float mv = grk < 4 ? v : -INFINITY;
      int erk = 0;
#pragma unroll 8
      for (int e2 = 0; e2 < 64; ++e2) { const float ov = __shfl(mv, e2); erk += (ov > mv || (ov == mv && e2 < lane)) ? 1 : 0; }
      const bool sel = (erk < 8) && (grk < 4);
      const float tot = wave_sum(sel ? score : 0.f);
      if (sel) {
        topw[tok * 8 + erk] = score / tot * 2.5f;
        const int lp = atomicAdd(&lcnt[lane], 1);
        const int ix = atomicAdd(&nent[0], 1);
        ent[ix] = (tok * 8 + erk) | (lane << 16) | (lp << 22);
      }
    }
    __syncthreads();
  }
  unsigned* gcnt = (unsigned*)(ws + WS_CTL) + CW_GCNT;
  if (tid < 64) lbase[tid] = (int)atomicAdd(&gcnt[tid], (unsigned)lcnt[tid]);
  __syncthreads();
  int* rowl = (int*)(ws + WS_ROWL);
  const int ne = nent[0];
  int* tpos = (int*)(ws + WS_TPOS);
  for (int i = tid; i < ne; i += NTHREADS) { const int w = ent[i]; const int code = w & 0xffff, e = (w >> 16) & 63, lp = (w >> 22) & 1023; const int pos = lbase[e] + lp; rowl[e * 8192 + pos] = code; tpos[code] = (e << 16) | pos; }
}

struct MoeMap { LAS int* cnt; LAS int* tstart; LAS unsigned char* t2e; };
__device__ __forceinline__ void moe_map_build(const Params& p, char* lds, MoeMap& mm) {
  mm.cnt = (LAS int*)((LAS char*)lds + 140000); mm.tstart = mm.cnt + 80; mm.t2e = (LAS unsigned char*)((LAS char*)lds + 141024);
  if (threadIdx.x < 64) {
    const unsigned* gcnt = (const unsigned*)(p.ws + WS_CTL) + CW_GCNT; const int e = (int)threadIdx.x;
    const int c = (int)__hip_atomic_load(&gcnt[e], __ATOMIC_RELAXED, __HIP_MEMORY_SCOPE_AGENT);
    const int nt = (c + 255) >> 8; int inc = nt;
#pragma unroll
    for (int d = 1; d < 64; d <<= 1) { const int o = __shfl_up(inc, d, 64); if (e >= d) inc += o; }
    mm.cnt[e] = c; mm.tstart[e] = inc - nt;
    if (e == 63) { mm.cnt[64] = T; mm.tstart[64] = inc; mm.tstart[65] = inc + ((T + 255) >> 8); }
  }
  __syncthreads();
  for (int e = threadIdx.x; e < 65; e += NTHREADS) for (int t = mm.tstart[e]; t < mm.tstart[e + 1]; ++t) mm.t2e[t] = (unsigned char)e;
  __syncthreads();
}
__device__ __forceinline__ int moe_find(const MoeMap& mm, int mtg) { return (int)mm.t2e[mtg]; }

struct RowGather { const int* rl; int cnt, base; __device__ __forceinline__ int operator()(int r) const { const int i = base + r; return i < cnt ? (rl[i] >> 3) : 0; } };

__device__ __forceinline__ void phase8(const Params& p, const MoeMap& mm) {
  const int tid = opaque_tid(), lane = tid & 63, wave = tid >> 6;
  const int gw = blockIdx.x * NWAVES + wave, NGW = gridDim.x * NWAVES;
  unsigned char* ws = p.ws;
  const unsigned char* yp = (const unsigned char*)(ws + R_YSLOT); const float* topw = (const float*)(ws + WS_TOPW); const int* tpos = (const int*)(ws + WS_TPOS);
  const float* mod = (const float*)(ws + WS_MOD); const float* g = p.in[26];
  f32x4 gg[8];
#pragma unroll
  for (int j = 0; j < 8; ++j) { const int c0 = 256 * j + 4 * lane; gg[j] = *(const f32x4*)(mod + 10240 + c0) * *(const f32x4*)(g + c0); }
  int row = gw;
  float w[8]; int tp[8];
  if (row < T) {
#pragma unroll
    for (int s = 0; s < 8; ++s) { w[s] = topw[row * 8 + s]; tp[s] = tpos[row * 8 + s]; }
  }
  const size_t shared0 = (size_t)256 * mm.tstart[64];
  for (; row < T; row += NGW) {
    unsigned roff[9];
#pragma unroll
    for (int s = 0; s < 8; ++s) roff[s] = (unsigned)(256 * mm.tstart[tp[s] >> 16] + (tp[s] & 0xffff));
    unsigned q[9][8];
#pragma unroll
    for (int j = 0; j < 8; ++j) {
      const int c0 = 256 * j + 4 * lane;
      q[8][j] = *(const unsigned*)(yp + (shared0 + row) * 2048 + c0);
#pragma unroll
      for (int s = 0; s < 8; ++s) q[s][j] = *(const unsigned*)(yp + (size_t)roff[s] * 2048 + c0);
    }
    u32x2 xb[8];
#pragma unroll
    for (int j = 0; j < 8; ++j) xb[j] = *(const u32x2*)((const bf16_t*)(ws + R_X1) + (size_t)row * D + 256 * j + 4 * lane);
    float wc[8];
#pragma unroll
    for (int s = 0; s < 8; ++s) wc[s] = w[s];
    const int nrow = row + NGW;
    if (nrow < T) {
#pragma unroll
      for (int s = 0; s < 8; ++s) { w[s] = topw[nrow * 8 + s]; tp[s] = tpos[nrow * 8 + s]; }
    }
    f32x4 v[8]; float ss = 0.f;
#pragma unroll
    for (int j = 0; j < 8; ++j) {
      f32x4 a = unpack4_fp8(q[8][j]);
#pragma unroll
      for (int s = 0; s < 8; ++s) a += unpack4_fp8(q[s][j]) * wc[s];
      v[j] = a; ss += a.x * a.x + a.y * a.y + a.z * a.z + a.w * a.w;
    }
    const float rstd = 1.0f / sqrtf(wave_sum(ss) * (1.0f / D) + EPS);
#pragma unroll
    for (int j = 0; j < 8; ++j) {
      const int c0 = 256 * j + 4 * lane;
      const f32x4 x1 = (f32x4){bf_lo(xb[j].x), bf_hi(xb[j].x), bf_lo(xb[j].y), bf_hi(xb[j].y)};
      *(f32x4*)(p.out + (size_t)row * D + c0) = x1 + gg[j] * (v[j] * rstd);
    }
  }
}

template <bool GATHER> struct SchedMoe {
  MoeMap mm; int shift, nwg, G, c; const char* Abase; const char* Bbase; size_t bstride, tstepB, tstepA; const int* rowl;
  __device__ __forceinline__ bool next(int i, pg8::Unit& u) const {
    const int L = i * G + c; if (L >= nwg) return false;
    const int wgid = pg8::xcd_remap(L, nwg);
    const int mtg = wgid >> shift, pn = wgid & ((1 << shift) - 1), e = moe_find(mm, mtg);
    u.pm = mtg; u.pn = pn; u.e = e; u.aux = mtg - mm.tstart[e];
    u.A = GATHER ? Abase : Abase + (size_t)mtg * tstepA; u.B = Bbase + (size_t)e * bstride + (size_t)pn * tstepB; return true;
  }
  __device__ __forceinline__ int row(const pg8::Unit& u, int r) const {
    const int i = 256 * u.aux + r;
    if (u.e == 64) return i;
    return i < mm.cnt[u.e] ? (rowl[u.e * 8192 + i] >> 3) : 0;
  }
};


#define XB_TMO      128
#define XB_XCNT(j)  (256  + 64 * (j))
#define XB_XSUB(j)  (1280 + 64 * (j))
#define XB_XGEN(j)  (2304 + 64 * (j))
#define XB_TOP      3328
#define XB_TOPGEN   3392
#define XCD_BAR_WORDS 3456
#define XB_SPIN_CAP (1u << 18)
__device__ __forceinline__ unsigned xb_ld(unsigned* p)              { return __hip_atomic_load(p, __ATOMIC_RELAXED, __HIP_MEMORY_SCOPE_AGENT); }
__device__ __forceinline__ unsigned xb_add(unsigned* p, unsigned v) { return __hip_atomic_fetch_add(p, v, __ATOMIC_RELAXED, __HIP_MEMORY_SCOPE_AGENT); }
__device__ __forceinline__ unsigned xb_xcc_id() { return (unsigned)__builtin_amdgcn_s_getreg((3 << 11) | 20) & 0xFu; }
#define XB_SPIN(cond, bar) do { unsigned _sp = 0; while (cond) { __builtin_amdgcn_s_sleep(1); \
    if ((++_sp & 255u) == 0u) { if (xb_ld(&(bar)[XB_TMO])) break; if (_sp > XB_SPIN_CAP) { atomicAdd(&(bar)[XB_TMO], 1u); break; } } } } while (0)
struct XcdBarrier { unsigned* bar; unsigned x; volatile LAS unsigned* st; };
__device__ __forceinline__ XcdBarrier xcd_barrier_post(unsigned* bar, volatile LAS unsigned* st) {
    XcdBarrier b; b.bar = bar; b.x = xb_xcc_id(); b.st = st;
    if (threadIdx.x == 0) (void)xb_add(&bar[XB_XCNT(b.x)], 1u);
    return b;
}
__device__ __forceinline__ void xcd_barrier_complete(unsigned* bar, unsigned x, unsigned& nloc, unsigned& nx) {
    const unsigned G = gridDim.x * gridDim.y * gridDim.z;
    unsigned sum, cnt, mine, sp = 0u;
    for (;;) {
        sum = 0u; cnt = 0u; mine = 0u;
#pragma unroll
        for (unsigned j = 0; j < 16; ++j) { const unsigned c = xb_ld(&bar[XB_XCNT(j)]); sum += c; cnt += (c > 0u) ? 1u : 0u; mine = (j == x) ? c : mine; }
        if (sum == G) break;
        __builtin_amdgcn_s_sleep(1);
        if ((++sp & 255u) == 0u) { if (xb_ld(&bar[XB_TMO])) break; if (sp > XB_SPIN_CAP) { atomicAdd(&bar[XB_TMO], 1u); break; } }
    }
    nloc = mine > 0u ? mine : 1u; nx = cnt > 0u ? cnt : 1u;
}
__device__ __forceinline__ void xcd_barrier(const XcdBarrier& b) {
    asm volatile("s_waitcnt vmcnt(0)" ::: "memory");
    __syncthreads();
    if (threadIdx.x == 0) {
        unsigned* bar = b.bar;
        __builtin_amdgcn_s_waitcnt(0);
        unsigned nloc = b.st[0], nx = b.st[1];
        if (nloc == 0u) { xcd_barrier_complete(bar, b.x, nloc, nx); b.st[0] = nloc; b.st[1] = nx; }
        const unsigned old = xb_add(&bar[XB_XSUB(b.x)], 1u);
        const unsigned gen = old / nloc;
        if (old + 1u == (gen + 1u) * nloc) {
            __builtin_amdgcn_fence(__ATOMIC_RELEASE, "agent");
            asm volatile("s_waitcnt vmcnt(0)" ::: "memory");
            const unsigned og = xb_add(&bar[XB_TOP], 1u);
            const unsigned tg = og / nx;
            if (og + 1u == (tg + 1u) * nx) xb_add(&bar[XB_TOPGEN], 1u);
            else XB_SPIN(xb_ld(&bar[XB_TOPGEN]) == tg, bar);
            __builtin_amdgcn_fence(__ATOMIC_ACQUIRE, "agent");
            xb_add(&bar[XB_XGEN(b.x)], 1u);
            asm volatile("s_waitcnt vmcnt(0)" ::: "memory");
        } else {
            XB_SPIN(xb_ld(&bar[XB_XGEN(b.x)]) == gen, bar);
            __builtin_amdgcn_fence(__ATOMIC_ACQUIRE, "agent");
            asm volatile("s_waitcnt vmcnt(0)" ::: "memory");
        }
    }
    __syncthreads();
}
constexpr int CW_BAR = 4096;
constexpr int LDS_BARST = 147392;

#ifndef FAST_GEMM
#define FAST_GEMM 1
#endif
#ifndef FAST_ATTN
#define FAST_ATTN 1
#endif

__global__ void __launch_bounds__(NTHREADS) fwd_megakernel(Params p) {
  extern __shared__ __attribute__((aligned(16))) char lds[];
  cg::grid_group grid = cg::this_grid();
  unsigned char* ws = p.ws;
  const int G = gridDim.x;
  LAS unsigned char* ring = (LAS unsigned char*)lds;
  if (threadIdx.x < 16) ((LAS unsigned*)(ring + LDS_BARST))[threadIdx.x] = 0u;
  __syncthreads();
  const XcdBarrier xbar = xcd_barrier_post((unsigned*)(ws + WS_CTL) + CW_BAR, (volatile LAS unsigned*)(ring + LDS_BARST));
#define GRID_BAR() xcd_barrier(xbar)

  phase0a(p, lds);
#if DUP_PHASE == 1
  GRID_BAR(); phase0a(p, lds);
#endif
  GRID_BAR();
  phase0b(p, lds);
  GRID_BAR();
  {
    EpiProj<true> E{ws, 0};
#if FAST_GEMM
    pg8::SchedPlain S(ws + WS_H2, ws + WS_WIN, T, 4096, D, G, (int)blockIdx.x);
    pg8::gemm_phase<EpiProj<true>, pg8::SchedPlain, true, false>(ring, D, S, E);
#if DUP_PHASE == 2
    GRID_BAR(); pg8::gemm_phase<EpiProj<true>, pg8::SchedPlain, true, false>(ring, D, S, E);
#endif
#else
    for (int u = blockIdx.x; u < 32 * 18; u += G) {
      pg8::Unit un{}; un.pm = u / 18; un.pn = u % 18;
      gemm_tile_naive<true>((const bf16_t*)(ws + WS_H2), D, (const bf16_t*)(ws + WS_WIN) + (size_t)256 * un.pn * D, D, RowIdent{256 * un.pm}, E, un);
    }
#endif
  }
  GRID_BAR();
  {
    EpiRowScale<true> EQ{(bf16_t*)(ws + R_QM), NQ, (const float*)(ws + WS_SSQ), 12, 1.0f / QR, 0.07216878364870322f * 1.4426950408889634f};
    EpiRowScale<true> EK{(bf16_t*)(ws + R_KVM), NKV, (const float*)(ws + WS_SSQ + 512 * 1024), 8, 1.0f / KVR, 1.0f};
#if FAST_GEMM
    const int bx = (int)blockIdx.x, NA = (G >= 128) ? 64 : 0;
    if (NA) { EpiProj<true> EV{ws, 16};
      pg8::SchedPlain S(ws + WS_H2, ws + WS_WIN + (size_t)4096 * D * 2, T, 512, D, NA, bx < NA ? bx : (1 << 20));
      pg8::gemm_phase<EpiProj<true>, pg8::SchedPlain, true, false>(ring, D, S, EV); }
    else { EpiProj<true> EV{ws, 16};
      pg8::SchedPlain S(ws + WS_H2, ws + WS_WIN + (size_t)4096 * D * 2, T, 512, D, G, bx);
      pg8::gemm_phase<EpiProj<true>, pg8::SchedPlain, true, false>(ring, D, S, EV); }
    { pg8::SchedPlain S(ws + R_QLAT, ws + WS_WUQ, T, NQ, QR, G - NA, bx >= NA ? bx - NA : (1 << 20));
      pg8::gemm_phase<EpiRowScale<true>, pg8::SchedPlain, true, false>(ring, QR, S, EQ); }
    { pg8::SchedPlain S(ws + R_KVLAT, ws + WS_WUKV, T, NKV, KVR, G - NA, bx >= NA ? bx - NA : (1 << 20));
      pg8::gemm_phase<EpiRowScale<true>, pg8::SchedPlain, true, false>(ring, KVR, S, EK); }
#else
    for (int u = blockIdx.x; u < 32 * 6 + 32 * 8; u += G) {
      pg8::Unit un{};
      if (u < 192) { un.pm = u / 6; un.pn = u % 6;
        gemm_tile_naive<true>((const bf16_t*)(ws + R_QLAT), QR, (const bf16_t*)(ws + WS_WUQ) + (size_t)256 * un.pn * QR, QR, RowIdent{256 * un.pm}, EQ, un);
      } else { const int v = u - 192; un.pm = v / 8; un.pn = v % 8;
        gemm_tile_naive<true>((const bf16_t*)(ws + R_KVLAT), KVR, (const bf16_t*)(ws + WS_WUKV) + (size_t)256 * un.pn * KVR, KVR, RowIdent{256 * un.pm}, EK, un);
      }
    }
#endif
  }
  rotary_rows(p);
  GRID_BAR();
#if FAST_ATTN
  fa::phase3_fast(p, ring, lds);
  GRID_BAR();
#else
  phase3_naive(p);
  GRID_BAR();
  phase3b_naive(p);
  GRID_BAR();
#endif
  {
    EpiBf16<true> E{(bf16_t*)(ws + R_Y), D};
#if FAST_GEMM
    pg8::SchedPlain S(ws + R_OATT, ws + WS_WOUT, T, D, D, G, (int)blockIdx.x);
    pg8::gemm_phase<EpiBf16<true>, pg8::SchedPlain, true, false>(ring, D, S, E);
#else
    for (int u = blockIdx.x; u < 32 * 8; u += G) {
      pg8::Unit un{}; un.pm = u / 8; un.pn = u % 8;
      gemm_tile_naive<true>((const bf16_t*)(ws + R_OATT), D, (const bf16_t*)(ws + WS_WOUT) + (size_t)256 * un.pn * D, D, RowIdent{256 * un.pm}, E, un);
    }
#endif
  }
  GRID_BAR();
  phase5(p, lds);
  GRID_BAR();
  {
    MoeMap mm; moe_map_build(p, lds, mm);
    const int nmt = mm.tstart[65];
    {
      EpiSwiglu<true> E{(bf16_t*)(ws + WS_ACT), 1.0f / 32.0f};
      SchedMoe<true> S{mm, 2, nmt * 4, G, (int)blockIdx.x, (const char*)(ws + WS_H2), (const char*)(ws + WS_WGU), (size_t)1024 * D, (size_t)256 * D, 0, (const int*)(ws + WS_ROWL)};
#if FAST_GEMM
      pg8::gemm_phase<EpiSwiglu<true>, SchedMoe<true>, true, true, true>(ring, D / 2, S, E);
#if DUP_PHASE == 6
      GRID_BAR(); pg8::gemm_phase<EpiSwiglu<true>, SchedMoe<true>, true, true, true>(ring, D / 2, S, E);
#endif
#else
      pg8::Unit un;
      for (int i = 0; S.next(i, un); ++i) {
        const int e = un.e, mt = un.aux;
        if (e < 64) gemm_tile_naive<true>((const bf16_t*)(ws + WS_H2), D, (const bf16_t*)un.B, D, RowGather{(const int*)(ws + WS_ROWL) + e * 8192, mm.cnt[e], 256 * mt}, E, un);
        else gemm_tile_naive<true>((const bf16_t*)(ws + WS_H2), D, (const bf16_t*)un.B, D, RowIdent{256 * mt}, E, un);
      }
#endif
    }
    GRID_BAR();
    {
      EpiRowsFp8M<true> E{(unsigned char*)(ws + R_YSLOT), 1.0f / 32.0f};
      SchedMoe<false> S{mm, 3, nmt * 8, G, (int)blockIdx.x, (const char*)(ws + WS_ACT), (const char*)(ws + WS_WD), (size_t)2048 * DE, (size_t)256 * DE, (size_t)256 * DE, (const int*)(ws + WS_ROWL)};
#if FAST_GEMM
      pg8::gemm_phase<EpiRowsFp8M<true>, SchedMoe<false>, true, false, true, true>(ring, DE / 2, S, E);
#if DUP_PHASE == 7
      GRID_BAR(); pg8::gemm_phase<EpiRowsFp8M<true>, SchedMoe<false>, true, false, true, true>(ring, DE / 2, S, E);
#endif
#else
      pg8::Unit un;
      for (int i = 0; S.next(i, un); ++i)
        gemm_tile_naive<true>((const bf16_t*)(ws + WS_ACT), DE, (const bf16_t*)un.B, DE, RowIdent{256 * un.pm}, E, un);
#endif
    }
  }
  GRID_BAR();
  { MoeMap mm8; mm8.cnt = (LAS int*)((LAS char*)lds + 140000); mm8.tstart = mm8.cnt + 80; mm8.t2e = (LAS unsigned char*)((LAS char*)lds + 141024); phase8(p, mm8); }
}

extern "C" void kernel_launch(void* const* d_in, const int* in_sizes, int n_in, void* d_out, int out_size, void* d_ws, size_t ws_size, hipStream_t stream) {
  static int grid_blocks = 0;
  if (grid_blocks == 0) {
    if (n_in != 27 || out_size != T * D || ws_size < WS_END) { fprintf(stderr, "kernel_launch: unexpected shapes (n_in %d out %d ws %zu)\n", n_in, out_size, ws_size); grid_blocks = -1; return; }
    int dev = 0, cus = 0, per_cu = 0;
    hipGetDevice(&dev);
    hipDeviceGetAttribute(&cus, hipDeviceAttributeMultiprocessorCount, dev);
    hipFuncSetAttribute((const void*)fwd_megakernel, hipFuncAttributeMaxDynamicSharedMemorySize, LDS_BYTES);
    hipOccupancyMaxActiveBlocksPerMultiprocessor(&per_cu, (const void*)fwd_megakernel, NTHREADS, LDS_BYTES);
    if (per_cu < 1) { fprintf(stderr, "kernel_launch: occupancy query says %d\n", per_cu); per_cu = 1; }
    if (per_cu > 1) per_cu = 1;
    grid_blocks = cus * per_cu;
  }
  if (grid_blocks < 0) return;
  hipMemsetAsync((char*)d_ws + WS_CTL, 0, CTL_BYTES, stream);
  Params p{};
  for (int i = 0; i < 27; ++i) p.in[i] = (const float*)d_in[i];
  p.out = (float*)d_out; p.ws = (unsigned char*)d_ws;
  void* args[] = {&p};
  hipError_t e = hipLaunchCooperativeKernel((const void*)fwd_megakernel, dim3(grid_blocks), dim3(NTHREADS), args, LDS_BYTES, stream);
  if (e != hipSuccess) fprintf(stderr, "cooperative launch failed: %s (grid %d)\n", hipGetErrorString(e), grid_blocks);
}
```

```cpp
#include <hip/hip_runtime.h>
#include <hip/hip_cooperative_groups.h>
#include <cstdio>
#include <cstdint>
namespace cg = cooperative_groups;
#ifndef DUP_PHASE
#define DUP_PHASE 0
#endif

typedef unsigned short bf16_t;
typedef short bf16x8 __attribute__((ext_vector_type(8)));
typedef float f32x4 __attribute__((ext_vector_type(4)));
typedef float f32x2 __attribute__((ext_vector_type(2)));
typedef unsigned u32x4 __attribute__((ext_vector_type(4)));
typedef unsigned u32x2 __attribute__((ext_vector_type(2)));
typedef __bf16 bf16x2_t __attribute__((ext_vector_type(2)));

constexpr int T = 8192, D = 2048;
constexpr int NIN = 4608;
constexpr int QR = 768, KVR = 512;
constexpr int NQ = 1536, NKV = 2048;
constexpr int NE = 64, DE = 512;
constexpr float EPS = 1e-6f;
constexpr int NTHREADS = 512, NWAVES = 8;
constexpr int LDS_BYTES = 147456;

constexpr size_t MiB = 1u << 20;
constexpr size_t WS_CTL = 0, CTL_BYTES = 1 * MiB;
constexpr size_t WS_MODP = 1 * MiB;
constexpr size_t WS_MOD = 3 * MiB;
constexpr size_t WS_WRT = 7 * MiB;
constexpr size_t WS_ROPEM = 4 * MiB;
constexpr size_t WS_ROPED = 6 * MiB;
constexpr size_t WS_WIN = 8 * MiB;
constexpr size_t WS_WUQ = 26 * MiB;
constexpr size_t WS_WUKV = 29 * MiB;
constexpr size_t WS_WOUT = 31 * MiB;
constexpr size_t WS_WGU = 40 * MiB;
constexpr size_t WS_WD = 300 * MiB;
constexpr size_t WS_H2 = 430 * MiB;
constexpr size_t WS_ACT = 462 * MiB;
constexpr size_t WS_ROWL = 550 * MiB;
constexpr size_t WS_TOPW = 552 * MiB;
constexpr size_t WS_TPOS = 554 * MiB;
constexpr size_t WS_SSQ = 553 * MiB;
constexpr size_t WS_R1 = 556 * MiB;
constexpr size_t R_QLAT = WS_R1 + 0 * MiB;
constexpr size_t R_KVLAT = WS_R1 + 12 * MiB;
constexpr size_t R_KPE = WS_R1 + 20 * MiB;
constexpr size_t R_DQ = WS_R1 + 21 * MiB;
constexpr size_t R_DK = WS_R1 + 37 * MiB;
constexpr size_t R_DV = WS_R1 + 53 * MiB;
constexpr size_t R_QM = WS_R1 + 69 * MiB;
constexpr size_t R_KVM = WS_R1 + 93 * MiB;
constexpr size_t R_OATT = WS_R1 + 125 * MiB;
constexpr size_t R_Y = WS_R1 + 157 * MiB;
constexpr size_t R_OC = WS_R1 + 221 * MiB;
constexpr size_t R_X1 = WS_R1 + 224 * MiB;
constexpr size_t R_YSLOT = WS_R1;
constexpr size_t WS_END = WS_R1 + 288 * MiB;

constexpr int CW_GCNT = 64;

struct Params {
  const float* in[27];
  float* out;
  unsigned char* ws;
};

__device__ __forceinline__ unsigned f2bf(float f) { unsigned u = __builtin_bit_cast(unsigned, f); return (u + 0x7fffu + ((u >> 16) & 1u)) >> 16; }
__device__ __forceinline__ unsigned pk2(float lo, float hi) { return f2bf(lo) | (f2bf(hi) << 16); }
__device__ __forceinline__ unsigned cvtpk2(float lo, float hi) { f32x2 v = {lo, hi}; bf16x2_t b = __builtin_convertvector(v, bf16x2_t); return __builtin_bit_cast(unsigned, b); }
__device__ __forceinline__ u32x4 pack8(const f32x4& a, const f32x4& b) { return (u32x4){cvtpk2(a.x, a.y), cvtpk2(a.z, a.w), cvtpk2(b.x, b.y), cvtpk2(b.z, b.w)}; }
__device__ __forceinline__ u32x2 pack8_fp8(const f32x4& a, const f32x4& b) {
  int lo = __builtin_amdgcn_cvt_pk_fp8_f32(a.x, a.y, 0, false); lo = __builtin_amdgcn_cvt_pk_fp8_f32(a.z, a.w, lo, true);
  int hi = __builtin_amdgcn_cvt_pk_fp8_f32(b.x, b.y, 0, false); hi = __builtin_amdgcn_cvt_pk_fp8_f32(b.z, b.w, hi, true);
  return (u32x2){(unsigned)lo, (unsigned)hi};
}
__device__ __forceinline__ f32x4 unpack4_fp8(unsigned v) { const f32x2 a = __builtin_amdgcn_cvt_pk_f32_fp8((int)v, false), b = __builtin_amdgcn_cvt_pk_f32_fp8((int)v, true); return (f32x4){a.x, a.y, b.x, b.y}; }
__device__ __forceinline__ float bf_lo(unsigned u) { return __uint_as_float(u << 16); }
__device__ __forceinline__ float bf_hi(unsigned u) { return __uint_as_float(u & 0xffff0000u); }
__device__ __forceinline__ float bf1(bf16_t h) { return __uint_as_float(((unsigned)h) << 16); }
__device__ __forceinline__ float wave_sum(float v) {
#pragma unroll
  for (int o = 1; o < 64; o <<= 1) v += __shfl_xor(v, o);
  return v;
}
__device__ __forceinline__ float dot2bf(unsigned a, unsigned b, float c) {
  return __builtin_amdgcn_fdot2_f32_bf16(__builtin_bit_cast(bf16x2_t, a), __builtin_bit_cast(bf16x2_t, b), c, false);
}
__device__ __forceinline__ void sincos_rev(float ang, float& c, float& s) {
  float rev = ang * 0.15915494309189535f;
  rev = rev - floorf(rev);
  s = __builtin_amdgcn_sinf(rev);
  c = __builtin_amdgcn_cosf(rev);
}
__device__ __forceinline__ int opaque_tid() { int t = threadIdx.x; asm volatile("" : "+v"(t)); return t; }
__device__ __forceinline__ int perm32(int rho) { const int n = rho >> 4, i = rho & 15; return 8 * (i >> 2) + 4 * n + (i & 3); }

struct TrDesc { const float* src; bf16_t* dst; const float* gs; int ldw, ldt; int f8; };
template <bool NT> __device__ __forceinline__ void tr_load(const TrDesc& d, f32x4 (&v)[8], int lane) {
  const float* s = d.src + (size_t)(lane >> 3) * d.ldw + 4 * (lane & 7);
#pragma unroll
  for (int i = 0; i < 8; ++i) { const f32x4* q = (const f32x4*)(s + (size_t)(8 * i) * d.ldw); v[i] = NT ? __builtin_nontemporal_load(q) : *q; }
}
template <bool NT> __device__ __forceinline__ void tr_load_pair(const TrDesc& d, f32x4 (&v)[8], int lane) {
  const float* s = d.src + (size_t)(2 * (lane >> 3)) * d.ldw + 4 * (lane & 7);
#pragma unroll
  for (int i = 0; i < 8; ++i) { const f32x4* q = (const f32x4*)(s + (size_t)(16 * (i >> 1) + (i & 1)) * d.ldw); v[i] = NT ? __builtin_nontemporal_load(q) : *q; }
}
template <bool NT> __device__ __forceinline__ void tr_finish_pair(const TrDesc& d, f32x4 (&v)[8], float* scr, int lane) {
  const int r8 = lane >> 3, c4 = lane & 7;
  const unsigned sb = (unsigned)(uintptr_t)scr;
  const unsigned wa = sb + (unsigned)((c4 >> 2) * 1024 + r8 * 32 + 8 * (c4 & 3));
#pragma unroll
  for (int j = 0; j < 4; ++j) {
    const f32x4 a = v[2 * j] * 32.0f, b = v[2 * j + 1] * 32.0f;
    int d0 = __builtin_amdgcn_cvt_pk_fp8_f32(a.x, b.x, 0, false); d0 = __builtin_amdgcn_cvt_pk_fp8_f32(a.y, b.y, d0, true);
    int d1 = __builtin_amdgcn_cvt_pk_fp8_f32(a.z, b.z, 0, false); d1 = __builtin_amdgcn_cvt_pk_fp8_f32(a.w, b.w, d1, true);
    const u32x2 w = (u32x2){(unsigned)d0, (unsigned)d1};
    asm volatile("ds_write_b64 %0, %1 offset:%c2" :: "v"(wa), "v"(w), "i"(256 * j) : "memory");
  }
  const int g = lane >> 4, q = lane & 15, r = q >> 2, c = q & 3, odd = g & 1;
  const unsigned ra = sb + (unsigned)((2 * g + odd) * 128 + r * 32 + 8 * c), rb = sb + (unsigned)((2 * g + 1 - odd) * 128 + r * 32 + 8 * c);
  u32x2 R0, R1, R2, R3;
  asm volatile("ds_read_b64_tr_b16 %0, %4\n\tds_read_b64_tr_b16 %1, %5\n\tds_read_b64_tr_b16 %2, %4 offset:1024\n\tds_read_b64_tr_b16 %3, %5 offset:1024\n\ts_waitcnt lgkmcnt(0)"
               : "=&v"(R0), "=&v"(R1), "=&v"(R2), "=&v"(R3) : "v"(ra), "v"(rb) : "memory");
  unsigned char* o = (unsigned char*)d.dst + (size_t)q * d.ldt + 16 * g;
  const u32x4 o0 = odd ? (u32x4){R1.x, R1.y, R0.x, R0.y} : (u32x4){R0.x, R0.y, R1.x, R1.y}, o1 = odd ? (u32x4){R3.x, R3.y, R2.x, R2.y} : (u32x4){R2.x, R2.y, R3.x, R3.y};
  u32x4* q0 = (u32x4*)o; u32x4* q1 = (u32x4*)(o + (size_t)16 * d.ldt);
  if (NT) { __builtin_nontemporal_store(o0, q0); __builtin_nontemporal_store(o1, q1); } else { *q0 = o0; *q1 = o1; }
}
template <bool NT> __device__ __forceinline__ void tr_finish(const TrDesc& d, f32x4 (&v)[8], float* scr, int lane) {
  const int r8 = lane >> 3, c4 = lane & 7;
  if (d.gs) {
#pragma unroll
    for (int i = 0; i < 8; ++i) v[i] *= d.gs[8 * i + r8];
  }
#pragma unroll
  for (int i = 0; i < 8; ++i) { float* t = scr + (8 * i + r8) * 33 + 4 * c4; t[0] = v[i].x; t[1] = v[i].y; t[2] = v[i].z; t[3] = v[i].w; }
  asm volatile("s_waitcnt lgkmcnt(0)" ::: "memory");
  const int c = lane & 7;
  if (d.f8) {
#pragma unroll
    for (int j = 0; j < 4; ++j) {
      const int n = (lane >> 3) + 8 * j; const float* s = scr + (8 * c) * 33 + n;
      const f32x4 a = (f32x4){s[0 * 33], s[1 * 33], s[2 * 33], s[3 * 33]} * 32.0f, b = (f32x4){s[4 * 33], s[5 * 33], s[6 * 33], s[7 * 33]} * 32.0f;
      const u32x2 o = pack8_fp8(a, b);
      u32x2* q = (u32x2*)((unsigned char*)d.dst + (size_t)n * d.ldt + 8 * c);
      if (NT) __builtin_nontemporal_store(o, q); else *q = o;
    }
  } else {
#pragma unroll
    for (int j = 0; j < 4; ++j) {
      const int n = (lane >> 3) + 8 * j; const float* s = scr + (8 * c) * 33 + n;
      u32x4 o; o.x = cvtpk2(s[0 * 33], s[1 * 33]); o.y = cvtpk2(s[2 * 33], s[3 * 33]); o.z = cvtpk2(s[4 * 33], s[5 * 33]); o.w = cvtpk2(s[6 * 33], s[7 * 33]);
      u32x4* q = (u32x4*)(d.dst + (size_t)n * d.ldt + 8 * c);
      if (NT) __builtin_nontemporal_store(o, q); else *q = o;
    }
  }
  asm volatile("s_waitcnt lgkmcnt(0)" ::: "memory");
}
constexpr int I_WIN = 32 * 138, I_WUQ = 12 * 48, I_WUKV = 8 * 64, I_WOUT = 32 * 64, I_GU = 65 * 1024, I_DN = 65 * 512;
constexpr int TR_SMALL = I_WIN + I_WUQ + I_WUKV + I_WOUT, TOTAL_TR = TR_SMALL + I_GU + I_DN;
constexpr int TR_FG = TR_SMALL - I_WOUT;
constexpr int CONV_CHUNK = 64, N_CONV_CHUNKS = (I_WOUT + I_GU + I_DN) / CONV_CHUNK;
static_assert((I_WOUT + I_GU + I_DN) % CONV_CHUNK == 0, "chunking");
__device__ __forceinline__ TrDesc tr_decode(const Params& p, int r) {
  unsigned char* ws = p.ws; TrDesc d; d.gs = nullptr; d.f8 = 0;
  if (r < I_WIN) {
    const int kb = r / 138, nb = r % 138, n0 = 32 * nb, k0 = 64 * kb;
    const int d0 = n0 < 1344 ? n0 : n0 + 192;
    d.src = p.in[5] + (size_t)k0 * 4416 + n0; d.ldw = 4416; d.dst = (bf16_t*)(ws + WS_WIN) + (size_t)d0 * 2048 + k0; d.ldt = 2048; return d;
  }
  r -= I_WIN;
  if (r < I_WUQ) { const int kb = r / 48, nb = r % 48, k0 = 64 * kb, n0 = 32 * nb;
    d.src = p.in[7] + (size_t)k0 * 1536 + n0; d.ldw = 1536; d.dst = (bf16_t*)(ws + WS_WUQ) + (size_t)n0 * 768 + k0; d.ldt = 768; d.gs = p.in[6] + k0; return d; }
  r -= I_WUQ;
  if (r < I_WUKV) { const int kb = r / 64, nb = r % 64, k0 = 64 * kb, n0 = 32 * nb;
    d.src = p.in[9] + (size_t)k0 * 2048 + n0; d.ldw = 2048; d.dst = (bf16_t*)(ws + WS_WUKV) + (size_t)n0 * 512 + k0; d.ldt = 512; d.gs = p.in[8] + k0; return d; }
  r -= I_WUKV;
  if (r < I_WOUT) { const int kb = r / 64, nb = r % 64, k0 = 64 * kb, n0 = 32 * nb;
    d.src = p.in[15] + (size_t)k0 * 2048 + n0; d.ldw = 2048; d.dst = (bf16_t*)(ws + WS_WOUT) + (size_t)n0 * 2048 + k0; d.ldt = 2048; return d; }
  r -= I_WOUT;
  if (r < I_GU) {
    const int e = r >> 10, q = r & 1023, up = q >> 9, idx = q & 511, kb = idx >> 4, nb = idx & 15, n0 = 32 * nb, k0 = 64 * kb;
    const float* s = (e < 64) ? (p.in[up ? 21 : 20] + (size_t)e * 2048 * 512) : p.in[up ? 24 : 23];
    const int d0 = 256 * (n0 >> 7) + (n0 & 127) + 128 * up;
    d.src = s + (size_t)k0 * 512 + n0; d.ldw = 512; d.dst = (bf16_t*)(ws + WS_WGU + (size_t)e * 1024 * 2048 + (size_t)d0 * 2048 + k0); d.ldt = 2048; d.f8 = 1; return d;
  }
  r -= I_GU;
  { const int e = r >> 9, idx = r & 511, kb = idx >> 6, nb = idx & 63, k0 = 64 * kb, n0 = 32 * nb;
    const float* s = (e < 64) ? (p.in[22] + (size_t)e * 512 * 2048) : p.in[25];
    d.src = s + (size_t)k0 * 2048 + n0; d.ldw = 2048; d.dst = (bf16_t*)(ws + WS_WD + (size_t)e * 2048 * 512 + (size_t)n0 * 512 + k0); d.ldt = 512; d.f8 = 1; return d; }
}
__device__ __forceinline__ void phase0a(const Params& p, char* lds) {
  const int tid = opaque_tid(), lane = tid & 63, wave = tid >> 6;
  const int gw = blockIdx.x * NWAVES + wave, NGW = gridDim.x * NWAVES;
  float* scr = (float*)(lds + wave * 16384);
  unsigned char* ws = p.ws;
  for (int r = gw; r < 48 * 32; r += NGW) {
    const int nt = r % 48, ks = r / 48;
    const float* c = p.in[1]; const float* w = p.in[2] + (size_t)(64 * ks) * 12288 + 256 * nt + 4 * lane;
    f32x4 acc = {0.f, 0.f, 0.f, 0.f};
    const float cl = c[64 * ks + lane]; const float sl = cl / (1.f + expf(-cl));
#pragma unroll
    for (int k = 0; k < 64; ++k) {
      const float sv = __int_as_float(__builtin_amdgcn_readlane(__float_as_int(sl), k));
      const f32x4 wv = *(const f32x4*)(w + (size_t)k * 12288);
      acc += wv * sv;
    }
    *(f32x4*)((float*)(ws + WS_MODP) + (size_t)ks * 12288 + 256 * nt + 4 * lane) = acc;
  }
  {
    f32x4 vA[8], vB[8]; TrDesc dA, dB;
    int it = gw;
    if (it < TR_FG) {
      dA = tr_decode(p, it); tr_load<false>(dA, vA, lane);
      for (;;) {
        const int itB = it + NGW; const bool hasB = itB < TR_FG;
        if (hasB) { dB = tr_decode(p, itB); tr_load<false>(dB, vB, lane); }
        tr_finish<false>(dA, vA, scr, lane);
        if (!hasB) break;
        const int itA = itB + NGW; const bool hasA = itA < TR_FG;
        if (hasA) { dA = tr_decode(p, itA); tr_load<false>(dA, vA, lane); }
        tr_finish<false>(dB, vB, scr, lane);
        if (!hasA) break;
        it = itA;
      }
    }
  }
  const int gt = blockIdx.x * NTHREADS + tid, NGT = gridDim.x * NTHREADS;
  for (int i = gt; i < T * 40; i += NGT) {
    if (i < T * 32) {
      const int pos = i >> 5, f = i & 31;
      const float inv = powf(500000.0f, -(float)(2 * f) / 64.0f);
      float c, s; sincos_rev((float)pos * inv, c, s);
      ((f32x2*)(ws + WS_ROPEM))[i] = (f32x2){c, s};
    } else {
      const int j = i - T * 32, pos = j >> 3, f = j & 7;
      const float inv = powf(500000.0f, -(float)(2 * f) / 16.0f);
      float c, s; sincos_rev((float)pos * inv, c, s);
      ((f32x2*)(ws + WS_ROPED))[j] = (f32x2){c, s};
    }
  }
  for (int i = gt; i < 64 * 4 * 64; i += NGT) {
    const int l = i & 63, jt = (i >> 6) & 3, s = i >> 8;
    const float* w = p.in[18] + (size_t)(32 * s + 8 * (l >> 4)) * 64 + 16 * jt + (l & 15);
    float v[8], lo[8];
#pragma unroll
    for (int j = 0; j < 8; ++j) { v[j] = w[(size_t)j * 64]; lo[j] = v[j] - bf1((bf16_t)f2bf(v[j])); }
    ((u32x4*)(ws + WS_WRT))[i] = (u32x4){pk2(v[0], v[1]), pk2(v[2], v[3]), pk2(v[4], v[5]), pk2(v[6], v[7])};
    ((u32x4*)(ws + WS_WRT + 256 * 1024))[i] = (u32x4){pk2(lo[0], lo[1]), pk2(lo[2], lo[3]), pk2(lo[4], lo[5]), pk2(lo[6], lo[7])};
  }
  if (blockIdx.x == 0 && tid == 0) {
    float a = 0.f, b = 0.f;
    for (int i = 0; i < 64; ++i) { a += p.in[10][i] * p.in[11][i]; b += p.in[12][i] * p.in[13][i]; }
    ((float*)(ws + WS_MOD))[16384] = expf(a) - expf(b) + 0.2f;
  }
}


__device__ __forceinline__ void conv_chunk(const Params& p, char* lds, int chunk) {
  const int tid = opaque_tid(), lane = tid & 63, wave = tid >> 6;
  float* scr = (float*)(lds + wave * 16384);
  const int base = TR_FG + chunk * CONV_CHUNK + wave * 8;
  f32x4 vA[8], vB[8], vC[8], vD[8]; TrDesc dA, dB, dC, dD;
  if (chunk * CONV_CHUNK >= I_WOUT) {
    dA = tr_decode(p, base + 0); tr_load_pair<true>(dA, vA, lane);
    dB = tr_decode(p, base + 1); tr_load_pair<true>(dB, vB, lane);
    dC = tr_decode(p, base + 2); tr_load_pair<true>(dC, vC, lane);
    dD = tr_decode(p, base + 3); tr_load_pair<true>(dD, vD, lane);
    tr_finish_pair<true>(dA, vA, scr, lane); dA = tr_decode(p, base + 4); tr_load_pair<true>(dA, vA, lane);
    tr_finish_pair<true>(dB, vB, scr, lane); dB = tr_decode(p, base + 5); tr_load_pair<true>(dB, vB, lane);
    tr_finish_pair<true>(dC, vC, scr, lane); dC = tr_decode(p, base + 6); tr_load_pair<true>(dC, vC, lane);
    tr_finish_pair<true>(dD, vD, scr, lane); dD = tr_decode(p, base + 7); tr_load_pair<true>(dD, vD, lane);
    tr_finish_pair<true>(dA, vA, scr, lane);
    tr_finish_pair<true>(dB, vB, scr, lane);
    tr_finish_pair<true>(dC, vC, scr, lane);
    tr_finish_pair<true>(dD, vD, scr, lane);
    return;
  }
  dA = tr_decode(p, base + 0); tr_load<true>(dA, vA, lane);
  dB = tr_decode(p, base + 1); tr_load<true>(dB, vB, lane);
  dC = tr_decode(p, base + 2); tr_load<true>(dC, vC, lane);
  dD = tr_decode(p, base + 3); tr_load<true>(dD, vD, lane);
  tr_finish<true>(dA, vA, scr, lane); dA = tr_decode(p, base + 4); tr_load<true>(dA, vA, lane);
  tr_finish<true>(dB, vB, scr, lane); dB = tr_decode(p, base + 5); tr_load<true>(dB, vB, lane);
  tr_finish<true>(dC, vC, scr, lane); dC = tr_decode(p, base + 6); tr_load<true>(dC, vC, lane);
  tr_finish<true>(dD, vD, scr, lane); dD = tr_decode(p, base + 7); tr_load<true>(dD, vD, lane);
  tr_finish<true>(dA, vA, scr, lane);
  tr_finish<true>(dB, vB, scr, lane);
  tr_finish<true>(dC, vC, scr, lane);
  tr_finish<true>(dD, vD, scr, lane);
}

__device__ __forceinline__ void phase0b(const Params& p, char* lds) {
  const int tid = opaque_tid(), lane = tid & 63, wave = tid >> 6;
  const int gw = blockIdx.x * NWAVES + wave, NGW = gridDim.x * NWAVES;
  unsigned char* ws = p.ws;
  const float* modp = (const float*)(ws + WS_MODP);
  float* shsc = (float*)lds;
  {
    float acc8[8];
#pragma unroll
    for (int i = 0; i < 8; ++i) acc8[i] = p.in[3][tid + NTHREADS * i];
#pragma unroll 8
    for (int k = 0; k < 32; ++k)
#pragma unroll
      for (int i = 0; i < 8; ++i) acc8[i] += modp[(size_t)k * 12288 + tid + NTHREADS * i];
#pragma unroll
    for (int i = 0; i < 8; ++i) shsc[tid + NTHREADS * i] = acc8[i];
  }
  for (int n = blockIdx.x * NTHREADS + tid; n < 12288; n += gridDim.x * NTHREADS) { float s = p.in[3][n]; for (int k = 0; k < 32; ++k) s += modp[(size_t)k * 12288 + n]; ((float*)(ws + WS_MOD))[n] = s; }
  __syncthreads();
  const float* x = p.in[0]; const float* g = p.in[4];
  bf16_t* xn = (bf16_t*)(ws + WS_H2);
  f32x4 v[8]; int row = gw;
  if (row < T) {
#pragma unroll
    for (int j = 0; j < 8; ++j) v[j] = *(const f32x4*)(x + (size_t)row * D + 256 * j + 4 * lane);
  }
  for (; row < T; row += NGW) {
    f32x4 vn[8]; const int nrow = row + NGW;
    if (nrow < T) {
#pragma unroll
      for (int j = 0; j < 8; ++j) vn[j] = *(const f32x4*)(x + (size_t)nrow * D + 256 * j + 4 * lane);
    }
    float ss = 0.f;
#pragma unroll
    for (int j = 0; j < 8; ++j) ss += v[j].x * v[j].x + v[j].y * v[j].y + v[j].z * v[j].z + v[j].w * v[j].w;
    const float rstd = 1.0f / sqrtf(wave_sum(ss) * (1.0f / D) + EPS);
#pragma unroll
    for (int j = 0; j < 8; ++j) {
      const int c0 = 256 * j + 4 * lane;
      const f32x4 gv = *(const f32x4*)(g + c0);
      const f32x4 sh = *(const f32x4*)(shsc + c0), sc = *(const f32x4*)(shsc + 2048 + c0);
      const f32x4 h = (v[j] * rstd) * gv * (sc + 1.0f) + sh;
      u32x2 o; o.x = pk2(h.x, h.y); o.y = pk2(h.z, h.w);
      *(u32x2*)(xn + (size_t)row * D + c0) = o;
    }
#pragma unroll
    for (int j = 0; j < 8; ++j) v[j] = vn[j];
  }
}

template <bool PERM> __device__ __forceinline__ int acc_col(int bj, int wc, int n, int fq) { return 128 * bj + 32 * wc + (PERM ? 8 * fq + 4 * n : 16 * n + 4 * fq); }
__device__ __forceinline__ int acc_row(int ai, int wr, int m, int fr) { return 128 * ai + 64 * wr + 16 * m + fr; }

template <bool PERM, class RowMap, class Epi, class U>
__device__ __forceinline__ void gemm_tile_naive(const bf16_t* A, int lda, const bf16_t* Bt, int K, const RowMap& rm, const Epi& epi, const U& unit) {
  const int tid = opaque_tid(), lane = tid & 63, wid = tid >> 6, wr = wid >> 2, wc = wid & 3, fr = lane & 15, fq = lane >> 4;
  f32x4 acc[2][2][4][2];
#pragma unroll
  for (int a = 0; a < 2; ++a)
#pragma unroll
    for (int b = 0; b < 2; ++b)
#pragma unroll
      for (int m = 0; m < 4; ++m)
#pragma unroll
        for (int n = 0; n < 2; ++n) acc[a][b][m][n] = (f32x4){0.f, 0.f, 0.f, 0.f};
  unsigned aoff[2][4], boff[2][2];
#pragma unroll
  for (int a = 0; a < 2; ++a)
#pragma unroll
    for (int m = 0; m < 4; ++m) aoff[a][m] = (unsigned)rm(acc_row(a, wr, m, fr)) * (unsigned)lda + 8u * fq;
#pragma unroll
  for (int b = 0; b < 2; ++b)
#pragma unroll
    for (int n = 0; n < 2; ++n) { const int rho = 16 * n + fr; boff[b][n] = (unsigned)(128 * b + 32 * wc + (PERM ? perm32(rho) : rho)) * (unsigned)K + 8u * fq; }
  for (int k0 = 0; k0 < K; k0 += 32) {
    bf16x8 af[2][4], bfr[2][2];
#pragma unroll
    for (int a = 0; a < 2; ++a)
#pragma unroll
      for (int m = 0; m < 4; ++m) af[a][m] = *(const bf16x8*)(A + aoff[a][m] + k0);
#pragma unroll
    for (int b = 0; b < 2; ++b)
#pragma unroll
      for (int n = 0; n < 2; ++n) bfr[b][n] = *(const bf16x8*)(Bt + boff[b][n] + k0);
#pragma unroll
    for (int a = 0; a < 2; ++a)
#pragma unroll
      for (int b = 0; b < 2; ++b)
#pragma unroll
        for (int m = 0; m < 4; ++m)
#pragma unroll
          for (int n = 0; n < 2; ++n) acc[a][b][m][n] = __builtin_amdgcn_mfma_f32_16x16x32_bf16(bfr[b][n], af[a][m], acc[a][b][m][n], 0, 0, 0);
  }
  epi(acc, unit, wr, wc, fr, fq);
}


#define LAS __attribute__((address_space(3)))
namespace pg8 {
typedef int i32x4_t __attribute__((ext_vector_type(4)));
constexpr int BM = 256, BK = 64, HALF = 128, HTB = HALF * BK * 2, STAGE_BYTES = 8 * HTB, NXCD = 8, WGM = 8;
__host__ __device__ __forceinline__ int lds_byte(int r, int c) { const int st = (r >> 4) * 2 + (c >> 5), rr = r & 15, cc = c & 31, ob = rr * 64 + cc * 2; return st * 1024 + (ob ^ (((ob >> 9) & 1) << 5)); }
__host__ __device__ __forceinline__ void stage_rc(int b, int& R, int& C) { const int st = b / 1024, sb = b % 1024, swz = sb ^ (((sb >> 9) & 1) << 5); R = (st >> 1) * 16 + swz / 64; C = (st & 1) * 32 + (swz % 64) / 2; }
struct Unit { const char* A; const char* B; int pm, pn, e, aux; };

__device__ __forceinline__ int xcd_remap(int L, int nwg) { const int q = nwg / NXCD, r = nwg % NXCD, xcd = L % NXCD, off = L / NXCD; return (xcd < r ? xcd * (q + 1) : r * (q + 1) + (xcd - r) * q) + off; }

template <class Epi, class Sched, bool ALIGN_EPI, bool GATHER, bool F8 = false, bool MERGEB = false>
__device__ __forceinline__ void gemm_phase(LAS unsigned char* lds, const int K, const Sched& S, const Epi& E) {
    const int tid = opaque_tid(), wid = __builtin_amdgcn_readfirstlane(tid >> 6), lane = tid & 63, wr = wid >> 2, wc = wid & 3, fr = lane & 15, fq = lane >> 4;
    const int nt = K / BK;
    unsigned voffB[2];
#pragma unroll
    for (int i = 0; i < 2; ++i) { int R, C; stage_rc(tid * 16 + i * 8192, R, C); const int Rb = MERGEB ? (64 * (R >> 5) + 16 * ((R >> 2) & 3) + 4 * ((R >> 4) & 1) + (R & 3)) : Epi::PERM ? ((R & ~31) + perm32(R & 31)) : R; voffB[i] = (unsigned)(Rb * K + C) * 2u; }
    const size_t kstep = (size_t)(BK * 2);
    const size_t hstep = MERGEB ? (size_t)8 * K * 2 : (size_t)HALF * K * 2;
    const unsigned ldsw = (unsigned)wid * 1024u;
    const int aoff = lds_byte(wr * 64 + fr, fq * 8), boff = lds_byte(wc * 32 + fr, fq * 8);
#define PG8_SA(b, h) (((b) * 2 + (h)) * HTB)
#define PG8_SB(b, h) ((4 + (b) * 2 + (h)) * HTB)
#define PG8_STAGE(bufoff, gbase, voff) do { _Pragma("unroll") for (int _i = 0; _i < 2; ++_i) \
        __builtin_amdgcn_global_load_lds((const unsigned*)((const char*)(gbase) + (voff)[_i]), (LAS unsigned*)(lds + (bufoff) + ldsw + _i * 8192), 16, 0, 0); } while (0)
#define PG8_LDA(dst, b, h) do { _Pragma("unroll") for (int m = 0; m < 4; ++m) _Pragma("unroll") for (int k = 0; k < 2; ++k) dst[m][k] = *(const LAS bf16x8*)(lds + PG8_SA(b, h) + aoff + m * 2048 + k * 1024); } while (0)
#define PG8_LDB(dst, b, h) do { _Pragma("unroll") for (int n = 0; n < 2; ++n) _Pragma("unroll") for (int k = 0; k < 2; ++k) dst[n][k] = *(const LAS bf16x8*)(lds + PG8_SB(b, h) + boff + n * 2048 + k * 1024); } while (0)
#define PG8_CAT(x, y) __builtin_shufflevector(__builtin_bit_cast(i32x4_t, x), __builtin_bit_cast(i32x4_t, y), 0, 1, 2, 3, 4, 5, 6, 7)
#define PG8_MMA(ai, bj, At, Bt) do { __builtin_amdgcn_s_setprio(1); _Pragma("unroll") for (int m = 0; m < 4; ++m) _Pragma("unroll") for (int n = 0; n < 2; ++n) { \
        if constexpr (F8) { const auto _a8 = PG8_CAT(Bt[n][0], Bt[n][1]); const auto _b8 = PG8_CAT(At[m][0], At[m][1]); \
          asm("v_mfma_scale_f32_16x16x128_f8f6f4 %0, %1, %2, %0, %3, %3 op_sel_hi:[0,0,0]" : "+v"(acc[ai][bj][m][n]) : "v"(_a8), "v"(_b8), "v"(mxs)); } \
        else { _Pragma("unroll") for (int k = 0; k < 2; ++k) acc[ai][bj][m][n] = __builtin_amdgcn_mfma_f32_16x16x32_bf16(Bt[n][k], At[m][k], acc[ai][bj][m][n], 0, 0, 0); } } \
        __builtin_amdgcn_s_setprio(0); } while (0)
#define PG8_WAIT_V(n) asm volatile("s_waitcnt vmcnt(" #n ")" ::: "memory")
#define PG8_WAIT_L(n) asm volatile("s_waitcnt lgkmcnt(" #n ")" ::: "memory")
#define PG8_WAIT_V8_UNLESS(f) asm volatile("s_cmp_lg_u32 %0, 0\n\ts_cbranch_scc1 .Lpg8skip%=\n\ts_waitcnt vmcnt(8)\n.Lpg8skip%=:" :: "s"(f) : "memory", "scc")
#define PG8_BAR __builtin_amdgcn_s_barrier()
#define PG8_SCHED __builtin_amdgcn_sched_barrier(0)
    const int mxs = 0x7f7f7f7f;
    (void)mxs;
    Unit cur, nxt; int ui = 0;
    if (!S.next(0, cur)) return;
    unsigned vA[2][2], vN[2][2];
#define PG8_MKOFF(u, v) do { _Pragma("unroll") for (int _h = 0; _h < 2; ++_h) _Pragma("unroll") for (int _i = 0; _i < 2; ++_i) { int _R, _C; stage_rc(opaque_tid() * 16 + _i * 8192, _R, _C); \
        v[_h][_i] = (unsigned)((GATHER ? S.row(u, _h * HALF + _R) : (_h * HALF + _R)) * K + _C) * 2u; } } while (0)
    PG8_MKOFF(cur, vA);
    f32x4 acc[2][2][4][2];
#pragma unroll
    for (int a = 0; a < 2; ++a)
#pragma unroll
        for (int b = 0; b < 2; ++b)
#pragma unroll
            for (int m = 0; m < 4; ++m)
#pragma unroll
                for (int n = 0; n < 2; ++n) acc[a][b][m][n] = (f32x4){0.f, 0.f, 0.f, 0.f};
    bf16x8 At[4][2], B0[2][2], B1[2][2];
    const char* cA = cur.A; const char* cB = cur.B;
    PG8_STAGE(PG8_SB(0, 0), cB, voffB); PG8_STAGE(PG8_SB(0, 1), cB + hstep, voffB); PG8_STAGE(PG8_SA(0, 0), cA, vA[0]); PG8_STAGE(PG8_SA(0, 1), cA, vA[1]);
    if (wr == 1) PG8_BAR;
    PG8_WAIT_V(2); PG8_BAR;
    PG8_STAGE(PG8_SB(1, 0), cB + kstep, voffB); PG8_STAGE(PG8_SA(1, 0), cA + kstep, vA[0]); PG8_STAGE(PG8_SB(1, 1), cB + hstep + kstep, voffB);
    PG8_WAIT_V(6); PG8_BAR;
    for (;;) {
        const bool has_next = S.next(ui + 1, nxt);
        if (has_next) { PG8_MKOFF(nxt, vN); } else {
#pragma unroll
            for (int h = 0; h < 2; ++h)
#pragma unroll
                for (int i = 0; i < 2; ++i) vN[h][i] = vA[h][i]; }
        const char* nA = has_next ? nxt.A : cA; const char* nB = has_next ? nxt.B : cB;
        for (int t = 0; t < nt; t += 2) {
            const bool last = (t == nt - 2); const int seam = __builtin_amdgcn_readfirstlane((t == 0 && ui > 0) ? 1 : 0);
            const char* a1 = cA + (size_t)(t + 1) * kstep;
            const char* a2 = last ? nA : cA + (size_t)(t + 2) * kstep; const char* b2 = last ? nB : cB + (size_t)(t + 2) * kstep;
            const char* a3 = a2 + kstep; const char* b3 = b2 + kstep;
            unsigned w0[2], w1[2];
#pragma unroll
            for (int i = 0; i < 2; ++i) { w0[i] = last ? vN[0][i] : vA[0][i]; w1[i] = last ? vN[1][i] : vA[1][i]; }
            PG8_LDB(B0, 0, 0); PG8_LDB(B1, 0, 1); PG8_SCHED; PG8_LDA(At, 0, 0); PG8_STAGE(PG8_SA(1, 1), a1, vA[1]);
            PG8_WAIT_V8_UNLESS(seam);
            PG8_WAIT_L(0); PG8_BAR; PG8_MMA(0, 0, At, B0); PG8_MMA(0, 1, At, B1); PG8_BAR; PG8_SCHED;
            PG8_LDA(At, 0, 1); PG8_STAGE(PG8_SB(0, 0), b2, voffB); PG8_STAGE(PG8_SB(0, 1), b2 + hstep, voffB); PG8_STAGE(PG8_SA(0, 0), a2, w0);
            PG8_WAIT_V8_UNLESS(seam);
            PG8_WAIT_L(0); PG8_BAR; PG8_MMA(1, 0, At, B0); PG8_MMA(1, 1, At, B1); PG8_BAR; PG8_SCHED;
            PG8_LDB(B0, 1, 0); PG8_LDB(B1, 1, 1); PG8_SCHED; PG8_LDA(At, 1, 0); PG8_STAGE(PG8_SA(0, 1), a2, w1);
            PG8_WAIT_V(8); PG8_WAIT_L(0); PG8_BAR; PG8_MMA(0, 0, At, B0); PG8_MMA(0, 1, At, B1); PG8_BAR; PG8_SCHED;
            PG8_LDA(At, 1, 1); PG8_STAGE(PG8_SB(1, 0), b3, voffB); PG8_STAGE(PG8_SB(1, 1), b3 + hstep, voffB); PG8_STAGE(PG8_SA(1, 0), a3, w0);
            PG8_WAIT_V(8); PG8_WAIT_L(0); PG8_BAR; PG8_MMA(1, 0, At, B0); PG8_MMA(1, 1, At, B1); PG8_BAR; PG8_SCHED;
        }
        PG8_WAIT_V(0);
        if constexpr (ALIGN_EPI) { if (wr == 0) PG8_BAR; }
        if constexpr (F8) asm volatile("s_nop 15\n\ts_nop 7" ::: "memory");
        E(acc, cur, wr, wc, fr, fq);
        if (!has_next) break;
#pragma unroll
        for (int a = 0; a < 2; ++a)
#pragma unroll
            for (int b = 0; b < 2; ++b)
#pragma unroll
                for (int m = 0; m < 4; ++m)
#pragma unroll
                    for (int n = 0; n < 2; ++n) acc[a][b][m][n] = (f32x4){0.f, 0.f, 0.f, 0.f};
        cur = nxt; cA = nA; cB = nB; ++ui;
#pragma unroll
        for (int h = 0; h < 2; ++h)
#pragma unroll
            for (int i = 0; i < 2; ++i) vA[h][i] = vN[h][i];
        if constexpr (ALIGN_EPI) { if (wr == 1) PG8_BAR; }
    }
    PG8_WAIT_V(0);
    if constexpr (!ALIGN_EPI) { if (wr == 0) PG8_BAR; }
    PG8_BAR;
#undef PG8_SA
#undef PG8_SB
#undef PG8_STAGE
#undef PG8_LDA
#undef PG8_LDB
#undef PG8_MMA
#undef PG8_CAT
#undef PG8_WAIT_V
#undef PG8_WAIT_L
#undef PG8_WAIT_V8_UNLESS
#undef PG8_BAR
#undef PG8_SCHED
#undef PG8_MKOFF
}

struct SchedPlain {
    const char* A; const char* B; int nM, nN, nwg, G, c; size_t tstep;
    __device__ __forceinline__ SchedPlain(const void* A_, const void* B_, int M, int N, int K, int G_, int c_) : A((const char*)A_), B((const char*)B_), nM(M / BM), nN(N / BM), nwg((M / BM) * (N / BM)), G(G_), c(c_), tstep((size_t)BM * K * 2) {}
    __device__ __forceinline__ bool next(int i, Unit& u) const {
        const int L = i * G + c; if (L >= nwg) return false;
        const int wgid = xcd_remap(L, nwg);
        const int nig = WGM * nN, gid = wgid / nig, fm = gid * WGM, gsz = (nM - fm) < WGM ? (nM - fm) : WGM;
        u.pm = fm + ((wgid % nig) % gsz); u.pn = (wgid % nig) / gsz; u.e = 0; u.aux = 0;
        u.A = A + (size_t)u.pm * tstep; u.B = B + (size_t)u.pn * tstep; return true;
    }
    __device__ __forceinline__ int row(const Unit&, int r) const { return r; }
};
}

struct RowIdent { int base; __device__ __forceinline__ int operator()(int r) const { return base + r; } };

template <bool PERM_> struct EpiProj {
  static constexpr bool PERM = PERM_;
  unsigned char* ws; int pn_base;
  __device__ __forceinline__ void operator()(const f32x4 (&acc)[2][2][4][2], const pg8::Unit& u, int wr, int wc, int fr, int fq) const {
    const int pm = u.pm, pn = u.pn + pn_base;
    bf16_t* dst; int ld, cb; float* ssq = nullptr; int nss = 0, sidx = 0; int climit = 256; float osc = 1.0f;
    if (pn < 3) { dst = (bf16_t*)(ws + R_QLAT); ld = 768; cb = 256 * pn; ssq = (float*)(ws + WS_SSQ); nss = 12; sidx = 4 * pn + wc; }
    else if (pn < 5) { dst = (bf16_t*)(ws + R_KVLAT); ld = 512; cb = 256 * (pn - 3); ssq = (float*)(ws + WS_SSQ + 512 * 1024); nss = 8; sidx = 4 * (pn - 3) + wc; }
    else if (pn == 5) { dst = (bf16_t*)(ws + R_KPE); ld = 64; cb = 0; climit = 64; }
    else if (pn < 10) { dst = (bf16_t*)(ws + R_DQ); ld = 1024; cb = 256 * (pn - 6); osc = 0.125f * 1.4426950408889634f; }
    else if (pn < 14) { dst = (bf16_t*)(ws + R_DK); ld = 1024; cb = 256 * (pn - 10); }
    else { dst = (bf16_t*)(ws + R_DV); ld = 1024; cb = 256 * (pn - 14); }
#pragma unroll
    for (int ai = 0; ai < 2; ++ai)
#pragma unroll
      for (int m = 0; m < 4; ++m) {
        const int row = 256 * pm + acc_row(ai, wr, m, fr); float ss = 0.f;
#pragma unroll
        for (int bj = 0; bj < 2; ++bj) {
#pragma unroll
          for (int n = 0; n < 2; ++n) {
            const f32x4 v = acc[ai][bj][m][n];
            ss += v.x * v.x + v.y * v.y + v.z * v.z + v.w * v.w;
            if (!PERM) { const int c0 = acc_col<PERM>(bj, wc, n, fq); if (c0 < climit) { u32x2 o; o.x = cvtpk2(v.x * osc, v.y * osc); o.y = cvtpk2(v.z * osc, v.w * osc); *(u32x2*)(dst + (size_t)row * ld + cb + c0) = o; } }
          }
          if (PERM) { const int c0 = acc_col<PERM>(bj, wc, 0, fq); if (c0 < climit) *(u32x4*)(dst + (size_t)row * ld + cb + c0) = pack8(acc[ai][bj][m][0] * osc, acc[ai][bj][m][1] * osc); }
        }
        if (ssq) { ss += __shfl_xor(ss, 16); ss += __shfl_xor(ss, 32); if (fq == 0) ssq[(size_t)row * nss + sidx] = ss; }
      }
  }
};

template <bool PERM_> struct EpiRowScale {
  static constexpr bool PERM = PERM_;
  bf16_t* dst; int ld; const float* ssq; int nss; float invk; float post;
  __device__ __forceinline__ void operator()(const f32x4 (&acc)[2][2][4][2], const pg8::Unit& u, int wr, int wc, int fr, int fq) const {
    const int pm = u.pm, pn = u.pn;
#pragma unroll
    for (int ai = 0; ai < 2; ++ai)
#pragma unroll
      for (int m = 0; m < 4; ++m) {
        const int row = 256 * pm + acc_row(ai, wr, m, fr); float ss = 0.f;
        for (int i = 0; i < nss; ++i) ss += ssq[(size_t)row * nss + i];
        const float rstd = post / sqrtf(ss * invk + EPS);
#pragma unroll
        for (int bj = 0; bj < 2; ++bj) {
          if (PERM) *(u32x4*)(dst + (size_t)row * ld + 256 * pn + acc_col<PERM>(bj, wc, 0, fq)) = pack8(acc[ai][bj][m][0] * rstd, acc[ai][bj][m][1] * rstd);
          else {
#pragma unroll
            for (int n = 0; n < 2; ++n) {
              const f32x4 v = acc[ai][bj][m][n] * rstd; const int c0 = acc_col<PERM>(bj, wc, n, fq);
              u32x2 o; o.x = cvtpk2(v.x, v.y); o.y = cvtpk2(v.z, v.w); *(u32x2*)(dst + (size_t)row * ld + 256 * pn + c0) = o;
            }
          }
        }
      }
  }
};

template <bool PERM_> struct EpiF32 {
  static constexpr bool PERM = PERM_;
  float* dst; int ld;
  __device__ __forceinline__ void operator()(const f32x4 (&acc)[2][2][4][2], const pg8::Unit& u, int wr, int wc, int fr, int fq) const {
    const int pm = u.pm, pn = u.pn;
#pragma unroll
    for (int ai = 0; ai < 2; ++ai)
#pragma unroll
      for (int m = 0; m < 4; ++m) {
        const int row = 256 * pm + acc_row(ai, wr, m, fr);
#pragma unroll
        for (int bj = 0; bj < 2; ++bj)
#pragma unroll
          for (int n = 0; n < 2; ++n) *(f32x4*)(dst + (size_t)row * ld + 256 * pn + acc_col<PERM>(bj, wc, n, fq)) = acc[ai][bj][m][n];
      }
  }
};

template <bool PERM_> struct EpiBf16 {
  static constexpr bool PERM = PERM_;
  bf16_t* dst; int ld;
  __device__ __forceinline__ void operator()(const f32x4 (&acc)[2][2][4][2], const pg8::Unit& u, int wr, int wc, int fr, int fq) const {
    const int pm = u.pm, pn = u.pn;
#pragma unroll
    for (int ai = 0; ai < 2; ++ai)
#pragma unroll
      for (int m = 0; m < 4; ++m) {
        const int row = 256 * pm + acc_row(ai, wr, m, fr);
#pragma unroll
        for (int bj = 0; bj < 2; ++bj) {
          if (PERM) *(u32x4*)(dst + (size_t)row * ld + 256 * pn + acc_col<PERM>(bj, wc, 0, fq)) = pack8(acc[ai][bj][m][0], acc[ai][bj][m][1]);
          else {
#pragma unroll
            for (int n = 0; n < 2; ++n) { const f32x4 v = acc[ai][bj][m][n]; u32x2 o; o.x = cvtpk2(v.x, v.y); o.y = cvtpk2(v.z, v.w); *(u32x2*)(dst + (size_t)row * ld + 256 * pn + acc_col<PERM>(bj, wc, n, fq)) = o; }
          }
        }
      }
  }
};

template <bool PERM_> struct EpiSwiglu {
  static constexpr bool PERM = PERM_;
  bf16_t* act; float insc;
  __device__ __forceinline__ void operator()(const f32x4 (&acc)[2][2][4][2], const pg8::Unit& u, int wr, int wc, int fr, int fq) const {
    const int arow0 = 256 * u.pm, pn = u.pn;
#pragma unroll
    for (int ai = 0; ai < 2; ++ai)
#pragma unroll
      for (int m = 0; m < 4; ++m) {
        const int row = arow0 + acc_row(ai, wr, m, fr);
        f32x4 av[2];
#pragma unroll
        for (int n = 0; n < 2; ++n) {
          const f32x4 g = acc[ai][0][m][n] * insc, u = acc[ai][1][m][n] * insc; f32x4 a;
#define SWG(gv, uv) ((gv) * __builtin_amdgcn_rcpf(1.f + __builtin_amdgcn_exp2f(-1.4426950408889634f * (gv))) * (uv))
          a.x = SWG(g.x, u.x); a.y = SWG(g.y, u.y); a.z = SWG(g.z, u.z); a.w = SWG(g.w, u.w);
#undef SWG
          av[n] = a;
          if (!PERM) *(unsigned*)((unsigned char*)act + (size_t)row * 512 + 128 * pn + acc_col<PERM>(0, wc, n, fq)) = pack8_fp8(a, a).x;
        }
        if (PERM) *(u32x2*)((unsigned char*)act + (size_t)row * 512 + 128 * pn + acc_col<PERM>(0, wc, 0, fq)) = pack8_fp8(av[0], av[1]);
      }
  }
};

template <bool PERM_> struct EpiRowsFp8M {
  static constexpr bool PERM = PERM_;
  unsigned char* yp; float insc;
  __device__ __forceinline__ void operator()(const f32x4 (&acc)[2][2][4][2], const pg8::Unit& u, int wr, int wc, int fr, int fq) const {
    const int pn = u.pn;
#pragma unroll
    for (int ai = 0; ai < 2; ++ai)
#pragma unroll
      for (int m = 0; m < 4; ++m) {
        const size_t row = (size_t)256 * u.pm + acc_row(ai, wr, m, fr);
        const u32x2 lo = pack8_fp8(acc[ai][0][m][0] * insc, acc[ai][0][m][1] * insc), hi = pack8_fp8(acc[ai][1][m][0] * insc, acc[ai][1][m][1] * insc);
        *(u32x4*)(yp + row * 2048 + 256 * pn + 64 * wc + 16 * fq) = (u32x4){lo.x, lo.y, hi.x, hi.y};
      }
  }
};
template <bool PERM_> struct EpiRowsFp8 {
  static constexpr bool PERM = PERM_;
  unsigned char* yp; float insc;
  __device__ __forceinline__ void operator()(const f32x4 (&acc)[2][2][4][2], const pg8::Unit& u, int wr, int wc, int fr, int fq) const {
    const int pn = u.pn;
#pragma unroll
    for (int ai = 0; ai < 2; ++ai)
#pragma unroll
      for (int m = 0; m < 4; ++m) {
        const size_t row = (size_t)256 * u.pm + acc_row(ai, wr, m, fr);
#pragma unroll
        for (int bj = 0; bj < 2; ++bj) {
          if (PERM) *(u32x2*)(yp + row * 2048 + 256 * pn + acc_col<PERM>(bj, wc, 0, fq)) = pack8_fp8(acc[ai][bj][m][0] * insc, acc[ai][bj][m][1] * insc);
          else {
#pragma unroll
            for (int n = 0; n < 2; ++n) { const f32x4 v = acc[ai][bj][m][n] * insc; const u32x2 o = pack8_fp8(v, v); *(unsigned*)(yp + row * 2048 + 256 * pn + acc_col<PERM>(bj, wc, n, fq)) = o.x; }
          }
        }
      }
  }
};

__device__ __forceinline__ void rot8(u32x4& lo, u32x4& hi, const f32x4 (&cs)[4]) {
  unsigned* l = (unsigned*)&lo; unsigned* h = (unsigned*)&hi;
#pragma unroll
  for (int w = 0; w < 4; ++w) {
    const float ca = cs[w].x, sa = cs[w].y, cb = cs[w].z, sb = cs[w].w;
    const float x1a = bf_lo(l[w]), x1b = bf_hi(l[w]), x2a = bf_lo(h[w]), x2b = bf_hi(h[w]);
    l[w] = pk2(x1a * ca - x2a * sa, x1b * cb - x2b * sb);
    h[w] = pk2(x2a * ca + x1a * sa, x2b * cb + x1b * sb);
  }
}
__device__ __forceinline__ void rotary_rows(const Params& p) {
  const int tid = opaque_tid(), lane = tid & 63, wave = tid >> 6;
  const int gw = blockIdx.x * NWAVES + wave, NGW = gridDim.x * NWAVES;
  unsigned char* ws = p.ws;
  bf16_t* dq = (bf16_t*)(ws + R_DQ); bf16_t* dk = (bf16_t*)(ws + R_DK); bf16_t* kpe = (bf16_t*)(ws + R_KPE);
  const float* rd = (const float*)(ws + WS_ROPED); const float* rm = (const float*)(ws + WS_ROPEM);
  for (int it = gw; it < T / 2; it += NGW) {
    const int row = 2 * it + (lane >> 5), q = lane & 31, comp = q & 15;
    bf16_t* base = ((q >> 4) ? dk : dq) + (size_t)row * 1024 + comp * 64;
    u32x4 lo = *(const u32x4*)base, hi = *(const u32x4*)(base + 8);
    f32x4 cs[4];
#pragma unroll
    for (int w = 0; w < 4; ++w) cs[w] = *(const f32x4*)(rd + (size_t)row * 16 + 4 * w);
    rot8(lo, hi, cs);
    *(u32x4*)base = lo; *(u32x4*)(base + 8) = hi;
  }
  for (int it = gw; it < T / 16; it += NGW) {
    const int row = 16 * it + (lane >> 2), l4 = lane & 3;
    bf16_t* base = kpe + (size_t)row * 64 + 8 * l4;
    u32x4 lo = *(const u32x4*)base, hi = *(const u32x4*)(base + 32);
    f32x4 cs[4];
#pragma unroll
    for (int w = 0; w < 4; ++w) cs[w] = *(const f32x4*)(rm + (size_t)row * 64 + 16 * l4 + 4 * w);
    rot8(lo, hi, cs);
    *(u32x4*)base = lo; *(u32x4*)(base + 32) = hi;
  }
}

__device__ __forceinline__ void attn_mla_naive(const Params& p, int h, int ci, int vq, int lane) {
  unsigned char* ws = p.ws;
  const bf16_t* qm = (const bf16_t*)(ws + R_QM); const bf16_t* kvm = (const bf16_t*)(ws + R_KVM); const bf16_t* kpe = (const bf16_t*)(ws + R_KPE);
  const f32x2* rm = (const f32x2*)(ws + WS_ROPEM);
  const int t = 64 * ci + lane;
  unsigned qn[64], qp[32];
  { const u32x4* q4 = (const u32x4*)(qm + (size_t)t * NQ + 192 * h);
#pragma unroll
    for (int i = 0; i < 16; ++i) { const u32x4 v = q4[i]; qn[4 * i] = v.x; qn[4 * i + 1] = v.y; qn[4 * i + 2] = v.z; qn[4 * i + 3] = v.w; }
#pragma unroll
    for (int i = 0; i < 8; ++i) { const u32x4 v = q4[16 + i]; qp[4 * i] = v.x; qp[4 * i + 1] = v.y; qp[4 * i + 2] = v.z; qp[4 * i + 3] = v.w; }
#pragma unroll
    for (int w = 0; w < 16; ++w) {
      const f32x2 c0 = rm[t * 32 + 2 * w], c1 = rm[t * 32 + 2 * w + 1];
      const float a0 = bf_lo(qp[w]), a1 = bf_hi(qp[w]), b0 = bf_lo(qp[w + 16]), b1 = bf_hi(qp[w + 16]);
      qp[w] = pk2(a0 * c0.x - b0 * c0.y, a1 * c1.x - b1 * c1.y);
      qp[w + 16] = pk2(b0 * c0.x + a0 * c0.y, b1 * c1.x + a1 * c1.y);
    }
  }
  const float scale = 0.07216878364870322f;
  float mx = -INFINITY, l = 0.f, o[32];
#pragma unroll
  for (int j = 0; j < 32; ++j) o[j] = 0.f;
  const int nk = 64 * (ci + 1);
  for (int key = 0; key < nk; ++key) {
    const u32x4* k4 = (const u32x4*)(kvm + (size_t)key * NKV + 256 * h);
    const u32x4* p4 = (const u32x4*)(kpe + (size_t)key * 64);
    float s = 0.f;
#pragma unroll
    for (int i = 0; i < 16; ++i) { const u32x4 v = k4[i]; s = dot2bf(qn[4 * i], v.x, s); s = dot2bf(qn[4 * i + 1], v.y, s); s = dot2bf(qn[4 * i + 2], v.z, s); s = dot2bf(qn[4 * i + 3], v.w, s); }
#pragma unroll
    for (int i = 0; i < 8; ++i) { const u32x4 v = p4[i]; s = dot2bf(qp[4 * i], v.x, s); s = dot2bf(qp[4 * i + 1], v.y, s); s = dot2bf(qp[4 * i + 2], v.z, s); s = dot2bf(qp[4 * i + 3], v.w, s); }
    s *= scale;
    if (s > mx) { const float f = __expf(mx - s); l *= f;
#pragma unroll
      for (int j = 0; j < 32; ++j) o[j] *= f;
      mx = s; }
    const float pe = __expf(s - mx); l += pe;
    const u32x4* v4 = (const u32x4*)(kvm + (size_t)key * NKV + 256 * h + 128 + 32 * vq);
#pragma unroll
    for (int i = 0; i < 4; ++i) { const u32x4 v = v4[i];
      o[8 * i] += pe * bf_lo(v.x); o[8 * i + 1] += pe * bf_hi(v.x); o[8 * i + 2] += pe * bf_lo(v.y); o[8 * i + 3] += pe * bf_hi(v.y);
      o[8 * i + 4] += pe * bf_lo(v.z); o[8 * i + 5] += pe * bf_hi(v.z); o[8 * i + 6] += pe * bf_lo(v.w); o[8 * i + 7] += pe * bf_hi(v.w); }
  }
  const float il = 1.0f / l;
  bf16_t* oa = (bf16_t*)(ws + R_OATT) + (size_t)t * 2048 + 128 * h + 32 * vq;
#pragma unroll
  for (int i = 0; i < 4; ++i) { u32x4 w; w.x = pk2(o[8 * i] * il, o[8 * i + 1] * il); w.y = pk2(o[8 * i + 2] * il, o[8 * i + 3] * il); w.z = pk2(o[8 * i + 4] * il, o[8 * i + 5] * il); w.w = pk2(o[8 * i + 6] * il, o[8 * i + 7] * il);
    ((u32x4*)oa)[i] = w; }
}
__device__ __forceinline__ void attn_diff_naive(const Params& p, int h, int c, int ci, int vh, int lane) {
  unsigned char* ws = p.ws;
  const bf16_t* dq = (const bf16_t*)(ws + R_DQ); const bf16_t* dk = (const bf16_t*)(ws + R_DK); const bf16_t* dv = (const bf16_t*)(ws + R_DV);
  const int t = 64 * ci + lane;
  unsigned q[32];
  { const u32x4* q4 = (const u32x4*)(dq + (size_t)t * 1024 + 128 * h + 64 * c);
#pragma unroll
    for (int i = 0; i < 8; ++i) { const u32x4 v = q4[i]; q[4 * i] = v.x; q[4 * i + 1] = v.y; q[4 * i + 2] = v.z; q[4 * i + 3] = v.w; } }
  const float scale = 0.125f;
  float mx = -INFINITY, l = 0.f, o[64];
#pragma unroll
  for (int j = 0; j < 64; ++j) o[j] = 0.f;
  const int nk = 64 * (ci + 1);
  for (int key = 0; key < nk; ++key) {
    const u32x4* k4 = (const u32x4*)(dk + (size_t)key * 1024 + 128 * h + 64 * c);
    float s = 0.f;
#pragma unroll
    for (int i = 0; i < 8; ++i) { const u32x4 v = k4[i]; s = dot2bf(q[4 * i], v.x, s); s = dot2bf(q[4 * i + 1], v.y, s); s = dot2bf(q[4 * i + 2], v.z, s); s = dot2bf(q[4 * i + 3], v.w, s); }
    s *= scale;
    if (s > mx) { const float f = __expf(mx - s); l *= f;
#pragma unroll
      for (int j = 0; j < 64; ++j) o[j] *= f;
      mx = s; }
    const float pe = __expf(s - mx); l += pe;
    const u32x4* v4 = (const u32x4*)(dv + (size_t)key * 1024 + 128 * h + 64 * vh);
#pragma unroll
    for (int i = 0; i < 8; ++i) { const u32x4 v = v4[i];
      o[8 * i] += pe * bf_lo(v.x); o[8 * i + 1] += pe * bf_hi(v.x); o[8 * i + 2] += pe * bf_lo(v.y); o[8 * i + 3] += pe * bf_hi(v.y);
      o[8 * i + 4] += pe * bf_lo(v.z); o[8 * i + 5] += pe * bf_hi(v.z); o[8 * i + 6] += pe * bf_lo(v.w); o[8 * i + 7] += pe * bf_hi(v.w); }
  }
  const float il = 1.0f / l;
  float* oc = (float*)(ws + R_OC) + (size_t)c * T * 1024 + (size_t)t * 1024 + 128 * h + 64 * vh;
#pragma unroll
  for (int i = 0; i < 16; ++i) ((f32x4*)oc)[i] = (f32x4){o[4 * i] * il, o[4 * i + 1] * il, o[4 * i + 2] * il, o[4 * i + 3] * il};
}
__device__ __forceinline__ void phase3_naive(const Params& p) {
  const int tid = opaque_tid(), lane = tid & 63, wave = tid >> 6;
  const int gw = blockIdx.x * NWAVES + wave, NGW = gridDim.x * NWAVES;
  for (int u = gw; u < 4096; u += NGW) {
    const int uu = (u < 2048) ? u : (6143 - u);
    const int ci = uu & 127, hv = uu >> 7;
    attn_mla_naive(p, hv >> 2, ci, hv & 3, lane);
  }
  for (int u = gw; u < 4096; u += NGW) {
    const int uu = (u < 2048) ? u : (6143 - u);
    const int ci = uu & 127, r = uu >> 7;
    attn_diff_naive(p, r >> 2, (r >> 1) & 1, ci, r & 1, lane);
  }
}
__device__ __forceinline__ void phase3b_naive(const Params& p) {
  const int tid = opaque_tid(), lane = tid & 63, wave = tid >> 6;
  const int gw = blockIdx.x * NWAVES + wave, NGW = gridDim.x * NWAVES;
  unsigned char* ws = p.ws;
  const float lam = ((const float*)(ws + WS_MOD))[16384];
  const float* oc0 = (const float*)(ws + R_OC); const float* oc1 = oc0 + (size_t)T * 1024;
  const float* gsub = p.in[14];
  bf16_t* oa = (bf16_t*)(ws + R_OATT);
  for (int it = gw; it < T * 8; it += NGW) {
    const int t = it >> 3, h = it & 7;
    const size_t off = (size_t)t * 1024 + 128 * h + 2 * lane;
    const f32x2 a = *(const f32x2*)(oc0 + off), b = *(const f32x2*)(oc1 + off);
    const float v0 = a.x - lam * b.x, v1 = a.y - lam * b.y;
    const float rstd = 1.0f / sqrtf(wave_sum(v0 * v0 + v1 * v1) * (1.0f / 128.0f) + EPS);
    const f32x2 g = *(const f32x2*)(gsub + 2 * lane);
    *(unsigned*)(oa + (size_t)t * 2048 + 1024 + 128 * h + 2 * lane) = pk2(v0 * rstd * g.x * 0.8f, v1 * rstd * g.y * 0.8f);
  }
}


namespace fa {
typedef float f32x16 __attribute__((ext_vector_type(16)));
typedef short v4i16_t __attribute__((ext_vector_type(4)));
constexpr int VBYTES = 16384, WSF_OFF = 122880;
constexpr float THR = 8.0f;
__device__ __forceinline__ int crow(int r, int hi) { return (r & 3) + 8 * (r >> 2) + 4 * hi; }
__device__ __forceinline__ unsigned cvtpk(float lo, float hi) { f32x2 v = {lo, hi}; bf16x2_t b = __builtin_convertvector(v, bf16x2_t); return __builtin_bit_cast(unsigned, b); }
__device__ __forceinline__ void glds16(const void* gsrc, unsigned lds_dst) { unsigned keep;
  asm volatile("s_mov_b32 %0, m0\n\ts_mov_b32 m0, %2\n\ts_nop 0\n\tglobal_load_lds_dwordx4 %1, off\n\ts_mov_b32 m0, %0" : "=&s"(keep) : "v"(gsrc), "s"(lds_dst) : "memory"); }
__device__ __forceinline__ float max3f(float a, float b, float c) { float r; asm("v_max3_f32 %0, %1, %2, %3" : "=v"(r) : "v"(a), "v"(b), "v"(c)); return r; }
__device__ __forceinline__ float max2f(float a, float b) { float r; asm("v_max_f32_e32 %0, %1, %2" : "=v"(r) : "v"(a), "v"(b)); return r; }
__device__ __forceinline__ float fadd_s(float a, float b) { float r; asm("v_add_f32_e32 %0, %1, %2" : "=v"(r) : "v"(a), "v"(b)); return r; }
struct Src { const char* kb0; unsigned kp0; const char* kb1; unsigned kp1; const char* vb; unsigned vp; };

template <int NKC  >
__device__ __forceinline__ void attn_pass(LAS unsigned char* lds, const Src& S, const bf16x8* qf, const float qscale, const int NT, const int NTW, f32x16 (&o)[4], float& l_out) {
  constexpr int NKS = NKC * 4, KBYTES = NKC * 8192, STAGE = KBYTES + VBYTES;
  const int tid = opaque_tid(), lane = tid & 63, wid = __builtin_amdgcn_readfirstlane(tid >> 6), r32 = lane & 31, hi = lane >> 5;
  unsigned koff[NKC], voff[2]; unsigned kdst[NKC], vdst[2];
#pragma unroll
  for (int i = 0; i < NKC; ++i) {
    if (NKC == 3 && i == 2) { koff[i] = (unsigned)lane * S.kp1 + (unsigned)wid * 16u; kdst[i] = (unsigned)(16 + wid) * 1024u; }
    else { koff[i] = (unsigned)lane * S.kp0 + (unsigned)(wid + 8 * i) * 16u; kdst[i] = (unsigned)(wid + 8 * i) * 1024u; }
  }
#pragma unroll
  for (int i = 0; i < 2; ++i) { const int ii = 2 * wid + i, b = ii >> 2, kg = ii & 3; voff[i] = (unsigned)(16 * kg + (lane >> 2)) * S.vp + (unsigned)(32 * b + 8 * (lane & 3)) * 2u; vdst[i] = (unsigned)KBYTES + (unsigned)b * 4096u + (unsigned)kg * 1024u; }
#define FA_ISSUE(j, st) do { const size_t _j = (size_t)(j) * 64; const unsigned _so = (unsigned)(st) * STAGE; \
    _Pragma("unroll") for (int _i = 0; _i < NKC; ++_i) { const char* _b = (NKC == 3 && _i == 2) ? S.kb1 + _j * S.kp1 : S.kb0 + _j * S.kp0; \
      __builtin_amdgcn_global_load_lds((const unsigned*)(_b + koff[_i]), (LAS unsigned*)(lds + _so + kdst[_i]), 16, 0, 0); } \
    _Pragma("unroll") for (int _i = 0; _i < 2; ++_i) __builtin_amdgcn_global_load_lds((const unsigned*)(S.vb + _j * S.vp + voff[_i]), (LAS unsigned*)(lds + _so + vdst[_i]), 16, 0, 0); } while (0)
  LAS float* wsf = (LAS float*)(lds + WSF_OFF) + wid * 64;
  float m_ref = -INFINITY, l_part = 0.f;
#pragma unroll
  for (int b = 0; b < 4; ++b)
#pragma unroll
    for (int r = 0; r < 16; ++r) o[b][r] = 0.f;
  const unsigned kread = (unsigned)hi * 1024u + (unsigned)r32 * 16u;
  const unsigned vread = (unsigned)KBYTES + (unsigned)(((lane >> 4) & 1) * 32 + (lane & 3) * 8 + (4 * hi + ((lane & 15) >> 2)) * 64);
  FA_ISSUE(0, 0);
  if (NT > 1) FA_ISSUE(1, 1);
  int st = 0;
  for (int j = 0; j < NT; ++j) {
    if (j + 1 < NT) { if (NKC == 3) asm volatile("s_waitcnt vmcnt(5)" ::: "memory"); else asm volatile("s_waitcnt vmcnt(3)" ::: "memory"); }
    else asm volatile("s_waitcnt vmcnt(0)" ::: "memory");
    asm volatile("s_waitcnt lgkmcnt(0)\n\ts_barrier" ::: "memory");
    if (j + 2 < NT) { const int st2 = (st + 2 >= 3) ? st - 1 : st + 2; FA_ISSUE(j + 2, st2); }
    if (j < NTW) {
      const LAS unsigned char* kb = lds + (unsigned)st * STAGE + kread;
      f32x16 p0, p1;
#pragma unroll
      for (int r = 0; r < 16; ++r) { p0[r] = 0.f; p1[r] = 0.f; }
#pragma unroll
      for (int d0 = 0; d0 < NKS; ++d0) {
        const bf16x8 k0 = *(const LAS bf16x8*)(kb + d0 * 2048);
        const bf16x8 k1 = *(const LAS bf16x8*)(kb + d0 * 2048 + 512);
        p0 = __builtin_amdgcn_mfma_f32_32x32x16_bf16(k0, qf[d0], p0, 0, 0, 0);
        p1 = __builtin_amdgcn_mfma_f32_32x32x16_bf16(k1, qf[d0], p1, 0, 0, 0);
      }
      float rm = __builtin_fmaxf(p0[0], p1[0]);
#pragma unroll
      for (int r = 1; r < 16; ++r) rm = __builtin_fmaxf(rm, __builtin_fmaxf(p0[r], p1[r]));
      { auto rr = __builtin_amdgcn_permlane32_swap(__float_as_uint(rm), __float_as_uint(rm), false, false); rm = __builtin_fmaxf(__uint_as_float(rr[0]), __uint_as_float(rr[1])); }
      rm *= qscale;
      if (__any(rm > m_ref + THR)) {
        const float m_new = __builtin_fmaxf(m_ref, rm);
        const float alpha = __builtin_amdgcn_exp2f(m_ref - m_new);
        l_part *= alpha; m_ref = m_new;
        if (hi == 0) wsf[r32] = alpha;
        asm volatile("s_waitcnt lgkmcnt(0)" ::: "memory");
#pragma unroll
        for (int r = 0; r < 16; ++r) { const float a = wsf[crow(r, hi)];
#pragma unroll
          for (int b = 0; b < 4; ++b) o[b][r] *= a; }
      }
      float ls = 0.f;
#pragma unroll
      for (int r = 0; r < 16; ++r) { p0[r] = __builtin_amdgcn_exp2f(p0[r] * qscale - m_ref); p1[r] = __builtin_amdgcn_exp2f(p1[r] * qscale - m_ref); ls += p0[r] + p1[r]; }
      l_part += ls;
      u32x4 pw[4];
      pw[0] = (u32x4){cvtpk(p0[0], p0[1]), cvtpk(p0[2], p0[3]), cvtpk(p0[4], p0[5]), cvtpk(p0[6], p0[7])};
      pw[1] = (u32x4){cvtpk(p0[8], p0[9]), cvtpk(p0[10], p0[11]), cvtpk(p0[12], p0[13]), cvtpk(p0[14], p0[15])};
      pw[2] = (u32x4){cvtpk(p1[0], p1[1]), cvtpk(p1[2], p1[3]), cvtpk(p1[4], p1[5]), cvtpk(p1[6], p1[7])};
      pw[3] = (u32x4){cvtpk(p1[8], p1[9]), cvtpk(p1[10], p1[11]), cvtpk(p1[12], p1[13]), cvtpk(p1[14], p1[15])};
      const LAS unsigned char* vbp = lds + (unsigned)st * STAGE + vread;
#pragma unroll
      for (int ks = 0; ks < 4; ++ks)
#pragma unroll
        for (int b = 0; b < 4; ++b) {
          const v4i16_t lo = __builtin_amdgcn_ds_read_tr16_b64_v4i16((LAS v4i16_t*)(vbp + b * 4096 + ks * 1024));
          const v4i16_t hh = __builtin_amdgcn_ds_read_tr16_b64_v4i16((LAS v4i16_t*)(vbp + b * 4096 + ks * 1024 + 512));
          const bf16x8 vf = (bf16x8){lo[0], lo[1], lo[2], lo[3], hh[0], hh[1], hh[2], hh[3]};
          o[b] = __builtin_amdgcn_mfma_f32_32x32x16_bf16(__builtin_bit_cast(bf16x8, pw[ks]), vf, o[b], 0, 0, 0);
        }
    }
    st = (st == 2) ? 0 : st + 1;
  }
  asm volatile("s_waitcnt lgkmcnt(0)\n\ts_barrier" ::: "memory");
  { auto rr = __builtin_amdgcn_permlane32_swap(__float_as_uint(l_part), __float_as_uint(l_part), false, false); l_out = __uint_as_float(rr[0]) + __uint_as_float(rr[1]); }
#undef FA_ISSUE
}


template <int NKC>
__device__ __forceinline__ void attn_pass3(LAS unsigned char* lds, const Src& S, const bf16x8* qf, const float qscale, const int NT, const int NTW, f32x16 (&o)[4], float& l_out) {
  constexpr int NKS = NKC * 4, KBYTES = NKC * 8192, STAGE = KBYTES + VBYTES;
  const int tid = opaque_tid(), lane = tid & 63, wid = __builtin_amdgcn_readfirstlane(tid >> 6), r32 = lane & 31, hi = lane >> 5;
  unsigned koff[NKC], voff[2]; unsigned kdst[NKC], vdst[2];
#pragma unroll
  for (int i = 0; i < NKC; ++i) {
    if (NKC == 3 && i < 2) { const int pi = wid + 8 * i, row = 4 * pi + (lane >> 4); koff[i] = (unsigned)row * S.kp0 + (unsigned)(((lane & 15) ^ (row & 15)) * 16); kdst[i] = (unsigned)pi * 1024u; }
    else { const int row = 8 * wid + (lane >> 3); const unsigned kp = (NKC == 3) ? S.kp1 : S.kp0; koff[i] = (unsigned)row * kp + (unsigned)(((lane & 7) ^ ((row >> 1) & 7)) * 16); kdst[i] = (NKC == 3 ? 16384u : 0u) + (unsigned)wid * 1024u; }
  }
#pragma unroll
  for (int i = 0; i < 2; ++i) { const int ii = 2 * wid + i, b = ii >> 2, kg = ii & 3; voff[i] = (unsigned)(16 * kg + (lane >> 2)) * S.vp + (unsigned)(32 * b + 8 * (lane & 3)) * 2u; vdst[i] = (unsigned)KBYTES + (unsigned)b * 4096u + (unsigned)kg * 1024u; }
#define FA_ISSUE(j, st) do { const size_t _j = (size_t)(j) * 64; const unsigned _so = lds0 + (unsigned)(st) * STAGE; \
    _Pragma("unroll") for (int _i = 0; _i < NKC; ++_i) { const char* _b = (NKC == 3 && _i == 2) ? S.kb1 + _j * S.kp1 : S.kb0 + _j * S.kp0; \
      glds16(_b + koff[_i], (unsigned)__builtin_amdgcn_readfirstlane(_so + kdst[_i])); } \
    _Pragma("unroll") for (int _i = 0; _i < 2; ++_i) glds16(S.vb + _j * S.vp + voff[_i], (unsigned)__builtin_amdgcn_readfirstlane(_so + vdst[_i])); } while (0)
#define FA_EXP8(P, base, PW) do { float _e[8]; _Pragma("unroll") for (int _i = 0; _i < 8; ++_i) { _e[_i] = __builtin_amdgcn_exp2f(P[(base) + _i]); } \
      l_part = fadd_s(l_part, fadd_s(fadd_s(fadd_s(_e[0], _e[1]), fadd_s(_e[2], _e[3])), fadd_s(fadd_s(_e[4], _e[5]), fadd_s(_e[6], _e[7])))); \
      PW = (u32x4){cvtpk(_e[0], _e[1]), cvtpk(_e[2], _e[3]), cvtpk(_e[4], _e[5]), cvtpk(_e[6], _e[7])}; } while (0)
#define FA_VRD1(L, H, va, off) asm volatile("ds_read_b64_tr_b16 %0, %2 offset:%c3\n\tds_read_b64_tr_b16 %1, %2 offset:%c4" : "=&v"(L), "=&v"(H) : "v"(va), "i"(off), "i"((off) + 512) : "memory")
#define FA_VRD8(VL, VH, va, ks0) do { _Pragma("unroll") for (int _b = 0; _b < 4; ++_b) { FA_VRD1(VL[_b], VH[_b], va, _b * 4096 + (ks0) * 1024); } \
      _Pragma("unroll") for (int _b = 0; _b < 4; ++_b) { FA_VRD1(VL[4 + _b], VH[4 + _b], va, _b * 4096 + ((ks0) + 1) * 1024); } } while (0)
#define FA_FRAG(VL, VH, i) (bf16x8){VL[i][0], VL[i][1], VL[i][2], VL[i][3], VH[i][0], VH[i][1], VH[i][2], VH[i][3]}
#define FA_PV8(PWA, PWB, VL, VH) do { _Pragma("unroll") for (int _b = 0; _b < 4; ++_b) o[_b] = __builtin_amdgcn_mfma_f32_32x32x16_bf16(__builtin_bit_cast(bf16x8, PWA), FA_FRAG(VL, VH, _b), o[_b], 0, 0, 0); \
      _Pragma("unroll") for (int _b = 0; _b < 4; ++_b) o[_b] = __builtin_amdgcn_mfma_f32_32x32x16_bf16(__builtin_bit_cast(bf16x8, PWB), FA_FRAG(VL, VH, 4 + _b), o[_b], 0, 0, 0); } while (0)
#define FA_PV(PW, vbp, ks) do { _Pragma("unroll") for (int _b = 0; _b < 4; ++_b) { \
      const v4i16_t lo = __builtin_amdgcn_ds_read_tr16_b64_v4i16((LAS v4i16_t*)((vbp) + _b * 4096 + (ks) * 1024)); \
      const v4i16_t hh = __builtin_amdgcn_ds_read_tr16_b64_v4i16((LAS v4i16_t*)((vbp) + _b * 4096 + (ks) * 1024 + 512)); \
      const bf16x8 vf = (bf16x8){lo[0], lo[1], lo[2], lo[3], hh[0], hh[1], hh[2], hh[3]}; \
      o[_b] = __builtin_amdgcn_mfma_f32_32x32x16_bf16(__builtin_bit_cast(bf16x8, PW), vf, o[_b], 0, 0, 0); } } while (0)
  const unsigned lds0 = (unsigned)(uintptr_t)lds;
  LAS float* wsf = (LAS float*)(lds + WSF_OFF) + wid * 64;
  float m_ref = 0.f, l_part = 0.f;
  f32x16 negm;
#pragma unroll
  for (int r = 0; r < 16; ++r) negm[r] = 0.f;
#pragma unroll
  for (int b = 0; b < 4; ++b)
#pragma unroll
    for (int r = 0; r < 16; ++r) o[b][r] = 0.f;
  const unsigned kread_n = (unsigned)r32 * 256u + (unsigned)(((r32 & 15) ^ hi) * 16);
  const unsigned kread_p = (NKC == 3 ? 16384u : 0u) + (unsigned)r32 * 128u + (unsigned)((((r32 >> 1) & 7) ^ hi) * 16);
  const unsigned vread = (unsigned)KBYTES + (unsigned)(((lane >> 4) & 1) * 32 + (lane & 3) * 8 + (4 * hi + ((lane & 15) >> 2)) * 64);
  constexpr int NST = (NKC == 1) ? 4 : 3;
  FA_ISSUE(0, 0);
  if (NT > 1) FA_ISSUE(1, 1);
  if (NST == 4 && NT > 2) FA_ISSUE(2, 2);
  int st = 0;
  for (int j = 0; j < NT; ++j) {
    if (NST == 4) { if (j + 2 < NT) asm volatile("s_waitcnt vmcnt(6)" ::: "memory"); else if (j + 1 < NT) asm volatile("s_waitcnt vmcnt(3)" ::: "memory"); else asm volatile("s_waitcnt vmcnt(0)" ::: "memory"); }
    else { if (j + 1 < NT) asm volatile("s_waitcnt vmcnt(5)" ::: "memory"); else asm volatile("s_waitcnt vmcnt(0)" ::: "memory"); }
    asm volatile("s_waitcnt lgkmcnt(0)\n\ts_barrier" ::: "memory");
    if (j + NST - 1 < NT) { const int st2 = (st == 0) ? NST - 1 : st - 1; FA_ISSUE(j + NST - 1, st2); }
    if (j < NTW) {
      const unsigned ksb = (unsigned)st * STAGE;
      f32x16 p0, p1;
#pragma unroll
      for (int d0 = 0; d0 < NKS; ++d0) {
        const bool nope = (NKC == 3) && d0 < 8;
        const unsigned ka = ksb + (nope ? (kread_n ^ (unsigned)(d0 * 32)) : (kread_p ^ (unsigned)((NKC == 3 ? d0 - 8 : d0) * 32)));
        const bf16x8 k0 = *(const LAS bf16x8*)(lds + ka);
        const bf16x8 k1 = *(const LAS bf16x8*)(lds + ka + (nope ? 8192u : 4096u));
        if (d0 == 0) { p0 = __builtin_amdgcn_mfma_f32_32x32x16_bf16(k0, qf[d0], negm, 0, 0, 0); p1 = __builtin_amdgcn_mfma_f32_32x32x16_bf16(k1, qf[d0], negm, 0, 0, 0); }
        else { p0 = __builtin_amdgcn_mfma_f32_32x32x16_bf16(k0, qf[d0], p0, 0, 0, 0); p1 = __builtin_amdgcn_mfma_f32_32x32x16_bf16(k1, qf[d0], p1, 0, 0, 0); }
      }
      __builtin_amdgcn_sched_group_barrier(0x100, 4, 0);
#pragma unroll
      for (int d0 = 0; d0 < NKS - 2; ++d0) { __builtin_amdgcn_sched_group_barrier(0x008, 2, 0); __builtin_amdgcn_sched_group_barrier(0x100, 2, 0); }
      __builtin_amdgcn_sched_group_barrier(0x008, 4, 0);
      __builtin_amdgcn_sched_barrier(0);
      asm volatile("s_nop 15\n\ts_nop 7" : "+v"(p0), "+v"(p1));
      float rm;
      { float a = max3f(p0[0], p0[1], p1[0]), b = max3f(p0[2], p0[3], p1[1]); a = max3f(a, p1[2], p1[3]);
#pragma unroll
        for (int r = 4; r < 16; r += 4) { a = max3f(a, p0[r], p0[r + 1]); b = max3f(b, p0[r + 2], p0[r + 3]); a = max3f(a, p1[r], p1[r + 1]); b = max3f(b, p1[r + 2], p1[r + 3]); }
        rm = max2f(a, b);
        auto rr = __builtin_amdgcn_permlane32_swap(__float_as_uint(rm), __float_as_uint(rm), false, false); rm = max2f(__uint_as_float(rr[0]), __uint_as_float(rr[1])); }
      if (__builtin_expect(j == 0 || __any(rm > THR), 0)) {
        const float dl = (j == 0) ? rm : __builtin_fmaxf(rm, 0.f);
        m_ref += dl;
#pragma unroll
        for (int r = 0; r < 16; ++r) { p0[r] -= dl; p1[r] -= dl; negm[r] = -m_ref; }
        const float alpha = __builtin_amdgcn_exp2f(-dl);
        l_part *= alpha;
        if (hi == 0) wsf[r32] = alpha;
        asm volatile("s_waitcnt lgkmcnt(0)" ::: "memory");
#pragma unroll
        for (int r = 0; r < 16; ++r) { const float a = wsf[crow(r, hi)];
#pragma unroll
          for (int b = 0; b < 4; ++b) o[b][r] *= a; }
      }
      const unsigned vaddr = lds0 + (unsigned)st * STAGE + vread;
      u32x4 pw0, pw1, pw2, pw3;
      if constexpr (NKC == 1) {
        v4i16_t vl[8], vh[8], wl[8], wh[8];
        FA_VRD8(vl, vh, vaddr, 0);
        FA_EXP8(p0, 0, pw0); FA_EXP8(p0, 8, pw1);
        asm volatile("s_waitcnt lgkmcnt(0)" ::: "memory"); __builtin_amdgcn_sched_barrier(0);
        FA_VRD8(wl, wh, vaddr, 2);
        __builtin_amdgcn_sched_barrier(0);
        FA_PV8(pw0, pw1, vl, vh);
        FA_EXP8(p1, 0, pw2); FA_EXP8(p1, 8, pw3);
#pragma unroll
        for (int q = 0; q < 8; ++q) { __builtin_amdgcn_sched_group_barrier(0x008, 1, 4); __builtin_amdgcn_sched_group_barrier(0x402, 6, 4); }
        asm volatile("s_waitcnt lgkmcnt(0)" ::: "memory"); __builtin_amdgcn_sched_barrier(0);
        FA_PV8(pw2, pw3, wl, wh);
        __builtin_amdgcn_sched_barrier(0);
      } else
      { v4i16_t vl[8], vh[8];
        FA_VRD8(vl, vh, vaddr, 0);
        FA_EXP8(p0, 0, pw0); FA_EXP8(p0, 8, pw1);
        asm volatile("s_waitcnt lgkmcnt(0)" ::: "memory"); __builtin_amdgcn_sched_barrier(0);
        FA_PV8(pw0, pw1, vl, vh);
        __builtin_amdgcn_sched_barrier(0);
        FA_VRD8(vl, vh, vaddr, 2);
        FA_EXP8(p1, 0, pw2); FA_EXP8(p1, 8, pw3);
        asm volatile("s_waitcnt lgkmcnt(0)" ::: "memory"); __builtin_amdgcn_sched_barrier(0);
        FA_PV8(pw2, pw3, vl, vh);
        __builtin_amdgcn_sched_barrier(0);
      }
    }
    st = (st == NST - 1) ? 0 : st + 1;
  }
  asm volatile("s_waitcnt lgkmcnt(0)\n\ts_barrier" ::: "memory");
  { auto rr = __builtin_amdgcn_permlane32_swap(__float_as_uint(l_part), __float_as_uint(l_part), false, false); l_out = __uint_as_float(rr[0]) + __uint_as_float(rr[1]); }
#undef FA_ISSUE
#undef FA_EXP8
#undef FA_PV
#undef FA_VRD1
#undef FA_VRD8
#undef FA_FRAG
#undef FA_PV8
}

__device__ __forceinline__ void row_bcast(LAS float* wsf, float v, int r32, int hi, float (&out)[16]) {
  asm volatile("s_waitcnt lgkmcnt(0)" ::: "memory");
  if (hi == 0) wsf[r32] = v;
  asm volatile("s_waitcnt lgkmcnt(0)" ::: "memory");
#pragma unroll
  for (int r = 0; r < 16; ++r) out[r] = wsf[crow(r, hi)];
  asm volatile("s_waitcnt lgkmcnt(0)" ::: "memory");
}

__device__ __forceinline__ void mla_unit(const Params& p, LAS unsigned char* lds, int h, int qb) {
  unsigned char* ws = p.ws;
  const int tid = opaque_tid(), lane = tid & 63, wid = __builtin_amdgcn_readfirstlane(tid >> 6), r32 = lane & 31, hi = lane >> 5;
  const int t = 256 * qb + 32 * wid + r32;
  bf16x8 qf[12];
  { const bf16_t* q = (const bf16_t*)(ws + R_QM) + (size_t)t * NQ + 192 * h + 8 * hi;
#pragma unroll
    for (int d0 = 0; d0 < 12; ++d0) qf[d0] = *(const bf16x8*)(q + 16 * d0);
    const f32x2* rm = (const f32x2*)(ws + WS_ROPEM) + (size_t)t * 32;
#pragma unroll
    for (int s = 8; s < 10; ++s) {
      bf16x8 a = qf[s], b = qf[s + 2];
#pragma unroll
      for (int j = 0; j < 8; ++j) { const f32x2 cs = rm[16 * (s - 8) + 8 * hi + j];
        const float x1 = bf1((bf16_t)a[j]), x2 = bf1((bf16_t)b[j]);
        a[j] = (short)f2bf(x1 * cs.x - x2 * cs.y); b[j] = (short)f2bf(x2 * cs.x + x1 * cs.y); }
      qf[s] = a; qf[s + 2] = b;
    }
  }
  asm volatile("s_waitcnt vmcnt(0)" ::: "memory");
#pragma unroll
  for (int d0 = 0; d0 < 12; ++d0) asm volatile("" : "+v"(qf[d0]));
  Src S; S.kb0 = (const char*)(ws + R_KVM) + 256 * h * 2; S.kp0 = NKV * 2; S.kb1 = (const char*)(ws + R_KPE); S.kp1 = 128; S.vb = (const char*)(ws + R_KVM) + (256 * h + 128) * 2; S.vp = NKV * 2;
  f32x16 o[4]; float l;
  attn_pass3<3>(lds, S, qf, 1.0f, 4 * qb + 4, 4 * qb + 1 + (wid >> 1), o, l);
  LAS float* wsf = (LAS float*)(lds + WSF_OFF) + wid * 64;
  float il[16]; row_bcast(wsf, 1.0f / l, r32, hi, il);
  char* ob = (char*)((bf16_t*)(ws + R_OATT) + (size_t)(256 * qb + 32 * wid) * 2048 + 128 * h);
  const unsigned lo = (unsigned)(4 * hi * 2048 + r32) * 2u;
#pragma unroll
  for (int r = 0; r < 16; ++r)
#pragma unroll
    for (int b = 0; b < 4; ++b) *(bf16_t*)(ob + lo + (unsigned)((((r & 3) + 8 * (r >> 2)) * 2048 + 32 * b) * 2)) = (bf16_t)f2bf(o[b][r] * il[r]);
}

template <int C>
__device__ __forceinline__ void diff_comp(const Params& p, LAS unsigned char* lds, int h, int qb, f32x16 (&oacc)[4]) {
  unsigned char* ws = p.ws;
  const int tid = opaque_tid(), lane = tid & 63, wid = __builtin_amdgcn_readfirstlane(tid >> 6), r32 = lane & 31, hi = lane >> 5;
  const int t = 256 * qb + 32 * wid + r32;
  LAS float* wsf = (LAS float*)(lds + WSF_OFF) + wid * 64;
  bf16x8 qf[4];
  { const bf16_t* q = (const bf16_t*)(ws + R_DQ) + (size_t)t * 1024 + 128 * h + 64 * C + 8 * hi;
#pragma unroll
    for (int d0 = 0; d0 < 4; ++d0) qf[d0] = *(const bf16x8*)(q + 16 * d0); }
  asm volatile("s_waitcnt vmcnt(0)" ::: "memory");
#pragma unroll
  for (int d0 = 0; d0 < 4; ++d0) asm volatile("" : "+v"(qf[d0]));
  Src S; S.kb0 = (const char*)(ws + R_DK) + (128 * h + 64 * C) * 2; S.kp0 = 2048; S.kb1 = S.kb0; S.kp1 = 2048; S.vb = (const char*)(ws + R_DV) + 128 * h * 2; S.vp = 2048;
  f32x16 o[4]; float l;
  attn_pass3<1>(lds, S, qf, 1.0f, 4 * qb + 4, 4 * qb + 1 + (wid >> 1), o, l);
  const float lam = ((const float*)(ws + WS_MOD))[16384];
  float il[16]; row_bcast(wsf, (C == 0 ? 1.0f : -lam) / l, r32, hi, il);
  const char* park = (const char*)((float*)(ws + R_OC) + (size_t)(((h * 32 + qb) * 8 + wid)) * 4096);
  const unsigned pl = (unsigned)(opaque_tid() & 63) * 4u;
  if (C == 0) {
#pragma unroll
    for (int b = 0; b < 4; ++b) { const char* pb = park + b * 4096;
#pragma unroll
      for (int r = 0; r < 16; ++r) *(float*)(const_cast<char*>(pb) + pl + (unsigned)(r * 256)) = o[b][r] * il[r]; }
  } else {
#pragma unroll
    for (int b = 0; b < 4; ++b) { const char* pb = park + b * 4096;
#pragma unroll
      for (int r = 0; r < 16; ++r) oacc[b][r] = *(const float*)(pb + pl + (unsigned)(r * 256)) + o[b][r] * il[r]; }
  }
}

__device__ __forceinline__ void diff_unit(const Params& p, LAS unsigned char* lds, int h, int qb) {
  unsigned char* ws = p.ws;
  f32x16 oacc[4];
  diff_comp<0>(p, lds, h, qb, oacc);
  diff_comp<1>(p, lds, h, qb, oacc);
  const int tid = opaque_tid(), lane = tid & 63, wid = __builtin_amdgcn_readfirstlane(tid >> 6), r32 = lane & 31, hi = lane >> 5;
  const float* gsub = p.in[14];
  float g4[4];
#pragma unroll
  for (int b = 0; b < 4; ++b) g4[b] = gsub[32 * b + r32] * 0.8f;
  char* ob = (char*)((bf16_t*)(ws + R_OATT) + (size_t)(256 * qb + 32 * wid) * 2048 + 1024 + 128 * h);
  const unsigned lo = (unsigned)(4 * hi * 2048 + r32) * 2u;
#pragma unroll
  for (int r = 0; r < 16; ++r) {
    float ss = 0.f;
#pragma unroll
    for (int b = 0; b < 4; ++b) ss += oacc[b][r] * oacc[b][r];
    ss += __shfl_xor(ss, 1); ss += __shfl_xor(ss, 2); ss += __shfl_xor(ss, 4); ss += __shfl_xor(ss, 8); ss += __shfl_xor(ss, 16);
    const float rstd = 1.0f / sqrtf(ss * (1.0f / 128.0f) + EPS);
#pragma unroll
    for (int b = 0; b < 4; ++b) *(bf16_t*)(ob + lo + (unsigned)((((r & 3) + 8 * (r >> 2)) * 2048 + 32 * b) * 2)) = (bf16_t)f2bf(oacc[b][r] * rstd * g4[b]);
  }
}

struct AUnit { unsigned char kind, qb; };
struct AList { AUnit u[64]; };
constexpr AList make_alist() {
  AList L{}; int cost[64] = {}; int n = 0;
  for (int qb = 0; qb < 32; ++qb) { L.u[n].kind = 0; L.u[n].qb = (unsigned char)qb; cost[n] = 100 * (qb + 1); ++n; }
  for (int qb = 0; qb < 32; ++qb) { L.u[n].kind = 1; L.u[n].qb = (unsigned char)qb; cost[n] = 165 * (qb + 1); ++n; }
  for (int i = 1; i < 64; ++i) { const AUnit x = L.u[i]; const int c = cost[i]; int j = i - 1; while (j >= 0 && cost[j] < c) { L.u[j + 1] = L.u[j]; cost[j + 1] = cost[j]; --j; } L.u[j + 1] = x; cost[j + 1] = c; }
  return L;
}
__constant__ AList g_alist = make_alist();
constexpr int CW_AQ = 1024, CW_ROLE = 1280, CW_CQ = 1536;
constexpr int LDS_AQW = 147408;
constexpr unsigned N_CONVERTERS_PER_XCD = 7;

__device__ __forceinline__ int wg_pull(unsigned* head, unsigned limit, volatile LAS int* bw) {
  if (threadIdx.x == 0) {
    int idx = (int)limit;
    if (__hip_atomic_load(head, __ATOMIC_RELAXED, __HIP_MEMORY_SCOPE_AGENT) < limit) idx = (int)__hip_atomic_fetch_add(head, 1u, __ATOMIC_RELAXED, __HIP_MEMORY_SCOPE_AGENT);
    bw[0] = idx;
  }
  __syncthreads();
  const int idx = __builtin_amdgcn_readfirstlane(bw[0]);
  __syncthreads();
  return idx;
}
__device__ __forceinline__ int wg_bcast(int v, volatile LAS int* bw) {
  if (threadIdx.x == 0) bw[0] = v;
  __syncthreads();
  const int r = __builtin_amdgcn_readfirstlane(bw[0]);
  __syncthreads();
  return r;
}
__device__ __forceinline__ int q_take(unsigned* head) { const unsigned t = __hip_atomic_fetch_add(head, 1u, __ATOMIC_RELAXED, __HIP_MEMORY_SCOPE_AGENT); return (int)(t < 0xffffu ? t : 0xffffu); }
__device__ __forceinline__ void attn_queue_loop(const Params& p, LAS unsigned char* lds, unsigned* ctl, volatile LAS int* bw, unsigned x0) {
  const bool t0 = threadIdx.x == 0;
  unsigned g = x0 & 7u; int nxt = 0; bool have = false;
  for (;;) {
    if (t0 && !have) nxt = q_take(ctl + CW_AQ + 16u * g);
    have = false;
    const int idx = wg_bcast(nxt, bw);
    if (idx >= 64) {
      int pick = -1;
      if (t0) {
        unsigned hv[8];
#pragma unroll
        for (unsigned k = 1; k < 8u; ++k) hv[k] = __hip_atomic_load(ctl + CW_AQ + 16u * ((x0 + k) & 7u), __ATOMIC_RELAXED, __HIP_MEMORY_SCOPE_AGENT);
#pragma unroll
        for (unsigned k = 1; k < 8u; ++k) if (pick < 0 && hv[k] < 64u) pick = (int)((x0 + k) & 7u);
        if (pick >= 0) { nxt = q_take(ctl + CW_AQ + 16u * (unsigned)pick); have = true; }
      }
      const int pk = wg_bcast(pick, bw);
      if (pk < 0) break;
      g = (unsigned)pk;
      continue;
    }
    const AUnit u = g_alist.u[idx];
    const int kind = __builtin_amdgcn_readfirstlane((int)u.kind), qb = __builtin_amdgcn_readfirstlane((int)u.qb);
    if (kind == 0) mla_unit(p, lds, (int)g, qb); else diff_unit(p, lds, (int)g, qb);
  }
}
__device__ __forceinline__ int wg_bcast_raw(int v, volatile LAS int* bw) {
  if (threadIdx.x == 0) bw[0] = v;
  asm volatile("s_waitcnt lgkmcnt(0)\n\ts_barrier" ::: "memory");
  const int r = bw[0];
  asm volatile("s_waitcnt lgkmcnt(0)\n\ts_barrier" ::: "memory");
  return __builtin_amdgcn_readfirstlane(r);
}
__device__ __forceinline__ void conv_queue_loop(const Params& p, char* lds_generic, unsigned* ctl, volatile LAS int* bw) {
  const bool t0 = threadIdx.x == 0;
  const int tid = opaque_tid(), lane = tid & 63, wave = tid >> 6;
  float* scr = (float*)(lds_generic + wave * 16384);
  constexpr int FIRST_F8 = I_WOUT / CONV_CHUNK;
  int nxt = 0;
  if (t0) nxt = q_take(ctl + CW_CQ);
  int cur = wg_bcast(nxt, bw);
  if (cur >= N_CONV_CHUNKS) return;
  if (t0) nxt = q_take(ctl + CW_CQ);
  while (cur < FIRST_F8) {
    conv_chunk(p, lds_generic, cur);
    __syncthreads();
    cur = wg_bcast(nxt, bw);
    if (cur >= N_CONV_CHUNKS) return;
    if (t0) nxt = q_take(ctl + CW_CQ);
  }
  f32x4 vA[8], vB[8], vC[8], vD[8]; TrDesc dA, dB, dC, dD;
  { const int base = TR_FG + cur * CONV_CHUNK + wave * 8;
    dA = tr_decode(p, base + 0); tr_load_pair<true>(dA, vA, lane);
    dB = tr_decode(p, base + 1); tr_load_pair<true>(dB, vB, lane);
    dC = tr_decode(p, base + 2); tr_load_pair<true>(dC, vC, lane);
    dD = tr_decode(p, base + 3); tr_load_pair<true>(dD, vD, lane); }
  for (;;) {
    const int nx = wg_bcast_raw(nxt, bw);
    if (t0 && nx < N_CONV_CHUNKS) nxt = q_take(ctl + CW_CQ);
    const int base = TR_FG + cur * CONV_CHUNK + wave * 8, nbase = TR_FG + nx * CONV_CHUNK + wave * 8;
    const bool more = nx < N_CONV_CHUNKS;
    tr_finish_pair<true>(dA, vA, scr, lane); dA = tr_decode(p, base + 4); tr_load_pair<true>(dA, vA, lane);
    tr_finish_pair<true>(dB, vB, scr, lane); dB = tr_decode(p, base + 5); tr_load_pair<true>(dB, vB, lane);
    tr_finish_pair<true>(dC, vC, scr, lane); dC = tr_decode(p, base + 6); tr_load_pair<true>(dC, vC, lane);
    tr_finish_pair<true>(dD, vD, scr, lane); dD = tr_decode(p, base + 7); tr_load_pair<true>(dD, vD, lane);
    tr_finish_pair<true>(dA, vA, scr, lane); if (more) { dA = tr_decode(p, nbase + 0); tr_load_pair<true>(dA, vA, lane); }
    tr_finish_pair<true>(dB, vB, scr, lane); if (more) { dB = tr_decode(p, nbase + 1); tr_load_pair<true>(dB, vB, lane); }
    tr_finish_pair<true>(dC, vC, scr, lane); if (more) { dC = tr_decode(p, nbase + 2); tr_load_pair<true>(dC, vC, lane); }
    tr_finish_pair<true>(dD, vD, scr, lane); if (more) { dD = tr_decode(p, nbase + 3); tr_load_pair<true>(dD, vD, lane); }
    if (!more) break;
    cur = nx;
  }
  __syncthreads();
}

__device__ __forceinline__ void phase3_fast(const Params& p, LAS unsigned char* lds, char* lds_generic) {
  unsigned* ctl = (unsigned*)(p.ws + WS_CTL);
  volatile LAS int* bw = (volatile LAS int*)(lds + LDS_AQW);
  const unsigned x0 = (unsigned)__builtin_amdgcn_s_getreg((3 << 11) | 20) & 7u;
  const int ticket = wg_pull(ctl + CW_ROLE + 16u * x0, 0xffffffffu, bw);
  if ((unsigned)ticket < N_CONVERTERS_PER_XCD) { conv_queue_loop(p, lds_generic, ctl, bw); attn_queue_loop(p, lds, ctl, bw, x0); }
  else { attn_queue_loop(p, lds, ctl, bw, x0); conv_queue_loop(p, lds_generic, ctl, bw); }
}
}

constexpr int P5_STRIDE = 2052;
__device__ __forceinline__ void phase5(const Params& p, char* lds) {
  const int tid = opaque_tid(), lane = tid & 63, wave = tid >> 6;
  unsigned char* ws = p.ws;
  float* tile = (float*)lds;
  float* part = (float*)lds;
  int* lcnt = (int*)(lds + 135168);
  int* lbase = lcnt + 64;
  int* nent = lcnt + 128;
  int* ent = lcnt + 192;
  const float* mod = (const float*)(ws + WS_MOD);
  const float* x = p.in[0]; const bf16_t* y = (const bf16_t*)(ws + R_Y);
  const float* g_post = p.in[16]; const float* g_pre = p.in[17];
  const float* wr_ = p.in[18]; const float* br_ = p.in[19];
  unsigned char* h2 = (unsigned char*)(ws + WS_H2);
  float* topw = (float*)(ws + WS_TOPW);
  if (tid < 64) lcnt[tid] = 0;
  if (tid == 64) nent[0] = 0;
  __syncthreads();
  const u32x4* wrh = (const u32x4*)(ws + WS_WRT); const u32x4* wrl = (const u32x4*)(ws + WS_WRT + 256 * 1024);
#define P5_LOADB(ks, H, L) do { _Pragma("unroll") for (int _jt = 0; _jt < 4; ++_jt) { H[_jt] = wrh[((8 * wave + (ks)) * 4 + _jt) * 64 + lqb]; L[_jt] = wrl[((8 * wave + (ks)) * 4 + _jt) * 64 + lqb]; } } while (0)
  for (int ti = blockIdx.x; ti < T / 16; ti += gridDim.x) {
    const int row0 = 16 * ti;
    u32x4 bH0[4], bL0[4], bH1[4], bL1[4], bH2[4], bL2[4], bH3[4], bL3[4];
    int lqb = lane; asm volatile("" : "+v"(lqb));
    {
      int lq = lane; asm volatile("" : "+v"(lq));
      const int lr0 = 2 * wave, rowa = row0 + lr0;
      u32x2 yy[2][8]; f32x4 xv[2][8];
#pragma unroll
      for (int rr = 0; rr < 2; ++rr)
#pragma unroll
        for (int j = 0; j < 8; ++j) yy[rr][j] = *(const u32x2*)(y + (size_t)(rowa + rr) * D + 256 * j + 4 * lq);
#pragma unroll
      for (int rr = 0; rr < 2; ++rr)
#pragma unroll
        for (int j = 0; j < 8; ++j) xv[rr][j] = *(const f32x4*)(x + (size_t)(rowa + rr) * D + 256 * j + 4 * lq);
      float ss[2] = {0.f, 0.f};
#pragma unroll
      for (int rr = 0; rr < 2; ++rr)
#pragma unroll
        for (int j = 0; j < 8; ++j) { const u32x2 q = yy[rr][j]; const float a = bf_lo(q.x), b = bf_hi(q.x), c = bf_lo(q.y), d = bf_hi(q.y); ss[rr] += a * a + b * b + c * c + d * d; }
      float rstdy[2], s1[2] = {0.f, 0.f};
#pragma unroll
      for (int rr = 0; rr < 2; ++rr) rstdy[rr] = 1.0f / sqrtf(wave_sum(ss[rr]) * (1.0f / D) + EPS);
#pragma unroll
      for (int j = 0; j < 8; ++j) {
        const int c0 = 256 * j + 4 * lq;
        const f32x4 gp = *(const f32x4*)(g_post + c0), ga = *(const f32x4*)(mod + 4096 + c0);
#pragma unroll
        for (int rr = 0; rr < 2; ++rr) {
          const u32x2 q = yy[rr][j]; const f32x4 yv = (f32x4){bf_lo(q.x), bf_hi(q.x), bf_lo(q.y), bf_hi(q.y)};
          const f32x4 x1 = xv[rr][j] + ga * ((yv * rstdy[rr]) * gp);
          { u32x2 xb; xb.x = pk2(x1.x, x1.y); xb.y = pk2(x1.z, x1.w); *(u32x2*)((bf16_t*)(ws + R_X1) + (size_t)(rowa + rr) * D + c0) = xb; }
          xv[rr][j] = x1; s1[rr] += x1.x * x1.x + x1.y * x1.y + x1.z * x1.z + x1.w * x1.w;
        }
      }
      float rstd1[2];
#pragma unroll
      for (int rr = 0; rr < 2; ++rr) rstd1[rr] = 1.0f / sqrtf(wave_sum(s1[rr]) * (1.0f / D) + EPS);
#pragma unroll
      for (int j = 0; j < 8; ++j) {
        const int c0 = 256 * j + 4 * lq;
        const f32x4 gf = *(const f32x4*)(g_pre + c0), sh = *(const f32x4*)(mod + 6144 + c0), sc = *(const f32x4*)(mod + 8192 + c0);
#pragma unroll
        for (int rr = 0; rr < 2; ++rr) {
          const f32x4 hv = (xv[rr][j] * rstd1[rr]) * gf * (sc + 1.0f) + sh;
          *(unsigned*)(h2 + (size_t)(rowa + rr) * D + c0) = pack8_fp8(hv, hv).x;
          float* tp = tile + (lr0 + rr) * P5_STRIDE + c0; tp[0] = hv.x; tp[1] = hv.y; tp[2] = hv.z; tp[3] = hv.w;
        }
      }
    }
    asm volatile("" ::: "memory");
    P5_LOADB(0, bH0, bL0); P5_LOADB(1, bH1, bL1); P5_LOADB(2, bH2, bL2); P5_LOADB(3, bH3, bL3);
    __syncthreads();
    f32x4 racc[4];
#pragma unroll
    for (int jt = 0; jt < 4; ++jt) racc[jt] = (f32x4){0.f, 0.f, 0.f, 0.f};
#define P5_STEP(ks, H, L) do { \
      const float* ap = tile + (lane & 15) * P5_STRIDE + 32 * (8 * wave + (ks)) + 8 * (lane >> 4); \
      const f32x4 a0 = *(const f32x4*)ap, a1 = *(const f32x4*)(ap + 4); \
      const float av[8] = {a0.x, a0.y, a0.z, a0.w, a1.x, a1.y, a1.z, a1.w}; \
      unsigned hw[4], lw[4]; \
      _Pragma("unroll") for (int j = 0; j < 4; ++j) { const unsigned h = cvtpk2(av[2 * j], av[2 * j + 1]); hw[j] = h; lw[j] = cvtpk2(av[2 * j] - bf_lo(h), av[2 * j + 1] - bf_hi(h)); } \
      const bf16x8 ah = __builtin_bit_cast(bf16x8, (u32x4){hw[0], hw[1], hw[2], hw[3]}), al = __builtin_bit_cast(bf16x8, (u32x4){lw[0], lw[1], lw[2], lw[3]}); \
      _Pragma("unroll") for (int jt = 0; jt < 4; ++jt) { \
        const bf16x8 bh = __builtin_bit_cast(bf16x8, H[jt]), bl = __builtin_bit_cast(bf16x8, L[jt]); \
        racc[jt] = __builtin_amdgcn_mfma_f32_16x16x32_bf16(ah, bh, racc[jt], 0, 0, 0); \
        racc[jt] = __builtin_amdgcn_mfma_f32_16x16x32_bf16(ah, bl, racc[jt], 0, 0, 0); \
        racc[jt] = __builtin_amdgcn_mfma_f32_16x16x32_bf16(al, bh, racc[jt], 0, 0, 0); } } while (0)
    P5_STEP(0, bH0, bL0); P5_LOADB(4, bH0, bL0);
    P5_STEP(1, bH1, bL1); P5_LOADB(5, bH1, bL1);
    P5_STEP(2, bH2, bL2); P5_LOADB(6, bH2, bL2);
    P5_STEP(3, bH3, bL3); P5_LOADB(7, bH3, bL3);
    P5_STEP(4, bH0, bL0); P5_STEP(5, bH1, bL1); P5_STEP(6, bH2, bL2); P5_STEP(7, bH3, bL3);
#undef P5_STEP
    __syncthreads();
#pragma unroll
    for (int jt = 0; jt < 4; ++jt)
#pragma unroll
      for (int r = 0; r < 4; ++r) part[(wave * 16 + (lane >> 4) * 4 + r) * 64 + 16 * jt + (lane & 15)] = racc[jt][r];
    __syncthreads();
#pragma unroll 1
    for (int rr = 0; rr < 2; ++rr) {
      const int lr = 2 * wave + rr, tok = row0 + lr;
      float logit = 0.f;
#pragma unroll
      for (int w = 0; w < 8; ++w) logit += part[(w * 16 + lr) * 64 + lane];
      const float score = 1.0f / (1.0f + expf(-logit));
      const float v = score + br_[lane];
      int rk = 0;
#pragma unroll
      for (int d = 1; d < 8; ++d) { const int ol = (lane & ~7) | ((lane + d) & 7); const float ov = __shfl(v, ol); rk += (ov > v || (ov == v && ol < lane)) ? 1 : 0; }
      float gs = rk < 2 ? v : 0.f;
      gs += __shfl_xor(gs, 1); gs += __shfl_xor(gs, 2); gs += __shfl_xor(gs, 4);
      int grk = 0; const int g = lane >> 3;
#pragma unroll
      for (int gg = 0; gg < 8; ++gg) { const float og = __shfl(gs, 8 * gg); grk += (og > gs || (og == gs && gg < g)) ? 1 : 0; }
      const float mv = grk < 4 ? v : -INFINITY;
      int erk = 0;
#pragma unroll 8
      for (int e2 = 0; e2 < 64; ++e2) { const float ov = __shfl(mv, e2); erk += (ov > mv || (ov == mv && e2 < lane)) ? 1 : 0; }
      const bool sel = (erk < 8) && (grk < 4);
      const float tot = wave_sum(sel ? score : 0.f);
      if (sel) {
        topw[tok * 8 + erk] = score / tot * 2.5f;
        const int lp = atomicAdd(&lcnt[lane], 1);
        const int ix = atomicAdd(&nent[0], 1);
        ent[ix] = (tok * 8 + erk) | (lane << 16) | (lp << 22);
      }
    }
    __syncthreads();
  }
  unsigned* gcnt = (unsigned*)(ws + WS_CTL) + CW_GCNT;
  if (tid < 64) lbase[tid] = (int)atomicAdd(&gcnt[tid], (unsigned)lcnt[tid]);
  __syncthreads();
  int* rowl = (int*)(ws + WS_ROWL);
  const int ne = nent[0];
  int* tpos = (int*)(ws + WS_TPOS);
  for (int i = tid; i < ne; i += NTHREADS) { const int w = ent[i]; const int code = w & 0xffff, e = (w >> 16) & 63, lp = (w >> 22) & 1023; const int pos = lbase[e] + lp; rowl[e * 8192 + pos] = code; tpos[code] = (e << 16) | pos; }
}

struct MoeMap { LAS int* cnt; LAS int* tstart; LAS unsigned char* t2e; };
__device__ __forceinline__ void moe_map_build(const Params& p, char* lds, MoeMap& mm) {
  mm.cnt = (LAS int*)((LAS char*)lds + 140000); mm.tstart = mm.cnt + 80; mm.t2e = (LAS unsigned char*)((LAS char*)lds + 141024);
  if (threadIdx.x < 64) {
    const unsigned* gcnt = (const unsigned*)(p.ws + WS_CTL) + CW_GCNT; const int e = (int)threadIdx.x;
    const int c = (int)__hip_atomic_load(&gcnt[e], __ATOMIC_RELAXED, __HIP_MEMORY_SCOPE_AGENT);
    const int nt = (c + 255) >> 8; int inc = nt;
#pragma unroll
    for (int d = 1; d < 64; d <<= 1) { const int o = __shfl_up(inc, d, 64); if (e >= d) inc += o; }
    mm.cnt[e] = c; mm.tstart[e] = inc - nt;
    if (e == 63) { mm.cnt[64] = T; mm.tstart[64] = inc; mm.tstart[65] = inc + ((T + 255) >> 8); }
  }
  __syncthreads();
  for (int e = threadIdx.x; e < 65; e += NTHREADS) for (int t = mm.tstart[e]; t < mm.tstart[e + 1]; ++t) mm.t2e[t] = (unsigned char)e;
  __syncthreads();
}
__device__ __forceinline__ int moe_find(const MoeMap& mm, int mtg) { return (int)mm.t2e[mtg]; }

struct RowGather { const int* rl; int cnt, base; __device__ __forceinline__ int operator()(int r) const { const int i = base + r; return i < cnt ? (rl[i] >> 3) : 0; } };

__device__ __forceinline__ void phase8(const Params& p, const MoeMap& mm) {
  const int tid = opaque_tid(), lane = tid & 63, wave = tid >> 6;
  const int gw = blockIdx.x * NWAVES + wave, NGW = gridDim.x * NWAVES;
  unsigned char* ws = p.ws;
  const unsigned char* yp = (const unsigned char*)(ws + R_YSLOT); const float* topw = (const float*)(ws + WS_TOPW); const int* tpos = (const int*)(ws + WS_TPOS);
  const float* mod = (const float*)(ws + WS_MOD); const float* g = p.in[26];
  f32x4 gg[8];
#pragma unroll
  for (int j = 0; j < 8; ++j) { const int c0 = 256 * j + 4 * lane; gg[j] = *(const f32x4*)(mod + 10240 + c0) * *(const f32x4*)(g + c0); }
  int row = gw;
  float w[8]; int tp[8];
  if (row < T) {
#pragma unroll
    for (int s = 0; s < 8; ++s) { w[s] = topw[row * 8 + s]; tp[s] = tpos[row * 8 + s]; }
  }
  const size_t shared0 = (size_t)256 * mm.tstart[64];
  for (; row < T; row += NGW) {
    unsigned roff[9];
#pragma unroll
    for (int s = 0; s < 8; ++s) roff[s] = (unsigned)(256 * mm.tstart[tp[s] >> 16] + (tp[s] & 0xffff));
    unsigned q[9][8];
#pragma unroll
    for (int j = 0; j < 8; ++j) {
      const int c0 = 256 * j + 4 * lane;
      q[8][j] = *(const unsigned*)(yp + (shared0 + row) * 2048 + c0);
#pragma unroll
      for (int s = 0; s < 8; ++s) q[s][j] = *(const unsigned*)(yp + (size_t)roff[s] * 2048 + c0);
    }
    u32x2 xb[8];
#pragma unroll
    for (int j = 0; j < 8; ++j) xb[j] = *(const u32x2*)((const bf16_t*)(ws + R_X1) + (size_t)row * D + 256 * j + 4 * lane);
    float wc[8];
#pragma unroll
    for (int s = 0; s < 8; ++s) wc[s] = w[s];
    const int nrow = row + NGW;
    if (nrow < T) {
#pragma unroll
      for (int s = 0; s < 8; ++s) { w[s] = topw[nrow * 8 + s]; tp[s] = tpos[nrow * 8 + s]; }
    }
    f32x4 v[8]; float ss = 0.f;
#pragma unroll
    for (int j = 0; j < 8; ++j) {
      f32x4 a = unpack4_fp8(q[8][j]);
#pragma unroll
      for (int s = 0; s < 8; ++s) a += unpack4_fp8(q[s][j]) * wc[s];
      v[j] = a; ss += a.x * a.x + a.y * a.y + a.z * a.z + a.w * a.w;
    }
    const float rstd = 1.0f / sqrtf(wave_sum(ss) * (1.0f / D) + EPS);
#pragma unroll
    for (int j = 0; j < 8; ++j) {
      const int c0 = 256 * j + 4 * lane;
      const f32x4 x1 = (f32x4){bf_lo(xb[j].x), bf_hi(xb[j].x), bf_lo(xb[j].y), bf_hi(xb[j].y)};
      *(f32x4*)(p.out + (size_t)row * D + c0) = x1 + gg[j] * (v[j] * rstd);
    }
  }
}

template <bool GATHER> struct SchedMoe {
  MoeMap mm; int shift, nwg, G, c; const char* Abase; const char* Bbase; size_t bstride, tstepB, tstepA; const int* rowl;
  __device__ __forceinline__ bool next(int i, pg8::Unit& u) const {
    const int L = i * G + c; if (L >= nwg) return false;
    const int wgid = pg8::xcd_remap(L, nwg);
    const int mtg = wgid >> shift, pn = wgid & ((1 << shift) - 1), e = moe_find(mm, mtg);
    u.pm = mtg; u.pn = pn; u.e = e; u.aux = mtg - mm.tstart[e];
    u.A = GATHER ? Abase : Abase + (size_t)mtg * tstepA; u.B = Bbase + (size_t)e * bstride + (size_t)pn * tstepB; return true;
  }
  __device__ __forceinline__ int row(const pg8::Unit& u, int r) const {
    const int i = 256 * u.aux + r;
    if (u.e == 64) return i;
    return i < mm.cnt[u.e] ? (rowl[u.e * 8192 + i] >> 3) : 0;
  }
};


#define XB_TMO      128
#define XB_XCNT(j)  (256  + 64 * (j))
#define XB_XSUB(j)  (1280 + 64 * (j))
#define XB_XGEN(j)  (2304 + 64 * (j))
#define XB_TOP      3328
#define XB_TOPGEN   3392
#define XCD_BAR_WORDS 3456
#define XB_SPIN_CAP (1u << 18)
__device__ __forceinline__ unsigned xb_ld(unsigned* p)              { return __hip_atomic_load(p, __ATOMIC_RELAXED, __HIP_MEMORY_SCOPE_AGENT); }
__device__ __forceinline__ unsigned xb_add(unsigned* p, unsigned v) { return __hip_atomic_fetch_add(p, v, __ATOMIC_RELAXED, __HIP_MEMORY_SCOPE_AGENT); }
__device__ __forceinline__ unsigned xb_xcc_id() { return (unsigned)__builtin_amdgcn_s_getreg((3 << 11) | 20) & 0xFu; }
#define XB_SPIN(cond, bar) do { unsigned _sp = 0; while (cond) { __builtin_amdgcn_s_sleep(1); \
    if ((++_sp & 255u) == 0u) { if (xb_ld(&(bar)[XB_TMO])) break; if (_sp > XB_SPIN_CAP) { atomicAdd(&(bar)[XB_TMO], 1u); break; } } } } while (0)
struct XcdBarrier { unsigned* bar; unsigned x; volatile LAS unsigned* st; };
__device__ __forceinline__ XcdBarrier xcd_barrier_post(unsigned* bar, volatile LAS unsigned* st) {
    XcdBarrier b; b.bar = bar; b.x = xb_xcc_id(); b.st = st;
    if (threadIdx.x == 0) (void)xb_add(&bar[XB_XCNT(b.x)], 1u);
    return b;
}
__device__ __forceinline__ void xcd_barrier_complete(unsigned* bar, unsigned x, unsigned& nloc, unsigned& nx) {
    const unsigned G = gridDim.x * gridDim.y * gridDim.z;
    unsigned sum, cnt, mine, sp = 0u;
    for (;;) {
        sum = 0u; cnt = 0u; mine = 0u;
#pragma unroll
        for (unsigned j = 0; j < 16; ++j) { const unsigned c = xb_ld(&bar[XB_XCNT(j)]); sum += c; cnt += (c > 0u) ? 1u : 0u; mine = (j == x) ? c : mine; }
        if (sum == G) break;
        __builtin_amdgcn_s_sleep(1);
        if ((++sp & 255u) == 0u) { if (xb_ld(&bar[XB_TMO])) break; if (sp > XB_SPIN_CAP) { atomicAdd(&bar[XB_TMO], 1u); break; } }
    }
    nloc = mine > 0u ? mine : 1u; nx = cnt > 0u ? cnt : 1u;
}
__device__ __forceinline__ void xcd_barrier(const XcdBarrier& b) {
    asm volatile("s_waitcnt vmcnt(0)" ::: "memory");
    __syncthreads();
    if (threadIdx.x == 0) {
        unsigned* bar = b.bar;
        __builtin_amdgcn_s_waitcnt(0);
        unsigned nloc = b.st[0], nx = b.st[1];
        if (nloc == 0u) { xcd_barrier_complete(bar, b.x, nloc, nx); b.st[0] = nloc; b.st[1] = nx; }
        const unsigned old = xb_add(&bar[XB_XSUB(b.x)], 1u);
        const unsigned gen = old / nloc;
        if (old + 1u == (gen + 1u) * nloc) {
            __builtin_amdgcn_fence(__ATOMIC_RELEASE, "agent");
            asm volatile("s_waitcnt vmcnt(0)" ::: "memory");
            const unsigned og = xb_add(&bar[XB_TOP], 1u);
            const unsigned tg = og / nx;
            if (og + 1u == (tg + 1u) * nx) xb_add(&bar[XB_TOPGEN], 1u);
            else XB_SPIN(xb_ld(&bar[XB_TOPGEN]) == tg, bar);
            __builtin_amdgcn_fence(__ATOMIC_ACQUIRE, "agent");
            xb_add(&bar[XB_XGEN(b.x)], 1u);
            asm volatile("s_waitcnt vmcnt(0)" ::: "memory");
        } else {
            XB_SPIN(xb_ld(&bar[XB_XGEN(b.x)]) == gen, bar);
            __builtin_amdgcn_fence(__ATOMIC_ACQUIRE, "agent");
            asm volatile("s_waitcnt vmcnt(0)" ::: "memory");
        }
    }
    __syncthreads();
}
constexpr int CW_BAR = 4096;
constexpr int LDS_BARST = 147392;

#ifndef FAST_GEMM
#define FAST_GEMM 1
#endif
#ifndef FAST_ATTN
#define FAST_ATTN 1
#endif

__global__ void __launch_bounds__(NTHREADS) fwd_megakernel(Params p) {
  extern __shared__ __attribute__((aligned(16))) char lds[];
  cg::grid_group grid = cg::this_grid();
  unsigned char* ws = p.ws;
  const int G = gridDim.x;
  LAS unsigned char* ring = (LAS unsigned char*)lds;
  if (threadIdx.x < 16) ((LAS unsigned*)(ring + LDS_BARST))[threadIdx.x] = 0u;
  __syncthreads();
  const XcdBarrier xbar = xcd_barrier_post((unsigned*)(ws + WS_CTL) + CW_BAR, (volatile LAS unsigned*)(ring + LDS_BARST));
#define GRID_BAR() xcd_barrier(xbar)

  phase0a(p, lds);
#if DUP_PHASE == 1
  GRID_BAR(); phase0a(p, lds);
#endif
  GRID_BAR();
  phase0b(p, lds);
  GRID_BAR();
  {
    EpiProj<true> E{ws, 0};
#if FAST_GEMM
    pg8::SchedPlain S(ws + WS_H2, ws + WS_WIN, T, 4096, D, G, (int)blockIdx.x);
    pg8::gemm_phase<EpiProj<true>, pg8::SchedPlain, true, false>(ring, D, S, E);
#if DUP_PHASE == 2
    GRID_BAR(); pg8::gemm_phase<EpiProj<true>, pg8::SchedPlain, true, false>(ring, D, S, E);
#endif
#else
    for (int u = blockIdx.x; u < 32 * 18; u += G) {
      pg8::Unit un{}; un.pm = u / 18; un.pn = u % 18;
      gemm_tile_naive<true>((const bf16_t*)(ws + WS_H2), D, (const bf16_t*)(ws + WS_WIN) + (size_t)256 * un.pn * D, D, RowIdent{256 * un.pm}, E, un);
    }
#endif
  }
  GRID_BAR();
  {
    EpiRowScale<true> EQ{(bf16_t*)(ws + R_QM), NQ, (const float*)(ws + WS_SSQ), 12, 1.0f / QR, 0.07216878364870322f * 1.4426950408889634f};
    EpiRowScale<true> EK{(bf16_t*)(ws + R_KVM), NKV, (const float*)(ws + WS_SSQ + 512 * 1024), 8, 1.0f / KVR, 1.0f};
#if FAST_GEMM
    const int bx = (int)blockIdx.x, NA = (G >= 128) ? 64 : 0;
    if (NA) { EpiProj<true> EV{ws, 16};
      pg8::SchedPlain S(ws + WS_H2, ws + WS_WIN + (size_t)4096 * D * 2, T, 512, D, NA, bx < NA ? bx : (1 << 20));
      pg8::gemm_phase<EpiProj<true>, pg8::SchedPlain, true, false>(ring, D, S, EV); }
    else { EpiProj<true> EV{ws, 16};
      pg8::SchedPlain S(ws + WS_H2, ws + WS_WIN + (size_t)4096 * D * 2, T, 512, D, G, bx);
      pg8::gemm_phase<EpiProj<true>, pg8::SchedPlain, true, false>(ring, D, S, EV); }
    { pg8::SchedPlain S(ws + R_QLAT, ws + WS_WUQ, T, NQ, QR, G - NA, bx >= NA ? bx - NA : (1 << 20));
      pg8::gemm_phase<EpiRowScale<true>, pg8::SchedPlain, true, false>(ring, QR, S, EQ); }
    { pg8::SchedPlain S(ws + R_KVLAT, ws + WS_WUKV, T, NKV, KVR, G - NA, bx >= NA ? bx - NA : (1 << 20));
      pg8::gemm_phase<EpiRowScale<true>, pg8::SchedPlain, true, false>(ring, KVR, S, EK); }
#else
    for (int u = blockIdx.x; u < 32 * 6 + 32 * 8; u += G) {
      pg8::Unit un{};
      if (u < 192) { un.pm = u / 6; un.pn = u % 6;
        gemm_tile_naive<true>((const bf16_t*)(ws + R_QLAT), QR, (const bf16_t*)(ws + WS_WUQ) + (size_t)256 * un.pn * QR, QR, RowIdent{256 * un.pm}, EQ, un);
      } else { const int v = u - 192; un.pm = v / 8; un.pn = v % 8;
        gemm_tile_naive<true>((const bf16_t*)(ws + R_KVLAT), KVR, (const bf16_t*)(ws + WS_WUKV) + (size_t)256 * un.pn * KVR, KVR, RowIdent{256 * un.pm}, EK, un);
      }
    }
#endif
  }
  rotary_rows(p);
  GRID_BAR();
#if FAST_ATTN
  fa::phase3_fast(p, ring, lds);
  GRID_BAR();
#else
  phase3_naive(p);
  GRID_BAR();
  phase3b_naive(p);
  GRID_BAR();
#endif
  {
    EpiBf16<true> E{(bf16_t*)(ws + R_Y), D};
#if FAST_GEMM
    pg8::SchedPlain S(ws + R_OATT, ws + WS_WOUT, T, D, D, G, (int)blockIdx.x);
    pg8::gemm_phase<EpiBf16<true>, pg8::SchedPlain, true, false>(ring, D, S, E);
#else
    for (int u = blockIdx.x; u < 32 * 8; u += G) {
      pg8::Unit un{}; un.pm = u / 8; un.pn = u % 8;
      gemm_tile_naive<true>((const bf16_t*)(ws + R_OATT), D, (const bf16_t*)(ws + WS_WOUT) + (size_t)256 * un.pn * D, D, RowIdent{256 * un.pm}, E, un);
    }
#endif
  }
  GRID_BAR();
  phase5(p, lds);
  GRID_BAR();
  {
    MoeMap mm; moe_map_build(p, lds, mm);
    const int nmt = mm.tstart[65];
    {
      EpiSwiglu<true> E{(bf16_t*)(ws + WS_ACT), 1.0f / 32.0f};
      SchedMoe<true> S{mm, 2, nmt * 4, G, (int)blockIdx.x, (const char*)(ws + WS_H2), (const char*)(ws + WS_WGU), (size_t)1024 * D, (size_t)256 * D, 0, (const int*)(ws + WS_ROWL)};
#if FAST_GEMM
      pg8::gemm_phase<EpiSwiglu<true>, SchedMoe<true>, true, true, true>(ring, D / 2, S, E);
#if DUP_PHASE == 6
      GRID_BAR(); pg8::gemm_phase<EpiSwiglu<true>, SchedMoe<true>, true, true, true>(ring, D / 2, S, E);
#endif
#else
      pg8::Unit un;
      for (int i = 0; S.next(i, un); ++i) {
        const int e = un.e, mt = un.aux;
        if (e < 64) gemm_tile_naive<true>((const bf16_t*)(ws + WS_H2), D, (const bf16_t*)un.B, D, RowGather{(const int*)(ws + WS_ROWL) + e * 8192, mm.cnt[e], 256 * mt}, E, un);
        else gemm_tile_naive<true>((const bf16_t*)(ws + WS_H2), D, (const bf16_t*)un.B, D, RowIdent{256 * mt}, E, un);
      }
#endif
    }
    GRID_BAR();
    {
      EpiRowsFp8M<true> E{(unsigned char*)(ws + R_YSLOT), 1.0f / 32.0f};
      SchedMoe<false> S{mm, 3, nmt * 8, G, (int)blockIdx.x, (const char*)(ws + WS_ACT), (const char*)(ws + WS_WD), (size_t)2048 * DE, (size_t)256 * DE, (size_t)256 * DE, (const int*)(ws + WS_ROWL)};
#if FAST_GEMM
      pg8::gemm_phase<EpiRowsFp8M<true>, SchedMoe<false>, true, false, true, true>(ring, DE / 2, S, E);
#if DUP_PHASE == 7
      GRID_BAR(); pg8::gemm_phase<EpiRowsFp8M<true>, SchedMoe<false>, true, false, true, true>(ring, DE / 2, S, E);
#endif
#else
      pg8::Unit un;
      for (int i = 0; S.next(i, un); ++i)
        gemm_tile_naive<true>((const bf16_t*)(ws + WS_ACT), DE, (const bf16_t*)un.B, DE, RowIdent{256 * un.pm}, E, un);
#endif
    }
  }
  GRID_BAR();
  { MoeMap mm8; mm8.cnt = (LAS int*)((LAS char*)lds + 140000); mm8.tstart = mm8.cnt + 80; mm8.t2e = (LAS unsigned char*)((LAS char*)lds + 141024); phase8(p, mm8); }
}

extern "C" void kernel_launch(void* const* d_in, const int* in_sizes, int n_in, void* d_out, int out_size, void* d_ws, size_t ws_size, hipStream_t stream) {
  static int grid_blocks = 0;
  if (grid_blocks == 0) {
    if (n_in != 27 || out_size != T * D || ws_size < WS_END) { fprintf(stderr, "kernel_launch: unexpected shapes (n_in %d out %d ws %zu)\n", n_in, out_size, ws_size); grid_blocks = -1; return; }
    int dev = 0, cus = 0, per_cu = 0;
    hipGetDevice(&dev);
    hipDeviceGetAttribute(&cus, hipDeviceAttributeMultiprocessorCount, dev);
    hipFuncSetAttribute((const void*)fwd_megakernel, hipFuncAttributeMaxDynamicSharedMemorySize, LDS_BYTES);
    hipOccupancyMaxActiveBlocksPerMultiprocessor(&per_cu, (const void*)fwd_megakernel, NTHREADS, LDS_BYTES);
    if (per_cu < 1) { fprintf(stderr, "kernel_launch: occupancy query says %d\n", per_cu); per_cu = 1; }
    if (per_cu > 1) per_cu = 1;
    grid_blocks = cus * per_cu;
  }
  if (grid_blocks < 0) return;
  hipMemsetAsync((char*)d_ws + WS_CTL, 0, CTL_BYTES, stream);
  Params p{};
  for (int i = 0; i < 27; ++i) p.in[i] = (const float*)d_in[i];
  p.out = (float*)d_out; p.ws = (unsigned char*)d_ws;
  void* args[] = {&p};
  hipError_t e = hipLaunchCooperativeKernel((const void*)fwd_megakernel, dim3(grid_blocks), dim3(NTHREADS), args, LDS_BYTES, stream);
  if (e != hipSuccess) fprintf(stderr, "cooperative launch failed: %s (grid %d)\n", hipGetErrorString(e), grid_blocks);
}
```
